# Optimizing an MI355X kernel written in HIP

```python
import jax, jax.numpy as jnp
from jax import lax
import numpy as np

D_MODEL = 1024
BATCH = 4
SEQ = 4096
DEPTH = 4

N_MIXERS = 3
RMS_EPS = 1e-6
BLOCK = 128
NEG = -1e30

SWA_HEAD_DIM = 64
SWA_HEADS = D_MODEL // SWA_HEAD_DIM
SWA_KV_HEADS = SWA_HEADS // 8
SWA_GROUP = SWA_HEADS // SWA_KV_HEADS
WINDOW = 128

SB_HEAD_DIM = 64
SB_HEADS = D_MODEL // SB_HEAD_DIM

RET_QK_DIM = 256
RET_HEADS = D_MODEL // RET_QK_DIM
RET_V_DIM = 2 * RET_QK_DIM

D_FF = 4 * D_MODEL

N_A = len(range(0, DEPTH, N_MIXERS))
N_B = len(range(1, DEPTH, N_MIXERS))
N_C = len(range(2, DEPTH, N_MIXERS))

kernel_name = "hybrid_swa_stickbreak_retnet_trunk"


def rms_norm(x, g):
    xf = x.astype(jnp.float32)
    y = xf * lax.rsqrt(jnp.mean(xf * xf, axis=-1, keepdims=True) + RMS_EPS)
    return (y * g.astype(jnp.float32)).astype(x.dtype)


def alibi_slopes(n_heads):
    return jnp.exp2(-8.0 * jnp.arange(1, n_heads + 1, dtype=jnp.float32) / n_heads)


def swa_mixer(h, w_qkv, sinks, w_o):
    B_, T, _ = h.shape
    nb = T // BLOCK
    HD, KV, G = SWA_HEAD_DIM, SWA_KV_HEADS, SWA_GROUP
    qkv = h @ w_qkv
    q, k, v = jnp.split(qkv, [SWA_HEADS * HD, (SWA_HEADS + KV) * HD], axis=-1)
    q = q.reshape(B_, nb, BLOCK, KV, G, HD)
    k = k.reshape(B_, nb, BLOCK, KV, HD)
    v = v.reshape(B_, nb, BLOCK, KV, HD)

    def with_prev(a):
        prev = jnp.pad(a, ((0, 0), (1, 0), (0, 0), (0, 0), (0, 0)))[:, :-1]
        return jnp.concatenate([prev, a], axis=2)

    kb, vb = with_prev(k), with_prev(v)
    s = jnp.einsum('bnqkgd,bnskd->bnkgqs', q, kb).astype(jnp.float32) * (HD ** -0.5)

    blk = jnp.arange(nb)[:, None, None]
    qi = jnp.arange(BLOCK)[None, :, None]
    kj = jnp.arange(2 * BLOCK)[None, None, :]
    dist = BLOCK + qi - kj
    kpos = (blk - 1) * BLOCK + kj
    mask = (dist >= 0) & (dist < WINDOW) & (kpos >= 0)
    slopes = alibi_slopes(SWA_HEADS).reshape(1, 1, KV, G, 1, 1)
    bias = -slopes * dist.astype(jnp.float32)[None, :, None, None]
    logits = jnp.where(mask[None, :, None, None], s + bias, NEG)

    sink = sinks.astype(jnp.float32).reshape(1, 1, KV, G, 1, 1)
    m = jnp.maximum(jnp.max(logits, axis=-1, keepdims=True), sink)
    p = jnp.exp(logits - m)
    probs = p / (jnp.sum(p, axis=-1, keepdims=True) + jnp.exp(sink - m))
    o = jnp.einsum('bnkgqs,bnskd->bnqkgd', probs.astype(vb.dtype), vb)
    return o.reshape(B_, T, SWA_HEADS * HD) @ w_o


def stick_breaking_mixer(h, w_qkv, w_o):
    B_, T, _ = h.shape
    HD, H = SB_HEAD_DIM, SB_HEADS
    qkv = (h @ w_qkv).reshape(B_, T, 3, H, HD)
    q = jnp.transpose(qkv[:, :, 0], (0, 2, 1, 3))
    k = jnp.transpose(qkv[:, :, 1], (0, 2, 1, 3))
    v = jnp.transpose(qkv[:, :, 2], (0, 2, 1, 3))
    scale = HD ** -0.5
    outs = []
    for n in range(T // BLOCK):
        q0, end = n * BLOCK, (n + 1) * BLOCK
        z = jnp.einsum('bhqd,bhsd->bhqs', q[:, :, q0:end], k[:, :, :end]).astype(jnp.float32) * scale
        t_pos = q0 + jnp.arange(BLOCK)[:, None]
        s_pos = jnp.arange(end)[None, :]
        causal = (s_pos < t_pos)[None, None]
        log_beta = jax.nn.log_sigmoid(z)
        log_1m_beta = jnp.where(causal, jax.nn.log_sigmoid(-z), 0.0)
        rest = lax.cumsum(log_1m_beta, axis=3, reverse=True) - log_1m_beta
        a = jnp.where(causal, jnp.exp(log_beta + rest), 0.0)
        outs.append(jnp.einsum('bhqs,bhsd->bhqd', a.astype(v.dtype), v[:, :, :end]))
    o = jnp.concatenate(outs, axis=2)
    return jnp.transpose(o, (0, 2, 1, 3)).reshape(B_, T, H * HD) @ w_o


def retention_mixer(h, w_in, w_o):
    B_, T, _ = h.shape
    nc, C, H, dk, dv = T // BLOCK, BLOCK, RET_HEADS, RET_QK_DIM, RET_V_DIM
    proj = h @ w_in
    q, k, v, g = jnp.split(proj, [H * dk, 2 * H * dk, 2 * H * dk + H * dv], axis=-1)
    q = q.astype(jnp.float32).reshape(B_, nc, C, H, dk)
    k = k.astype(jnp.float32).reshape(B_, nc, C, H, dk) * (dk ** -0.5)
    v = v.astype(jnp.float32).reshape(B_, nc, C, H, dv)

    log_gamma = jnp.log1p(-jnp.exp2(-5.0 - jnp.arange(H, dtype=jnp.float32)))
    idx = jnp.arange(C)
    diff = idx[:, None] - idx[None, :]
    decay_mat = jnp.where(diff >= 0,
                          jnp.exp(log_gamma[:, None, None] * jnp.maximum(diff, 0).astype(jnp.float32)),
                          0.0)
    scores = jnp.einsum('bnihd,bnjhd->bnhij', q, k) * decay_mat
    o_inner = jnp.einsum('bnhij,bnjhe->bnihe', scores, v)
    q_decay = jnp.exp(log_gamma[:, None] * (idx + 1).astype(jnp.float32))
    k_decay = jnp.exp(log_gamma[:, None] * (C - 1 - idx).astype(jnp.float32))
    chunk_decay = jnp.exp(log_gamma * C)[None, :, None, None]
    kv_chunk = jnp.einsum('bnjhd,hj,bnjhe->bnhde', k, k_decay, v)

    def step(state, kv_n):
        return state * chunk_decay + kv_n, state

    init = jnp.zeros((B_, H, dk, dv), jnp.float32)
    _, prev_states = lax.scan(step, init, jnp.moveaxis(kv_chunk, 1, 0))
    prev_states = jnp.moveaxis(prev_states, 0, 1)
    o_cross = jnp.einsum('bnihd,hi,bnhde->bnihe', q, q_decay, prev_states)
    o = o_inner + o_cross
    o = o * lax.rsqrt(jnp.mean(o * o, axis=-1, keepdims=True) + RMS_EPS)
    o = o.reshape(B_, T, H * dv)
    y = jax.nn.silu(g.astype(jnp.float32)) * o
    return y.astype(h.dtype) @ w_o


def squared_relu_mlp(h, w_up, w_down):
    a = jax.nn.relu(h @ w_up)
    return (a * a) @ w_down


def setup_inputs(seed: int = 0) -> dict:
    key = jax.random.key(seed)
    ks = jax.random.split(key, 16)

    def dense(k, shape):
        return jax.random.normal(k, shape, jnp.float32) * (shape[-2] ** -0.5)

    def gain(k, shape):
        return 1.0 + 0.02 * jax.random.normal(k, shape, jnp.float32)

    swa_qkv_dim = (SWA_HEADS + 2 * SWA_KV_HEADS) * SWA_HEAD_DIM
    ret_in_dim = 2 * RET_HEADS * RET_QK_DIM + 2 * RET_HEADS * RET_V_DIM
    return {
        "x": jax.random.normal(ks[0], (BATCH, SEQ, D_MODEL), jnp.float32),
        "attn_norm": gain(ks[1], (DEPTH, D_MODEL)),
        "mlp_norm": gain(ks[2], (DEPTH, D_MODEL)),
        "final_norm": gain(ks[3], (D_MODEL,)),
        "swa_w_qkv": dense(ks[4], (N_A, D_MODEL, swa_qkv_dim)),
        "swa_sinks": 0.5 * jax.random.normal(ks[5], (N_A, SWA_HEADS), jnp.float32),
        "swa_w_o": dense(ks[6], (N_A, SWA_HEADS * SWA_HEAD_DIM, D_MODEL)),
        "sb_w_qkv": dense(ks[7], (N_B, D_MODEL, 3 * SB_HEADS * SB_HEAD_DIM)),
        "sb_w_o": dense(ks[8], (N_B, SB_HEADS * SB_HEAD_DIM, D_MODEL)),
        "ret_w_in": dense(ks[9], (N_C, D_MODEL, ret_in_dim)),
        "ret_w_o": dense(ks[10], (N_C, RET_HEADS * RET_V_DIM, D_MODEL)),
        "mlp_w_up": dense(ks[11], (DEPTH, D_MODEL, D_FF)),
        "mlp_w_down": dense(ks[12], (DEPTH, D_FF, D_MODEL)),
    }


def reference(x, attn_norm, mlp_norm, final_norm, swa_w_qkv, swa_sinks, swa_w_o,
              sb_w_qkv, sb_w_o, ret_w_in, ret_w_o, mlp_w_up, mlp_w_down):
    h = x
    for i in range(DEPTH):
        kind, j = i % N_MIXERS, i // N_MIXERS
        u = rms_norm(h, attn_norm[i])
        if kind == 0:
            mix = swa_mixer(u, swa_w_qkv[j], swa_sinks[j], swa_w_o[j])
        elif kind == 1:
            mix = stick_breaking_mixer(u, sb_w_qkv[j], sb_w_o[j])
        else:
            mix = retention_mixer(u, ret_w_in[j], ret_w_o[j])
        h = h + mix
        h = h + squared_relu_mlp(rms_norm(h, mlp_norm[i]), mlp_w_up[i], mlp_w_down[i])
    return rms_norm(h, final_norm)
```

```cpp
#include <hip/hip_runtime.h>
#include <hip/hip_cooperative_groups.h>
#include <cstdio>
#include <cstdint>
namespace cg = cooperative_groups;
namespace pg8 {
#define PG8_LAS __attribute__((address_space(3)))
typedef unsigned short bf16_t;
typedef short bf16x8 __attribute__((ext_vector_type(8)));
typedef float f32x4 __attribute__((ext_vector_type(4)));
typedef unsigned u32x4 __attribute__((ext_vector_type(4)));
constexpr int BM = 256, BK = 64, HALF = 128, HTB = HALF * BK * 2  , STAGE_BYTES = 8 * HTB, NXCD = 8, WGM = 8;

__host__ __device__ __forceinline__ int lds_byte(int r, int c) { const int st = (r >> 4) * 2 + (c >> 5), rr = r & 15, cc = c & 31, ob = rr * 64 + cc * 2; return st * 1024 + (ob ^ (((ob >> 9) & 1) << 5)); }
__host__ __device__ __forceinline__ void stage_rc(int b, int& R, int& C) { const int st = b / 1024, sb = b % 1024, swz = sb ^ (((sb >> 9) & 1) << 5); R = (st >> 1) * 16 + swz / 64; C = (st & 1) * 32 + (swz % 64) / 2; }
__host__ __device__ __forceinline__ int perm32(int rho) { const int n = rho >> 4, i = rho & 15; return 8 * (i >> 2) + 4 * n + (i & 3); }

struct Unit { int pm, pn; };
struct Gemm { const bf16_t* A; const bf16_t* Bt; int M, N, K; };

struct StaticOrder {
    int nM, nN, nwg, G, c;
    __host__ __device__ void init(int M, int N, int G_, int c_) { nM = M / BM; nN = N / BM; nwg = nM * nN; G = G_; c = c_; }
    __host__ __device__ bool next(int i, Unit& u) const {
        const long L = (long)i * G + c; if (L >= nwg) return false;
        int wgid = (int)L; { const int q = nwg / NXCD, r = nwg % NXCD, xcd = wgid % NXCD, off = wgid / NXCD; wgid = (xcd < r ? xcd * (q + 1) : r * (q + 1) + (xcd - r) * q) + off; }
        const int nig = WGM * nN, gid = wgid / nig, fm = gid * WGM, gsz = (nM - fm) < WGM ? (nM - fm) : WGM;
        u.pm = fm + ((wgid % nig) % gsz); u.pn = (wgid % nig) / gsz; return true;
    }
    __device__ __forceinline__ void a_ready(const Unit&) const {}
    __device__ __forceinline__ void done(const Unit&) const {}
};

__device__ __forceinline__ unsigned cvt_pk_bf16(float lo, float hi) { unsigned r; asm volatile("v_cvt_pk_bf16_f32 %0, %1, %2" : "=v"(r) : "v"(lo), "v"(hi)); return r; }
typedef float f32x2 __attribute__((ext_vector_type(2)));
__device__ __forceinline__ f32x2 gelu_pk(f32x2 v) {
    const f32x2 av = __builtin_elementwise_abs(v), d = av * 0.2316418882f + 1.0f;
    f32x2 t; t.x = __builtin_amdgcn_rcpf(d.x); t.y = __builtin_amdgcn_rcpf(d.y);
    f32x2 q = t * 0.5307027145f + (-0.7265760135f); q = q * t + 0.7107068705f; q = q * t + (-0.142248368f); q = q * t + 0.127414796f; q = q * t;
    const f32x2 s = (v * v) * (-0.72134752044f);
    f32x2 e; e.x = __builtin_amdgcn_exp2f(s.x); e.y = __builtin_amdgcn_exp2f(s.y);
    const f32x2 m = v * (q * e), r = v - m;
    f32x2 o; o.x = v.x < 0.f ? m.x : r.x; o.y = v.y < 0.f ? m.y : r.y; return o;
}

template <int ACT  > struct EpiBf16 {
    static constexpr bool PERM = true, AFTER_DRAIN = false; static_assert(ACT == 0 || ACT == 1, "EpiBf16: ACT is 0 (none) or 1 (gelu_pk)");
    bf16_t* O; int ldc; const float* bias; int split_cols; size_t split_stride; float scale0;
    __device__ __forceinline__ void operator()(const f32x4 (&acc)[2][2][4][2], const Unit& u, int wr, int wc, int fr, int fq) const {
        const int row0 = u.pm * BM + wr * 64 + fr; int colt = u.pn * BM; bf16_t* base = O;
        float sc = 1.f; if (split_cols) { const int t = colt / split_cols; base += (size_t)t * split_stride; colt -= t * split_cols; if (t == 0) sc = scale0; }
        const int col0 = colt + wc * 32 + 8 * fq, bcol0 = u.pn * BM + wc * 32 + 8 * fq;
        f32x4 bv[2][2];
#pragma unroll
        for (int bj = 0; bj < 2; ++bj)
#pragma unroll
            for (int n = 0; n < 2; ++n) bv[bj][n] = bias ? *(const f32x4*)(bias + bcol0 + bj * HALF + 4 * n) : (f32x4){0.f, 0.f, 0.f, 0.f};
#pragma unroll
        for (int ai = 0; ai < 2; ++ai)
#pragma unroll
            for (int m = 0; m < 4; ++m) { bf16_t* rowp = base + (size_t)(row0 + ai * HALF + m * 16) * ldc + col0;
#pragma unroll
                for (int bj = 0; bj < 2; ++bj) { f32x4 v0 = acc[ai][bj][m][0] + bv[bj][0], v1 = acc[ai][bj][m][1] + bv[bj][1];
                    if (ACT == 1) { f32x2 a = gelu_pk((f32x2){v0[0], v0[1]}), b = gelu_pk((f32x2){v0[2], v0[3]}), c = gelu_pk((f32x2){v1[0], v1[1]}), d = gelu_pk((f32x2){v1[2], v1[3]});
                        v0 = (f32x4){a.x, a.y, b.x, b.y}; v1 = (f32x4){c.x, c.y, d.x, d.y}; }
                    v0 = v0 * sc; v1 = v1 * sc; u32x4 w; w.x = cvt_pk_bf16(v0[0], v0[1]); w.y = cvt_pk_bf16(v0[2], v0[3]); w.z = cvt_pk_bf16(v1[0], v1[1]); w.w = cvt_pk_bf16(v1[2], v1[3]);
                    *(u32x4*)(rowp + bj * HALF) = w; } }
    }
};

template <class Epi, class Sched, bool ALIGN_EPI = false, bool SP2 = false>
__device__ __forceinline__ void gemm_phase(PG8_LAS unsigned char* lds, const Gemm g, const Sched& S, const Epi& E) {
    int tid_ = threadIdx.x; asm volatile("" : "+v"(tid_));
    const int tid = tid_, wid = __builtin_amdgcn_readfirstlane(tid >> 6), lane = tid & 63, wr = wid >> 2, wc = wid & 3, fr = lane & 15, fq = lane >> 4;
    const int K = g.K, nt = K / BK;
    unsigned voffA[2], voffB[2];
#pragma unroll
    for (int i = 0; i < 2; ++i) { int R, C; stage_rc(tid * 16 + i * 8192, R, C); const int Rb = Epi::PERM ? ((R & ~31) + perm32(R & 31)) : R;
        voffA[i] = (unsigned)(R * K + C) * 2u; voffB[i] = (unsigned)(Rb * K + C) * 2u; }
    const size_t kstep = (size_t)(BK * 2);
    const size_t hstep = (size_t)HALF * K * 2;
    const size_t tstep = 2 * hstep;
    const unsigned ldsw = (unsigned)wid * 1024u;
    const int aoff = lds_byte(wr * 64 + fr, fq * 8), boff = lds_byte(wc * 32 + fr, fq * 8);
#define PG8_SA(b, h) (((b) * 2 + (h)) * HTB)
#define PG8_SB(b, h) ((4 + (b) * 2 + (h)) * HTB)
#define PG8_STAGE(bufoff, gbase, voff) do { _Pragma("unroll") for (int _i = 0; _i < 2; ++_i) \
        __builtin_amdgcn_global_load_lds((const unsigned*)((const char*)(gbase) + (voff)[_i]), (PG8_LAS unsigned*)(lds + (bufoff) + ldsw + _i * 8192), 16, 0, 0); } while (0)
#define PG8_LDA(dst, b, h) do { _Pragma("unroll") for (int m = 0; m < 4; ++m) _Pragma("unroll") for (int k = 0; k < 2; ++k) dst[m][k] = *(const PG8_LAS bf16x8*)(lds + PG8_SA(b, h) + aoff + m * 2048 + k * 1024); } while (0)
#define PG8_LDB(dst, b, h) do { _Pragma("unroll") for (int n = 0; n < 2; ++n) _Pragma("unroll") for (int k = 0; k < 2; ++k) dst[n][k] = *(const PG8_LAS bf16x8*)(lds + PG8_SB(b, h) + boff + n * 2048 + k * 1024); } while (0)
#define PG8_MMA(ai, bj, At, Bt) do { __builtin_amdgcn_s_setprio(1); _Pragma("unroll") for (int m = 0; m < 4; ++m) _Pragma("unroll") for (int n = 0; n < 2; ++n) _Pragma("unroll") for (int k = 0; k < 2; ++k) \
        acc[ai][bj][m][n] = __builtin_amdgcn_mfma_f32_16x16x32_bf16(Bt[n][k], At[m][k], acc[ai][bj][m][n], 0, 0, 0); __builtin_amdgcn_s_setprio(0); } while (0)
#define PG8_WAIT_V(n) asm volatile("s_waitcnt vmcnt(" #n ")" ::: "memory")
#define PG8_WAIT_L(n) asm volatile("s_waitcnt lgkmcnt(" #n ")" ::: "memory")
#define PG8_BAR __builtin_amdgcn_s_barrier()
#define PG8_SCHED __builtin_amdgcn_sched_barrier(0)
    Unit cur, nxt; int ui = 0;
    if (!S.next(0, cur)) return;
    f32x4 acc[2][2][4][2];
#pragma unroll
    for (int a = 0; a < 2; ++a)
#pragma unroll
        for (int b = 0; b < 2; ++b)
#pragma unroll
            for (int m = 0; m < 4; ++m)
#pragma unroll
                for (int n = 0; n < 2; ++n) acc[a][b][m][n] = (f32x4){0.f, 0.f, 0.f, 0.f};
    bf16x8 At[4][2], B0[2][2], B1[2][2];
    const char* cA = (const char*)g.A + (size_t)cur.pm * tstep; const char* cB = (const char*)g.Bt + (size_t)cur.pn * tstep;
    S.a_ready(cur);
    if constexpr (SP2) {
        PG8_STAGE(PG8_SB(0, 0), cB, voffB); PG8_STAGE(PG8_SB(0, 1), cB + hstep, voffB); PG8_STAGE(PG8_SA(0, 0), cA, voffA); PG8_STAGE(PG8_SA(0, 1), cA + hstep, voffA);
        if (wr == 1) PG8_BAR;
        PG8_WAIT_V(2); PG8_BAR;
        PG8_STAGE(PG8_SB(1, 0), cB + kstep, voffB); PG8_STAGE(PG8_SA(1, 0), cA + kstep, voffA); PG8_STAGE(PG8_SB(1, 1), cB + hstep + kstep, voffB);
        PG8_WAIT_V(6); PG8_BAR;
    } else {
        PG8_STAGE(PG8_SB(0, 0), cB, voffB); PG8_STAGE(PG8_SA(0, 0), cA, voffA); PG8_STAGE(PG8_SB(0, 1), cB + hstep, voffB); PG8_STAGE(PG8_SA(0, 1), cA + hstep, voffA);
        if (wr == 1) PG8_BAR;
        PG8_WAIT_V(4); PG8_BAR;
        PG8_STAGE(PG8_SB(1, 0), cB + kstep, voffB); PG8_STAGE(PG8_SA(1, 0), cA + kstep, voffA); PG8_STAGE(PG8_SB(1, 1), cB + hstep + kstep, voffB);
        PG8_WAIT_V(6); PG8_BAR;
    }
    for (;;) {
        const bool has_next = S.next(ui + 1, nxt);
        const char* nA = has_next ? (const char*)g.A + (size_t)nxt.pm * tstep : cA; const char* nB = has_next ? (const char*)g.Bt + (size_t)nxt.pn * tstep : cB;
        for (int t = 0; t < nt; t += 2) {
            const bool last = (t == nt - 2);
            const char* a1 = cA + (size_t)(t + 1) * kstep;
            const char* a2 = last ? nA : cA + (size_t)(t + 2) * kstep; const char* b2 = last ? nB : cB + (size_t)(t + 2) * kstep;
            const char* a3 = a2 + kstep; const char* b3 = b2 + kstep;
            if (last && has_next) S.a_ready(nxt);
            if constexpr (SP2) {
            PG8_LDB(B0, 0, 0); PG8_LDB(B1, 0, 1); PG8_SCHED; PG8_LDA(At, 0, 0); PG8_STAGE(PG8_SA(1, 1), a1 + hstep, voffA);
            PG8_WAIT_V(8); PG8_WAIT_L(0); PG8_BAR; PG8_MMA(0, 0, At, B0); PG8_MMA(0, 1, At, B1); PG8_BAR; PG8_SCHED;
            PG8_LDA(At, 0, 1); PG8_STAGE(PG8_SB(0, 0), b2, voffB); PG8_STAGE(PG8_SB(0, 1), b2 + hstep, voffB); PG8_STAGE(PG8_SA(0, 0), a2, voffA);
            PG8_WAIT_V(8); PG8_WAIT_L(0); PG8_BAR; PG8_MMA(1, 0, At, B0); PG8_MMA(1, 1, At, B1); PG8_BAR; PG8_SCHED;
            PG8_LDB(B0, 1, 0); PG8_LDB(B1, 1, 1); PG8_SCHED; PG8_LDA(At, 1, 0); PG8_STAGE(PG8_SA(0, 1), a2 + hstep, voffA);
            PG8_WAIT_V(8); PG8_WAIT_L(0); PG8_BAR; PG8_MMA(0, 0, At, B0); PG8_MMA(0, 1, At, B1); PG8_BAR; PG8_SCHED;
            PG8_LDA(At, 1, 1); PG8_STAGE(PG8_SB(1, 0), b3, voffB); PG8_STAGE(PG8_SB(1, 1), b3 + hstep, voffB); PG8_STAGE(PG8_SA(1, 0), a3, voffA);
            PG8_WAIT_V(8); PG8_WAIT_L(0); PG8_BAR; PG8_MMA(1, 0, At, B0); PG8_MMA(1, 1, At, B1); PG8_BAR; PG8_SCHED;
            } else {
            PG8_LDB(B0, 0, 0); PG8_SCHED; PG8_LDA(At, 0, 0); PG8_STAGE(PG8_SA(1, 1), a1 + hstep, voffA);
            PG8_WAIT_L(8); PG8_BAR; PG8_WAIT_L(0); PG8_MMA(0, 0, At, B0); PG8_BAR; PG8_SCHED;
            PG8_LDB(B1, 0, 1); PG8_STAGE(PG8_SB(0, 0), b2, voffB);
            PG8_BAR; PG8_WAIT_L(0); PG8_MMA(0, 1, At, B1); PG8_BAR;
            PG8_LDA(At, 0, 1); PG8_STAGE(PG8_SA(0, 0), a2, voffA);
            PG8_BAR; PG8_WAIT_L(0); PG8_MMA(1, 0, At, B0); PG8_BAR; PG8_SCHED;
            PG8_STAGE(PG8_SB(0, 1), b2 + hstep, voffB);
            PG8_WAIT_V(6); PG8_BAR; PG8_MMA(1, 1, At, B1); PG8_BAR;
            PG8_LDB(B0, 1, 0); PG8_SCHED; PG8_LDA(At, 1, 0); PG8_STAGE(PG8_SA(0, 1), a2 + hstep, voffA);
            PG8_WAIT_L(8); PG8_BAR; PG8_WAIT_L(0); PG8_MMA(0, 0, At, B0); PG8_BAR; PG8_SCHED;
            PG8_LDB(B1, 1, 1); PG8_STAGE(PG8_SB(1, 0), b3, voffB);
            PG8_BAR; PG8_WAIT_L(0); PG8_MMA(0, 1, At, B1); PG8_BAR;
            PG8_LDA(At, 1, 1); PG8_STAGE(PG8_SA(1, 0), a3, voffA);
            PG8_BAR; PG8_WAIT_L(0); PG8_MMA(1, 0, At, B0); PG8_BAR; PG8_SCHED;
            PG8_STAGE(PG8_SB(1, 1), b3 + hstep, voffB);
            PG8_WAIT_V(6); PG8_BAR; PG8_MMA(1, 1, At, B1); PG8_BAR;
            }
        }
        if constexpr (ALIGN_EPI) { if (wr == 0) PG8_BAR; }
        if constexpr (!Epi::AFTER_DRAIN) { E(acc, cur, wr, wc, fr, fq); S.done(cur); }
        if (!has_next) break;
#pragma unroll
        for (int a = 0; a < 2; ++a)
#pragma unroll
            for (int b = 0; b < 2; ++b)
#pragma unroll
                for (int m = 0; m < 4; ++m)
#pragma unroll
                    for (int n = 0; n < 2; ++n) acc[a][b][m][n] = (f32x4){0.f, 0.f, 0.f, 0.f};
        cur = nxt; cA = nA; cB = nB; ++ui;
        if constexpr (ALIGN_EPI) { if (wr == 1) PG8_BAR; }
    }
    PG8_WAIT_V(0);
    if constexpr (!ALIGN_EPI) { if (wr == 0) PG8_BAR; }
    PG8_BAR;
    if constexpr (Epi::AFTER_DRAIN) { E.fused(acc, cur, wr, wc, fr, fq, lds, wid, lane); S.done(cur); }
#undef PG8_SA
#undef PG8_SB
#undef PG8_STAGE
#undef PG8_LDA
#undef PG8_LDB
#undef PG8_MMA
#undef PG8_WAIT_V
#undef PG8_WAIT_L
#undef PG8_BAR
#undef PG8_SCHED
}
}

#define LAS __attribute__((address_space(3)))
typedef unsigned short bf16;
typedef pg8::f32x4 f32x4;
typedef pg8::u32x4 u32x4;
typedef unsigned u32x2 __attribute__((ext_vector_type(2)));
typedef float f32x2_t __attribute__((ext_vector_type(2))); typedef __bf16 bf16x2_t __attribute__((ext_vector_type(2)));
__device__ __forceinline__ unsigned cvt_pk_bf16(float lo, float hi) { f32x2_t v = {lo, hi}; bf16x2_t r = __builtin_convertvector(v, bf16x2_t); return __builtin_bit_cast(unsigned, r); }
constexpr int D = 1024, BATCH = 4, SEQ = 4096, M = BATCH * SEQ, FF = 4096, DEPTH = 4;
constexpr int NWAVES = 8, NTHREADS = 512;
constexpr float RMS_EPS = 1e-6f;
constexpr size_t MiB = 1u << 20;
constexpr size_t WS_SSQ = 0;
constexpr size_t WS_BAR = 1 * MiB;
constexpr size_t WS_HB = 2 * MiB;
constexpr size_t WS_WB0 = 34 * MiB, WS_WB1 = 66 * MiB;
constexpr size_t WS_R = 98 * MiB;
constexpr size_t WS_SC = 226 * MiB;
constexpr size_t WS_SSQO = 242 * MiB;
constexpr size_t WS_END = 246 * MiB;
constexpr size_t WB_IN = 0, WB_O = 12 * MiB, WB_UP = 16 * MiB, WB_DOWN = 24 * MiB;
constexpr size_t R_O = 96 * MiB;
constexpr size_t R_V = 64 * MiB;
constexpr int LDS_BYTES = 147456;

__device__ __forceinline__ float bflo(unsigned u) { return __uint_as_float(u << 16); }
__device__ __forceinline__ float bfhi(unsigned u) { return __uint_as_float(u & 0xffff0000u); }
__device__ __forceinline__ float wave_sum(float v) {
#pragma unroll
    for (int o = 1; o < 64; o <<= 1) v += __shfl_xor(v, o);
    return v;
}
__device__ __forceinline__ float row_rs(const float* ssq, int row) {
    const f32x4* p = (const f32x4*)(ssq + (size_t)row * 16);
    const f32x4 a = p[0], b = p[1], c = p[2], d = p[3];
    const float s = (((a[0] + a[1]) + (a[2] + a[3])) + ((b[0] + b[1]) + (b[2] + b[3]))) + (((c[0] + c[1]) + (c[2] + c[3])) + ((d[0] + d[1]) + (d[2] + d[3])));
    return rsqrtf(s * (1.f / 1024.f) + RMS_EPS);
}

template <int ACT> struct EpiRowScale {
    static constexpr bool PERM = true, AFTER_DRAIN = false;
    bf16* O; int ldc; const float* ssq; int split_cols; size_t split_stride;
    const LAS float* tab; int k0, k1, k2, k3;
    __device__ __forceinline__ void operator()(const f32x4 (&acc)[2][2][4][2], const pg8::Unit& u, int wr, int wc, int fr, int fq) const {
        const int row0 = u.pm * 256 + wr * 64 + fr; int colt = u.pn * 256; bf16* base = O;
        if (split_cols) { const int t = colt / split_cols; base += (size_t)t * split_stride; colt -= t * split_cols; }
        const int col0 = colt + wc * 32 + 8 * fq;
        const int slot = (u.pm == k0) ? 0 : (u.pm == k1) ? 1 : (u.pm == k2) ? 2 : (u.pm == k3) ? 3 : -1;
#pragma unroll
        for (int ai = 0; ai < 2; ++ai)
#pragma unroll
            for (int m = 0; m < 4; ++m) {
                const int row = row0 + ai * 128 + m * 16; const float rs = slot >= 0 ? tab[slot * 256 + wr * 64 + fr + ai * 128 + m * 16] : row_rs(ssq, row);
                bf16* rowp = base + (size_t)row * ldc + col0;
#pragma unroll
                for (int bj = 0; bj < 2; ++bj) {
                    f32x4 v0 = acc[ai][bj][m][0] * rs, v1 = acc[ai][bj][m][1] * rs;
                    if (ACT == 1) {
#pragma unroll
                        for (int e = 0; e < 4; ++e) { float a = fmaxf(v0[e], 0.f), b = fmaxf(v1[e], 0.f); v0[e] = a * a; v1[e] = b * b; }
                    }
                    u32x4 w; w.x = cvt_pk_bf16(v0[0], v0[1]); w.y = cvt_pk_bf16(v0[2], v0[3]); w.z = cvt_pk_bf16(v1[0], v1[1]); w.w = cvt_pk_bf16(v1[2], v1[3]);
                    *(u32x4*)(rowp + bj * 128) = w;
                }
            }
    }
};
template <bool BASE_F32> struct EpiRes {
    static constexpr bool PERM = true, AFTER_DRAIN = false;
    const float* xbase; bf16* hb; float* ssq;
    __device__ __forceinline__ void operator()(const f32x4 (&acc)[2][2][4][2], const pg8::Unit& u, int wr, int wc, int fr, int fq) const {
        const int col0 = u.pn * 256 + wc * 32 + 8 * fq;
#pragma unroll
        for (int ai = 0; ai < 2; ++ai)
#pragma unroll
            for (int m = 0; m < 4; ++m) {
                const int row = u.pm * 256 + ai * 128 + wr * 64 + m * 16 + fr; const size_t off = (size_t)row * D + col0; float s = 0.f;
#pragma unroll
                for (int bj = 0; bj < 2; ++bj) {
                    const size_t o = off + bj * 128;
                    f32x4 v0, v1;
                    if (BASE_F32) { v0 = *(const f32x4*)(xbase + o); v1 = *(const f32x4*)(xbase + o + 4); }
                    else { const u32x4 hv = *(const u32x4*)(hb + o); v0 = (f32x4){bflo(hv.x), bfhi(hv.x), bflo(hv.y), bfhi(hv.y)}; v1 = (f32x4){bflo(hv.z), bfhi(hv.z), bflo(hv.w), bfhi(hv.w)}; }
                    v0 = v0 + acc[ai][bj][m][0]; v1 = v1 + acc[ai][bj][m][1];
                    s += ((v0[0] * v0[0] + v0[1] * v0[1]) + (v0[2] * v0[2] + v0[3] * v0[3])) + ((v1[0] * v1[0] + v1[1] * v1[1]) + (v1[2] * v1[2] + v1[3] * v1[3]));
                    u32x4 w; w.x = cvt_pk_bf16(v0[0], v0[1]); w.y = cvt_pk_bf16(v0[2], v0[3]); w.z = cvt_pk_bf16(v1[0], v1[1]); w.w = cvt_pk_bf16(v1[2], v1[3]);
                    *(u32x4*)(hb + o) = w;
                }
                s += __shfl_xor(s, 16); s += __shfl_xor(s, 32);
                if (fq == 0) ssq[(size_t)row * 16 + u.pn * 4 + wc] = s;
            }
    }
};
struct EpiGate {
    static constexpr bool PERM = true, AFTER_DRAIN = false;
    bf16* Y; const bf16* Oin; const float* ssq; const float* rmso;
    __device__ __forceinline__ void operator()(const f32x4 (&acc)[2][2][4][2], const pg8::Unit& u, int wr, int wc, int fr, int fq) const {
        const int row0 = u.pm * 256 + wr * 64 + fr; const int col0 = u.pn * 256 + wc * 32 + 8 * fq;
#pragma unroll
        for (int ai = 0; ai < 2; ++ai)
#pragma unroll
            for (int m = 0; m < 4; ++m) {
                const int row = row0 + ai * 128 + m * 16; const float rs = row_rs(ssq, row);
                float ro; { const f32x4* p = (const f32x4*)(rmso + ((size_t)row * 4 + (u.pn >> 1)) * 16); const f32x4 a = p[0], b = p[1], c = p[2], d = p[3];
                    const float s = (((a[0] + a[1]) + (a[2] + a[3])) + ((b[0] + b[1]) + (b[2] + b[3]))) + (((c[0] + c[1]) + (c[2] + c[3])) + ((d[0] + d[1]) + (d[2] + d[3]))); ro = rsqrtf(s * (1.f / 512.f) + RMS_EPS); }
#pragma unroll
                for (int bj = 0; bj < 2; ++bj) {
                    const int c = col0 + bj * 128;
                    const u32x4 ov = *(const u32x4*)(Oin + (size_t)row * 2048 + c);
                    float o8[8] = {bflo(ov.x), bfhi(ov.x), bflo(ov.y), bfhi(ov.y), bflo(ov.z), bfhi(ov.z), bflo(ov.w), bfhi(ov.w)};
                    float y8[8];
#pragma unroll
                    for (int e = 0; e < 8; ++e) { const float g = (e < 4 ? acc[ai][bj][m][0][e & 3] : acc[ai][bj][m][1][e & 3]) * rs; const float sg = g / (1.f + __expf(-g)); y8[e] = sg * o8[e] * ro; }
                    u32x4 w; w.x = cvt_pk_bf16(y8[0], y8[1]); w.y = cvt_pk_bf16(y8[2], y8[3]); w.z = cvt_pk_bf16(y8[4], y8[5]); w.w = cvt_pk_bf16(y8[6], y8[7]);
                    *(u32x4*)(Y + (size_t)row * 2048 + c) = w;
                }
            }
    }
};

struct Args { const float* in[13]; float* out; unsigned char* ws; };

struct CvItem { const float* src; bf16* dst; const float* gain; float cs; int N, K; };
__device__ __forceinline__ void cv_load(const CvItem& d, float (&r)[32]) {
#pragma unroll
    for (int i = 0; i < 32; ++i) r[i] = d.src[(size_t)(2 * i) * d.N];
}
__device__ __forceinline__ void cv_store(const CvItem& d, const float (&r)[32], LAS float* scr, int lane) {
#pragma unroll
    for (int i = 0; i < 32; ++i) scr[(2 * i + (lane >> 5)) * 33 + (lane & 31)] = r[i] * d.cs;
    asm volatile("s_waitcnt lgkmcnt(0)" ::: "memory");
    const int c = lane & 7;
    f32x4 g0 = (f32x4){1.f, 1.f, 1.f, 1.f}, g1 = g0;
    if (d.gain) { g0 = *(const f32x4*)(d.gain + 8 * c); g1 = *(const f32x4*)(d.gain + 8 * c + 4); }
#pragma unroll
    for (int j = 0; j < 4; ++j) { const int nn = (lane >> 3) + 8 * j; const LAS float* s = scr + (8 * c) * 33 + nn;
        u32x4 o; o.x = cvt_pk_bf16(s[0 * 33] * g0[0], s[1 * 33] * g0[1]); o.y = cvt_pk_bf16(s[2 * 33] * g0[2], s[3 * 33] * g0[3]);
        o.z = cvt_pk_bf16(s[4 * 33] * g1[0], s[5 * 33] * g1[1]); o.w = cvt_pk_bf16(s[6 * 33] * g1[2], s[7 * 33] * g1[3]);
        *(u32x4*)(d.dst + (size_t)nn * d.K + 8 * c) = o; }
    asm volatile("s_waitcnt lgkmcnt(0)" ::: "memory");
}
__device__ __forceinline__ void convert_layer(const Args& a, int i, LAS unsigned char* lds, int gw, int NGW, int wave, int lane) {
    const int kind = i % 3, j = i / 3;
    const float* w_in; int n_in; const float* w_o; int k_o; int sc_lo, sc_hi; float sc;
    if (kind == 0) { w_in = a.in[4] + (size_t)j * D * 1280; n_in = 1280; w_o = a.in[6] + (size_t)j * D * D; k_o = 1024; sc_lo = 0; sc_hi = 1024; sc = 0.125f; }
    else if (kind == 1) { w_in = a.in[7] + (size_t)j * D * 3072; n_in = 3072; w_o = a.in[8] + (size_t)j * D * D; k_o = 1024; sc_lo = 0; sc_hi = 1024; sc = 0.125f * 1.4426950408889634f; }
    else { w_in = a.in[9] + (size_t)j * D * 6144; n_in = 6144; w_o = a.in[10] + (size_t)j * 2048 * D; k_o = 2048; sc_lo = 1024; sc_hi = 2048; sc = 0.0625f; }
    const float* w_up = a.in[11] + (size_t)i * D * FF; const float* w_dn = a.in[12] + (size_t)i * FF * D;
    const float* g_attn = a.in[1] + (size_t)i * D; const float* g_mlp = a.in[2] + (size_t)i * D;
    unsigned char* wb = a.ws + ((i & 1) ? WS_WB1 : WS_WB0);
    LAS float* scr = (LAS float*)(lds + wave * 16384);
    const int I_in = (D / 64) * (n_in / 32), I_o = (k_o / 64) * (D / 32), I_up = (D / 64) * (FF / 32), I_dn = (FF / 64) * (D / 32);
    const int NITEMS = I_in + I_o + I_up + I_dn;
#define CV_DECODE(dsc, itv) do { int r_ = (itv); const float* W_; int K_, N_; bf16* WT_; const float* gn_; int lo_ = 0, hi_ = 0; \
        if (r_ < I_in) { W_ = w_in; K_ = D; N_ = n_in; WT_ = (bf16*)(wb + WB_IN); gn_ = g_attn; lo_ = sc_lo; hi_ = sc_hi; } \
        else if ((r_ -= I_in) < I_o) { W_ = w_o; K_ = k_o; N_ = D; WT_ = (bf16*)(wb + WB_O); gn_ = nullptr; } \
        else if ((r_ -= I_o) < I_up) { W_ = w_up; K_ = D; N_ = FF; WT_ = (bf16*)(wb + WB_UP); gn_ = g_mlp; } \
        else { r_ -= I_up; W_ = w_dn; K_ = FF; N_ = D; WT_ = (bf16*)(wb + WB_DOWN); gn_ = nullptr; } \
        const int nblk_ = N_ / 32, kb_ = r_ / nblk_, nb_ = r_ % nblk_, k0_ = 64 * kb_, n0_ = 32 * nb_, n_ = n0_ + (lane & 31); \
        (dsc).src = W_ + (size_t)(k0_ + (lane >> 5)) * N_ + n_; (dsc).dst = WT_ + (size_t)n0_ * K_ + k0_; (dsc).gain = gn_ ? gn_ + k0_ : nullptr; \
        (dsc).cs = (n_ >= lo_ && n_ < hi_) ? sc : 1.f; (dsc).N = N_; (dsc).K = K_; } while (0)
    for (int it = gw; it < NITEMS; it += 2 * NGW) {
        CvItem d0, d1; float r0[32], r1[32];
        CV_DECODE(d0, it); cv_load(d0, r0);
        const bool two = it + NGW < NITEMS;
        if (two) { CV_DECODE(d1, it + NGW); cv_load(d1, r1); }
        cv_store(d0, r0, scr, lane);
        if (two) cv_store(d1, r1, scr, lane);
    }
#undef CV_DECODE
}

#define UNPACK8(dst, vv_) do { (dst)[0] = bflo((vv_)[0]); (dst)[1] = bfhi((vv_)[0]); (dst)[2] = bflo((vv_)[1]); (dst)[3] = bfhi((vv_)[1]); (dst)[4] = bflo((vv_)[2]); (dst)[5] = bfhi((vv_)[2]); (dst)[6] = bflo((vv_)[3]); (dst)[7] = bfhi((vv_)[3]); } while (0)
__device__ __forceinline__ void swa_naive(const bf16* qkv, const float* sinks, bf16* o, int gtid, int gthreads) {
    for (int idx = gtid; idx < M * 16; idx += gthreads) {
        const int head = idx & 15, m = idx >> 4, t = m & (SEQ - 1), kv = head >> 3;
        float q[64], acc[64];
        { const u32x4* qp = (const u32x4*)(qkv + (size_t)m * 1280 + head * 64);
#pragma unroll
          for (int c = 0; c < 8; ++c) { const u32x4 w = qp[c]; UNPACK8(q + 8 * c, w); } }
#pragma unroll
        for (int d = 0; d < 64; ++d) acc[d] = 0.f;
        const float slope = exp2f(-0.5f * (float)(head + 1));
        float mr = sinks[head], l = 1.f;
        const int s0 = t - 127 < 0 ? 0 : t - 127;
        for (int s = s0; s <= t; ++s) {
            const bf16* kp = qkv + (size_t)(m - (t - s)) * 1280 + 1024 + kv * 64; const bf16* vp = kp + 128;
            float z = 0.f;
#pragma unroll
            for (int c = 0; c < 8; ++c) { const u32x4 w = ((const u32x4*)kp)[c]; float k8[8]; UNPACK8(k8, w);
#pragma unroll
                for (int e = 0; e < 8; ++e) z += q[8 * c + e] * k8[e]; }
            z -= slope * (float)(t - s);
            const float mn = fmaxf(mr, z), corr = __expf(mr - mn), p = __expf(z - mn);
            l = l * corr + p; mr = mn;
#pragma unroll
            for (int c = 0; c < 8; ++c) { const u32x4 w = ((const u32x4*)vp)[c]; float v8[8]; UNPACK8(v8, w);
#pragma unroll
                for (int e = 0; e < 8; ++e) acc[8 * c + e] = acc[8 * c + e] * corr + p * v8[e]; }
        }
        const float inv = 1.f / l;
        u32x4* op = (u32x4*)(o + (size_t)m * 1024 + head * 64);
#pragma unroll
        for (int c = 0; c < 8; ++c) { u32x4 w; w.x = cvt_pk_bf16(acc[8 * c] * inv, acc[8 * c + 1] * inv); w.y = cvt_pk_bf16(acc[8 * c + 2] * inv, acc[8 * c + 3] * inv);
            w.z = cvt_pk_bf16(acc[8 * c + 4] * inv, acc[8 * c + 5] * inv); w.w = cvt_pk_bf16(acc[8 * c + 6] * inv, acc[8 * c + 7] * inv); op[c] = w; }
    }
}
__device__ __forceinline__ void sb_naive(const bf16* qkv, bf16* o, int gtid, int gthreads) {
    int it = 0; const bool mir = (gthreads % (SEQ * 16)) == 0;
    for (int idx = gtid; idx < M * 16; idx += gthreads, ++it) {
        const int head = idx & 15; int m = idx >> 4; int t = m & (SEQ - 1);
        if (mir && (it & 1)) { t = SEQ - 1 - t; m = (m & ~(SEQ - 1)) + t; }
        float q[64], acc[64];
        { const u32x4* qp = (const u32x4*)(qkv + (size_t)m * 3072 + head * 64);
#pragma unroll
          for (int c = 0; c < 8; ++c) { const u32x4 w = qp[c]; UNPACK8(q + 8 * c, w); } }
#pragma unroll
        for (int d = 0; d < 64; ++d) acc[d] = 0.f;
        float carry = 0.f;
        for (int s = t - 1; s >= 0; --s) {
            const bf16* kp = qkv + (size_t)(m - (t - s)) * 3072 + 1024 + head * 64; const bf16* vp = kp + 1024;
            float z = 0.f;
#pragma unroll
            for (int c = 0; c < 8; ++c) { const u32x4 w = ((const u32x4*)kp)[c]; float k8[8]; UNPACK8(k8, w);
#pragma unroll
                for (int e = 0; e < 8; ++e) z += q[8 * c + e] * k8[e]; }
            const float sp = fmaxf(z, 0.f) + __logf(1.f + __expf(-fabsf(z)));
            const float p = __expf(z - sp + carry);
            carry -= sp;
#pragma unroll
            for (int c = 0; c < 8; ++c) { const u32x4 w = ((const u32x4*)vp)[c]; float v8[8]; UNPACK8(v8, w);
#pragma unroll
                for (int e = 0; e < 8; ++e) acc[8 * c + e] += p * v8[e]; }
        }
        u32x4* op = (u32x4*)(o + (size_t)m * 1024 + head * 64);
#pragma unroll
        for (int c = 0; c < 8; ++c) { u32x4 w; w.x = cvt_pk_bf16(acc[8 * c], acc[8 * c + 1]); w.y = cvt_pk_bf16(acc[8 * c + 2], acc[8 * c + 3]);
            w.z = cvt_pk_bf16(acc[8 * c + 4], acc[8 * c + 5]); w.w = cvt_pk_bf16(acc[8 * c + 6], acc[8 * c + 7]); op[c] = w; }
    }
}
__device__ __forceinline__ void ret_naive(const bf16* qk, bf16* vo, int gtid, int gthreads) {
    for (int idx = gtid; idx < 16 * 512 * 16; idx += gthreads) {
        const int dqi = idx & 15, e = (idx >> 4) & 511, bh = idx >> 13, b = bh >> 2, h = bh & 3;
        const float gamma = 1.f - exp2f(-5.f - (float)h);
        float S[16];
#pragma unroll
        for (int j = 0; j < 16; ++j) S[j] = 0.f;
        for (int t = 0; t < SEQ; ++t) {
            const size_t row = (size_t)b * SEQ + t;
            const u32x4* qp = (const u32x4*)(qk + row * 2048 + h * 256 + dqi * 16);
            const u32x4* kp = (const u32x4*)(qk + row * 2048 + 1024 + h * 256 + dqi * 16);
            bf16* vp = vo + row * 2048 + h * 512 + e;
            const float v = __uint_as_float((unsigned)(*vp) << 16);
            float q16[16], k16[16];
            { const u32x4 w0 = qp[0], w1 = qp[1]; UNPACK8(q16, w0); UNPACK8(q16 + 8, w1); }
            { const u32x4 w0 = kp[0], w1 = kp[1]; UNPACK8(k16, w0); UNPACK8(k16 + 8, w1); }
            float part = 0.f;
#pragma unroll
            for (int j = 0; j < 16; ++j) { S[j] = gamma * S[j] + k16[j] * v; part += q16[j] * S[j]; }
            part += __shfl_xor(part, 1); part += __shfl_xor(part, 2); part += __shfl_xor(part, 4); part += __shfl_xor(part, 8);
            if (dqi == 0) *vp = (bf16)(cvt_pk_bf16(part, 0.f) & 0xffffu);
        }
    }
}

typedef short bf16x8 __attribute__((ext_vector_type(8)));
typedef short s16x4 __attribute__((ext_vector_type(4)));
typedef float f32x16 __attribute__((ext_vector_type(16)));
#define MFMA32(a, b, c) __builtin_amdgcn_mfma_f32_32x32x16_bf16((a), (b), (c), 0, 0, 0)
__device__ __forceinline__ s16x4 tr16(const LAS unsigned char* p) { return __builtin_bit_cast(s16x4, __builtin_amdgcn_ds_read_tr16_b64_v4i16((LAS s16x4*)p)); }
__device__ __forceinline__ bf16x8 pack8(const float* a) {
    u32x4 w; w.x = cvt_pk_bf16(a[0], a[1]); w.y = cvt_pk_bf16(a[2], a[3]); w.z = cvt_pk_bf16(a[4], a[5]); w.w = cvt_pk_bf16(a[6], a[7]);
    return __builtin_bit_cast(bf16x8, w);
}
constexpr int SB_ROW = 144, SB_TILE = 64 * SB_ROW;
__device__ __forceinline__ void sb_phase(const bf16* qkv, bf16* o, LAS unsigned char* lds, int vcu, int G, int tid) {
    const int lane = tid & 63, wave = __builtin_amdgcn_readfirstlane(tid >> 6), r32 = lane & 31, hi = lane >> 5;
    const int srow = tid >> 3, sch = tid & 7;
    const int i16 = lane & 15, tq = i16 >> 2, tp = i16 & 3, blk = (lane >> 4) & 1;
    const int vtr_off = (4 * hi + tq) * SB_ROW + (16 * blk + 4 * tp) * 2;
    LAS unsigned* flg = (LAS unsigned*)(lds + 4 * SB_TILE);
    for (int P = vcu; P < 512; P += G) {
        const int bh = P >> 3, jj = P & 7, b = bh >> 4, h = bh & 15;
        for (int half = 0; half < 2; ++half) {
            const int jq = half ? 15 - jj : jj;
            const size_t mb = (size_t)b * SEQ;
            const bf16* kbase = qkv + mb * 3072 + 1024 + h * 64; const bf16* vbase = kbase + 1024;
            const int tq0 = 256 * jq + 32 * wave;
            bf16x8 qf[4];
            { const bf16* qp = qkv + (mb + tq0 + r32) * 3072 + h * 64 + 8 * hi;
#pragma unroll
              for (int d0 = 0; d0 < 4; ++d0) qf[d0] = *(const bf16x8*)(qp + 16 * d0); }
            f32x16 o0, o1;
#pragma unroll
            for (int r = 0; r < 16; ++r) { o0[r] = 0.f; o1[r] = 0.f; }
            float carry = 0.f; bool mydone = false;
            const int nst = 4 * jq + 4;
            { const size_t roff = (size_t)(64 * (nst - 1) + srow) * 3072 + sch * 8;
              const u32x4 kk = *(const u32x4*)(kbase + roff), vv = *(const u32x4*)(vbase + roff);
              *(LAS u32x4*)(lds + srow * SB_ROW + sch * 16) = kk; *(LAS u32x4*)(lds + 2 * SB_TILE + srow * SB_ROW + sch * 16) = vv; }
            __syncthreads();
            for (int st = nst - 1, it = 0; st >= 0; --st, ++it) {
                const int cb = it & 1;
                const LAS unsigned char* Kb = lds + cb * SB_TILE; const LAS unsigned char* Vb = lds + 2 * SB_TILE + cb * SB_TILE;
                u32x4 kk, vv;
                if (st > 0) { const size_t roff = (size_t)(64 * (st - 1) + srow) * 3072 + sch * 8; kk = *(const u32x4*)(kbase + roff); vv = *(const u32x4*)(vbase + roff); }
                if (64 * st < tq0 + 32 && !mydone) {
                    const bool diag = (64 * st + 63 >= tq0);
#pragma unroll
                    for (int sub = 1; sub >= 0; --sub) {
                        f32x16 p;
#pragma unroll
                        for (int r = 0; r < 16; ++r) p[r] = 0.f;
                        const LAS unsigned char* kp = Kb + (32 * sub + r32) * SB_ROW + 16 * hi;
#pragma unroll
                        for (int d0 = 0; d0 < 4; ++d0) p = MFMA32(*(const LAS bf16x8*)(kp + 32 * d0), qf[d0], p);
                        float l[16]; const int sg0 = 64 * st + 32 * sub + 4 * hi, tg = tq0 + r32;
#pragma unroll
                        for (int r = 0; r < 16; ++r) {
                            const float z = p[r]; const float e = __builtin_amdgcn_exp2f(z); float lg = __builtin_amdgcn_logf(1.f + e); lg = z > 32.f ? z : lg;
                            const bool valid = !diag || (sg0 + (r & 3) + 8 * (r >> 2) < tg);
                            l[r] = valid ? -lg : 0.f;
                        }
                        float gs[4], ot[4], ps[4];
#pragma unroll
                        for (int g = 0; g < 4; ++g) { gs[g] = (l[4 * g] + l[4 * g + 1]) + (l[4 * g + 2] + l[4 * g + 3]); ot[g] = __shfl_xor(gs[g], 32); ps[g] = gs[g] + ot[g]; }
                        float T[4]; T[3] = 0.f; T[2] = ps[3]; T[1] = ps[3] + ps[2]; T[0] = T[1] + ps[1];
                        const float total = T[0] + ps[0];
                        float A[16];
#pragma unroll
                        for (int g = 0; g < 4; ++g) {
                            const float base = carry + T[g] + (hi == 0 ? ot[g] : 0.f);
                            const float i3 = base + l[4 * g + 3], i2 = i3 + l[4 * g + 2], i1 = i2 + l[4 * g + 1], i0 = i1 + l[4 * g];
                            A[4 * g + 3] = __builtin_amdgcn_exp2f(p[4 * g + 3] + i3); A[4 * g + 2] = __builtin_amdgcn_exp2f(p[4 * g + 2] + i2);
                            A[4 * g + 1] = __builtin_amdgcn_exp2f(p[4 * g + 1] + i1); A[4 * g] = __builtin_amdgcn_exp2f(p[4 * g] + i0);
                        }
                        if (diag) {
#pragma unroll
                            for (int r = 0; r < 16; ++r) A[r] = (sg0 + (r & 3) + 8 * (r >> 2) < tg) ? A[r] : 0.f;
                        }
                        carry += total;
                        const bf16x8 pf0 = pack8(A), pf1 = pack8(A + 8);
#pragma unroll
                        for (int s = 0; s < 2; ++s) {
                            const LAS unsigned char* vp = Vb + (32 * sub + 16 * s) * SB_ROW + vtr_off;
                            const s16x4 a0 = tr16(vp), a1 = tr16(vp + 8 * SB_ROW), b0 = tr16(vp + 64), b1 = tr16(vp + 64 + 8 * SB_ROW);
                            const bf16x8 vf0 = __builtin_shufflevector(a0, a1, 0, 1, 2, 3, 4, 5, 6, 7), vf1 = __builtin_shufflevector(b0, b1, 0, 1, 2, 3, 4, 5, 6, 7);
                            o0 = MFMA32(vf0, s ? pf1 : pf0, o0); o1 = MFMA32(vf1, s ? pf1 : pf0, o1);
                        }
                    }
                }
                if (64 * st < tq0 + 32) mydone = __all(carry <= -150.f);
                if (lane == 0) flg[(it & 1) * 8 + wave] = mydone ? 1u : 0u;
                if (st > 0) { LAS unsigned char* Kn = lds + (cb ^ 1) * SB_TILE; *(LAS u32x4*)(Kn + srow * SB_ROW + sch * 16) = kk; *(LAS u32x4*)(Kn + 2 * SB_TILE + srow * SB_ROW + sch * 16) = vv; }
                __syncthreads();
                { const u32x4 f0 = *(const LAS u32x4*)(flg + (it & 1) * 8), f1 = *(const LAS u32x4*)(flg + (it & 1) * 8 + 4);
                  if ((f0.x & f0.y & f0.z & f0.w & f1.x & f1.y & f1.z & f1.w) != 0u) break; }
            }
            bf16* op = o + (mb + tq0 + r32) * 1024 + h * 64 + 4 * hi;
#pragma unroll
            for (int g = 0; g < 4; ++g) {
                u32x2 w0, w1; w0.x = cvt_pk_bf16(o0[4 * g], o0[4 * g + 1]); w0.y = cvt_pk_bf16(o0[4 * g + 2], o0[4 * g + 3]);
                w1.x = cvt_pk_bf16(o1[4 * g], o1[4 * g + 1]); w1.y = cvt_pk_bf16(o1[4 * g + 2], o1[4 * g + 3]);
                *(u32x2*)(op + 8 * g) = w0; *(u32x2*)(op + 32 + 8 * g) = w1;
            }
        }
    }
}

__device__ __forceinline__ void swa_phase(const bf16* qkv, const float* sinks, bf16* o, LAS unsigned char* lds, int vcu, int G, int tid) {
    const int lane = tid & 63, wave = __builtin_amdgcn_readfirstlane(tid >> 6), r32 = lane & 31, hi = lane >> 5;
    const int i16 = lane & 15, tq = i16 >> 2, tp = i16 & 3, blk = (lane >> 4) & 1;
    const int vtr_off = (4 * hi + tq) * SB_ROW + (16 * blk + 4 * tp) * 2;
    LAS unsigned char* Kb = lds; LAS unsigned char* Vb = lds + 256 * SB_ROW;
    for (int u = vcu; u < 256; u += G) {
        const int kv = u & 1, n = (u >> 1) & 31, b = u >> 6;
        const int head = kv * 8 + wave;
        const float slope = exp2f(-0.5f * (float)(head + 1)), sink = sinks[head];
        __syncthreads();
#pragma unroll
        for (int c4 = 0; c4 < 4; ++c4) {
            const int idx = tid + NTHREADS * c4, kr = idx >> 3, ch = idx & 7;
            u32x4 kk = (u32x4){0u, 0u, 0u, 0u}, vv = kk;
            if (n > 0 || kr >= 128) { const bf16* p = qkv + ((size_t)b * SEQ + 128 * (n - 1) + kr) * 1280 + 1024 + kv * 64 + ch * 8; kk = *(const u32x4*)p; vv = *(const u32x4*)(p + 128); }
            *(LAS u32x4*)(Kb + kr * SB_ROW + ch * 16) = kk; *(LAS u32x4*)(Vb + kr * SB_ROW + ch * 16) = vv;
        }
        __syncthreads();
        for (int sb = 0; sb < 4; ++sb) {
            const size_t qrow = (size_t)b * SEQ + 128 * n + 32 * sb + r32;
            bf16x8 qf[4];
            { const bf16* qp = qkv + qrow * 1280 + head * 64 + 8 * hi;
#pragma unroll
              for (int d0 = 0; d0 < 4; ++d0) qf[d0] = *(const bf16x8*)(qp + 16 * d0); }
            const int kl = 128 + 32 * sb + r32;
            float lg[5][16]; float mx = sink;
#pragma unroll
            for (int kt = 0; kt < 5; ++kt) {
                f32x16 p;
#pragma unroll
                for (int r = 0; r < 16; ++r) p[r] = 0.f;
                const LAS unsigned char* kp = Kb + (32 * (sb + kt) + r32) * SB_ROW + 16 * hi;
#pragma unroll
                for (int d0 = 0; d0 < 4; ++d0) p = MFMA32(*(const LAS bf16x8*)(kp + 32 * d0), qf[d0], p);
#pragma unroll
                for (int r = 0; r < 16; ++r) {
                    const int kvl = 32 * (sb + kt) + (r & 3) + 8 * (r >> 2) + 4 * hi, dist = kl - kvl;
                    const bool valid = dist >= 0 && dist < 128 && (n > 0 || kvl >= 128);
                    const float v = valid ? p[r] - slope * (float)dist : -1e30f;
                    lg[kt][r] = v; mx = fmaxf(mx, v);
                }
            }
            mx = fmaxf(mx, __shfl_xor(mx, 32));
            float l = 0.f;
            f32x16 o0, o1;
#pragma unroll
            for (int r = 0; r < 16; ++r) { o0[r] = 0.f; o1[r] = 0.f; }
#pragma unroll
            for (int kt = 0; kt < 5; ++kt) {
#pragma unroll
                for (int r = 0; r < 16; ++r) { const float e = __expf(lg[kt][r] - mx); lg[kt][r] = e; l += e; }
                const bf16x8 pf0 = pack8(&lg[kt][0]), pf1 = pack8(&lg[kt][8]);
#pragma unroll
                for (int s = 0; s < 2; ++s) {
                    const LAS unsigned char* vp = Vb + (32 * (sb + kt) + 16 * s) * SB_ROW + vtr_off;
                    const s16x4 a0 = tr16(vp), a1 = tr16(vp + 8 * SB_ROW), b0 = tr16(vp + 64), b1 = tr16(vp + 64 + 8 * SB_ROW);
                    const bf16x8 vf0 = __builtin_shufflevector(a0, a1, 0, 1, 2, 3, 4, 5, 6, 7), vf1 = __builtin_shufflevector(b0, b1, 0, 1, 2, 3, 4, 5, 6, 7);
                    o0 = MFMA32(vf0, s ? pf1 : pf0, o0); o1 = MFMA32(vf1, s ? pf1 : pf0, o1);
                }
            }
            l += __shfl_xor(l, 32);
            const float inv = 1.f / (l + __expf(sink - mx));
            bf16* op = o + qrow * 1024 + head * 64 + 4 * hi;
#pragma unroll
            for (int g = 0; g < 4; ++g) {
                u32x2 w0, w1; w0.x = cvt_pk_bf16(o0[4 * g] * inv, o0[4 * g + 1] * inv); w0.y = cvt_pk_bf16(o0[4 * g + 2] * inv, o0[4 * g + 3] * inv);
                w1.x = cvt_pk_bf16(o1[4 * g] * inv, o1[4 * g + 1] * inv); w1.y = cvt_pk_bf16(o1[4 * g + 2] * inv, o1[4 * g + 3] * inv);
                *(u32x2*)(op + 8 * g) = w0; *(u32x2*)(op + 32 + 8 * g) = w1;
            }
        }
    }
}

__device__ __forceinline__ void ret_scores(bf16* qk, bf16* sc, int vcu, int G, int tid) {
    const int lane = tid & 63, wave = __builtin_amdgcn_readfirstlane(tid >> 6), r32 = lane & 31, hi = lane >> 5;
    const int it = wave >> 1, jh = wave & 1;
    for (int u = vcu; u < 512; u += G) {
        const int bh = u >> 5, n = u & 31, b = bh >> 2, h = bh & 3;
        const float lg = log2f(1.f - exp2f(-5.f - (float)h));
        const size_t row0 = (size_t)b * SEQ + n * 128;
        const bf16* qp = qk + (row0 + 32 * it + r32) * 2048 + h * 256 + 8 * hi;
        bf16x8 qf[16];
#pragma unroll
        for (int ks = 0; ks < 16; ++ks) qf[ks] = *(const bf16x8*)(qp + 16 * ks);
#pragma unroll
        for (int jt2 = 0; jt2 < 2; ++jt2) {
            const int jt = 2 * jh + jt2;
            if (jt <= it) {
                const bf16* kp = qk + (row0 + 32 * jt + r32) * 2048 + 1024 + h * 256 + 8 * hi;
                f32x16 p;
#pragma unroll
                for (int r = 0; r < 16; ++r) p[r] = 0.f;
#pragma unroll
                for (int ks = 0; ks < 16; ++ks) p = MFMA32(*(const bf16x8*)(kp + 16 * ks), qf[ks], p);
                const int i = 32 * it + r32;
                bf16* sp = sc + (size_t)u * 16384 + (size_t)(it * 8 + 2 * jt) * 512 + r32 * 8 + 4 * hi;
#pragma unroll
                for (int g = 0; g < 4; ++g) {
                    float v[4];
#pragma unroll
                    for (int e = 0; e < 4; ++e) { const int j = 32 * jt + 8 * g + 4 * hi + e; v[e] = (i >= j) ? p[4 * g + e] * exp2f((float)(i - j) * lg) : 0.f; }
                    u32x2 w; w.x = cvt_pk_bf16(v[0], v[1]); w.y = cvt_pk_bf16(v[2], v[3]);
                    *(u32x2*)(sp + (g >> 1) * 512 + (g & 1) * 256) = w;
                }
            }
        }
        __syncthreads();
        if (jh == 0) {
            char* qc = (char*)(qk + row0 * 2048 + h * 256) + (size_t)(it * 32 + hi) * 4096 + r32 * 16;
#pragma unroll
            for (int ks = 0; ks < 16; ++ks) *(bf16x8*)(qc + ks * 8192) = qf[ks];
        }
    }
}
constexpr int RT_ST_ROW = 528, RT_V_ROW = 80, RT_K_ROW = 144;
constexpr int RT_OFF_ST = 0, RT_OFF_V = 32 * RT_ST_ROW, RT_OFF_VD = RT_OFF_V + 128 * RT_V_ROW, RT_OFF_K = RT_OFF_VD + 128 * RT_V_ROW, RT_SLAB = 64 * RT_K_ROW;
__device__ __forceinline__ void ret_scan(const bf16* qk, bf16* vo, const bf16* sc, float* ssqo, LAS unsigned char* lds, int vcu, int G, int tid) {
    const int lane = tid & 63, wave = __builtin_amdgcn_readfirstlane(tid >> 6), r32 = lane & 31, hi = lane >> 5;
    const int i16 = lane & 15, tq = i16 >> 2, tp = i16 & 3, blk = (lane >> 4) & 1;
    const int trv = (8 * hi + tq) * RT_V_ROW + (16 * blk + 4 * tp) * 2, trk = (8 * hi + tq) * RT_K_ROW + (16 * blk + 4 * tp) * 2;
    const int vj = tid >> 2, vch = tid & 3;
    const int krj = lane >> 3, kch = lane & 7, uw = wave & 3;
    const bool owave = wave < 4;
    LAS unsigned char* slab = lds + RT_OFF_K + uw * RT_SLAB;
    for (int u = vcu; u < 256; u += G) {
        const int bh = u >> 4, es = u & 15, b = bh >> 2, h = bh & 3, e0 = 32 * es;
        const float lg = log2f(1.f - exp2f(-5.f - (float)h)), cdec = exp2f(128.f * lg);
        const float kd = exp2f((float)(127 - vj) * lg);
        const size_t rowb = (size_t)b * SEQ;
        const int i = 32 * uw + r32;
        const float qd = exp2f((float)(i + 1) * lg);
        f32x16 st0, st1;
#pragma unroll
        for (int r = 0; r < 16; ++r) { st0[r] = 0.f; st1[r] = 0.f; }
        u32x4 kreg[16], vreg; bf16x8 qreg[16], sreg[8];
        unsigned offq = (unsigned)(hi * 4096 + r32 * 16), offs = (unsigned)(lane * 16), offk = (unsigned)(krj * 2048 + 8 * kch) * 2u, offv = (unsigned)(vj * 2048 + 8 * vch) * 2u;
        unsigned offo = (unsigned)(i * 2048 + 4 * hi) * 2u, offsq = (unsigned)(i * 64) * 4u;
        const char* const qbase = (const char*)(qk + rowb * 2048 + h * 256);
        const char* const kbase = (const char*)(qk + rowb * 2048 + 1024 + h * 256 + 64 * uw);
        const char* const sbase = (const char*)(sc + (size_t)(bh * 32) * 16384);
        char* const vbase = (char*)(vo + rowb * 2048 + h * 512 + e0);
        char* const sqbase = (char*)(ssqo + (rowb * 4 + h) * 16 + es);
#define RT_LOAD_K(nn, half) do { const char* kb_ = kbase + (size_t)(128 * (nn) + 64 * (half)) * 4096; _Pragma("unroll") for (int c8 = 0; c8 < 8; ++c8) \
            kreg[8 * (half) + c8] = *(const u32x4*)(kb_ + c8 * 32768 + offk); } while (0)
#define RT_LOAD_QS(nn) do { const char* qb_ = qbase + (size_t)(128 * (nn) + 32 * uw) * 4096; \
            _Pragma("unroll") for (int ks = 0; ks < 16; ++ks) qreg[ks] = *(const bf16x8*)(qb_ + 8192 * ks + offq); \
            const char* sb_ = sbase + (size_t)(nn) * 32768 + uw * 8192; \
            _Pragma("unroll") for (int ks = 0; ks < 8; ++ks) if (ks < 2 * uw + 2) sreg[ks] = *(const bf16x8*)(sb_ + 1024 * ks + offs); } while (0)
#define RT_LOAD_V(nn) do { vreg = *(const u32x4*)(vbase + (size_t)(128 * (nn)) * 4096 + offv); } while (0)
#define RT_WRITE_V() do { *(LAS u32x4*)(lds + RT_OFF_V + vj * RT_V_ROW + vch * 16) = vreg; float f8[8]; UNPACK8(f8, vreg); \
            u32x4 wd; wd.x = cvt_pk_bf16(f8[0] * kd, f8[1] * kd); wd.y = cvt_pk_bf16(f8[2] * kd, f8[3] * kd); wd.z = cvt_pk_bf16(f8[4] * kd, f8[5] * kd); wd.w = cvt_pk_bf16(f8[6] * kd, f8[7] * kd); \
            *(LAS u32x4*)(lds + RT_OFF_VD + vj * RT_V_ROW + vch * 16) = wd; } while (0)
        __syncthreads();
        for (int x = tid * 16; x < 32 * RT_ST_ROW; x += NTHREADS * 16) *(LAS u32x4*)(lds + RT_OFF_ST + x) = (u32x4){0u, 0u, 0u, 0u};
        RT_LOAD_V(0); RT_WRITE_V();
#define RT_BAR() do { asm volatile("s_waitcnt lgkmcnt(0)" ::: "memory"); __builtin_amdgcn_s_barrier(); asm volatile("" ::: "memory"); } while (0)
        if (owave) {
            RT_LOAD_QS(0);
            for (int n = 0; n < 32; ++n) {
                RT_BAR();
                asm volatile("" : "+v"(offq), "+v"(offs), "+v"(offv), "+v"(offo), "+v"(offsq));
                if (n < 31) RT_LOAD_V(n + 1);
                f32x16 oc, oi;
#pragma unroll
                for (int r = 0; r < 16; ++r) { oc[r] = 0.f; oi[r] = 0.f; }
                const LAS unsigned char* sp = lds + RT_OFF_ST + r32 * RT_ST_ROW + 16 * hi;
#pragma unroll
                for (int ks = 0; ks < 16; ++ks) oc = MFMA32(*(const LAS bf16x8*)(sp + 32 * ks), qreg[ks], oc);
#pragma unroll
                for (int ks = 0; ks < 8; ++ks) if (ks < 2 * uw + 2) {
                    const LAS unsigned char* vp = lds + RT_OFF_V + 16 * ks * RT_V_ROW + trv;
                    const s16x4 a0 = tr16(vp), a1 = tr16(vp + 4 * RT_V_ROW);
                    const bf16x8 vf = __builtin_shufflevector(a0, a1, 0, 1, 2, 3, 4, 5, 6, 7);
                    oi = MFMA32(vf, sreg[ks], oi);
                }
                if (n < 31) RT_LOAD_QS(n + 1);
                float s = 0.f;
                char* const op = vbase + (size_t)(128 * n) * 4096 + offo;
#pragma unroll
                for (int g = 0; g < 4; ++g) {
                    float v[4];
#pragma unroll
                    for (int e = 0; e < 4; ++e) { v[e] = oi[4 * g + e] + qd * oc[4 * g + e]; s += v[e] * v[e]; }
                    u32x2 w; w.x = cvt_pk_bf16(v[0], v[1]); w.y = cvt_pk_bf16(v[2], v[3]);
                    *(u32x2*)(op + 16 * g) = w;
                }
                s += __shfl_xor(s, 32);
                if (hi == 0) *(float*)(sqbase + (size_t)(128 * n) * 256 + offsq) = s;
                RT_BAR();
                if (n < 31) RT_WRITE_V();
            }
        } else {
            RT_LOAD_K(0, 0); RT_LOAD_K(0, 1);
            for (int n = 0; n < 32; ++n) {
                RT_BAR();
                asm volatile("" : "+v"(offk), "+v"(offv));
                if (n < 31) RT_LOAD_V(n + 1);
#pragma unroll
                for (int r = 0; r < 16; ++r) { st0[r] *= cdec; st1[r] *= cdec; }
#pragma unroll
                for (int half = 0; half < 2; ++half) {
#pragma unroll
                    for (int c8 = 0; c8 < 8; ++c8) *(LAS u32x4*)(slab + (krj + 8 * c8) * RT_K_ROW + kch * 16) = kreg[8 * half + c8];
                    if (n < 31) { if (half == 0) RT_LOAD_K(n + 1, 0); else RT_LOAD_K(n + 1, 1); }
#pragma unroll
                    for (int ks = 0; ks < 4; ++ks) {
                        const LAS unsigned char* kp = slab + 16 * ks * RT_K_ROW + trk;
                        const LAS unsigned char* vp = lds + RT_OFF_VD + (64 * half + 16 * ks) * RT_V_ROW + trv;
                        const s16x4 v0 = tr16(vp), v1 = tr16(vp + 4 * RT_V_ROW);
                        const s16x4 k0 = tr16(kp), k1 = tr16(kp + 4 * RT_K_ROW), k2 = tr16(kp + 64), k3 = tr16(kp + 64 + 4 * RT_K_ROW);
                        const bf16x8 vf = __builtin_shufflevector(v0, v1, 0, 1, 2, 3, 4, 5, 6, 7);
                        const bf16x8 kf0 = __builtin_shufflevector(k0, k1, 0, 1, 2, 3, 4, 5, 6, 7), kf1 = __builtin_shufflevector(k2, k3, 0, 1, 2, 3, 4, 5, 6, 7);
                        st0 = MFMA32(kf0, vf, st0); st1 = MFMA32(kf1, vf, st1);
                    }
                }
                RT_BAR();
                { LAS unsigned char* wp = lds + RT_OFF_ST + r32 * RT_ST_ROW + (64 * uw + 4 * hi) * 2;
#pragma unroll
                  for (int g = 0; g < 4; ++g) {
                    u32x2 w0, w1; w0.x = cvt_pk_bf16(st0[4 * g], st0[4 * g + 1]); w0.y = cvt_pk_bf16(st0[4 * g + 2], st0[4 * g + 3]);
                    w1.x = cvt_pk_bf16(st1[4 * g], st1[4 * g + 1]); w1.y = cvt_pk_bf16(st1[4 * g + 2], st1[4 * g + 3]);
                    *(LAS u32x2*)(wp + 16 * g) = w0; *(LAS u32x2*)(wp + 64 + 16 * g) = w1;
                  } }
                if (n < 31) RT_WRITE_V();
            }
        }
#undef RT_BAR
#undef RT_LOAD_K
#undef RT_LOAD_QS
#undef RT_LOAD_V
#undef RT_WRITE_V
    }
}

#define XB_TMO      128
#define XB_XCNT(j)  (256  + 64 * (j))
#define XB_XSUB(j)  (1280 + 64 * (j))
#define XB_XGEN(j)  (2304 + 64 * (j))
#define XB_TOP      3328
#define XB_TOPGEN   3392
#define XCD_BAR_WORDS 3456
#define XB_SPIN_CAP (1u << 18)

__device__ __forceinline__ unsigned xb_ld(unsigned* p)              { return __hip_atomic_load(p, __ATOMIC_RELAXED, __HIP_MEMORY_SCOPE_AGENT); }
__device__ __forceinline__ unsigned xb_add(unsigned* p, unsigned v) { return __hip_atomic_fetch_add(p, v, __ATOMIC_RELAXED, __HIP_MEMORY_SCOPE_AGENT); }
__device__ __forceinline__ unsigned xb_xcc_id() { return (unsigned)__builtin_amdgcn_s_getreg((3 << 11) | 20) & 0xFu; }
#define XB_SPIN(cond, bar) do { unsigned _sp = 0; while (cond) { __builtin_amdgcn_s_sleep(1); \
    if ((++_sp & 255u) == 0u) { if (xb_ld(&(bar)[XB_TMO])) break; if (_sp > XB_SPIN_CAP) { atomicAdd(&(bar)[XB_TMO], 1u); break; } } } } while (0)

struct XcdBarrier {
    unsigned* bar; unsigned x;
    volatile LAS unsigned* st;
};

__device__ __forceinline__ XcdBarrier xcd_barrier_post(unsigned* bar, volatile LAS unsigned* st) {
    XcdBarrier b; b.bar = bar; b.x = xb_xcc_id(); b.st = st;
    if (threadIdx.x == 0) (void)xb_add(&bar[XB_XCNT(b.x)], 1u);
    return b;
}
__device__ __forceinline__ void xcd_barrier_complete(unsigned* bar, unsigned x, unsigned& nloc, unsigned& nx) {
    const unsigned G = gridDim.x * gridDim.y * gridDim.z;
    unsigned sum, cnt, mine, sp = 0u;
    for (;;) {
        sum = 0u; cnt = 0u; mine = 0u;
#pragma unroll
        for (unsigned j = 0; j < 16; ++j) { const unsigned c = xb_ld(&bar[XB_XCNT(j)]); sum += c; cnt += (c > 0u) ? 1u : 0u; mine = (j == x) ? c : mine; }
        if (sum == G) break;
        __builtin_amdgcn_s_sleep(1);
        if ((++sp & 255u) == 0u) { if (xb_ld(&bar[XB_TMO])) break; if (sp > XB_SPIN_CAP) { atomicAdd(&bar[XB_TMO], 1u); break; } }
    }
    nloc = mine > 0u ? mine : 1u; nx = cnt > 0u ? cnt : 1u;
}

__device__ __forceinline__ void xcd_barrier(const XcdBarrier& b) {
    asm volatile("s_waitcnt vmcnt(0)" ::: "memory");
    __syncthreads();
    if (threadIdx.x == 0) {
        unsigned* bar = b.bar;
        __builtin_amdgcn_s_waitcnt(0);
        unsigned nloc = b.st[0], nx = b.st[1];
        if (nloc == 0u) { xcd_barrier_complete(bar, b.x, nloc, nx); b.st[0] = nloc; b.st[1] = nx; }
        const unsigned old = xb_add(&bar[XB_XSUB(b.x)], 1u);
        const unsigned gen = old / nloc;
        if (old + 1u == (gen + 1u) * nloc) {
            __builtin_amdgcn_fence(__ATOMIC_RELEASE, "agent");
            asm volatile("s_waitcnt vmcnt(0)" ::: "memory");
            const unsigned og = xb_add(&bar[XB_TOP], 1u);
            const unsigned tg = og / nx;
            if (og + 1u == (tg + 1u) * nx) xb_add(&bar[XB_TOPGEN], 1u);
            else XB_SPIN(xb_ld(&bar[XB_TOPGEN]) == tg, bar);
            __builtin_amdgcn_fence(__ATOMIC_ACQUIRE, "agent");
            xb_add(&bar[XB_XGEN(b.x)], 1u);
            asm volatile("s_waitcnt vmcnt(0)" ::: "memory");
        } else {
            XB_SPIN(xb_ld(&bar[XB_XGEN(b.x)]) == gen, bar);
            __builtin_amdgcn_fence(__ATOMIC_ACQUIRE, "agent");
            asm volatile("s_waitcnt vmcnt(0)" ::: "memory");
        }
    }
    __syncthreads();
}

#define FILL_RS_TABLE(S_, kk_) do { _Pragma("unroll") for (int ui_ = 0; ui_ < 4; ++ui_) { pg8::Unit u_; kk_[ui_] = -1; \
        if (S_.next(ui_, u_)) { kk_[ui_] = u_.pm; if (tl_ < 256) rstab[ui_ * 256 + tl_] = row_rs(ssq, u_.pm * 256 + tl_); } } __syncthreads(); } while (0)
__global__ void __launch_bounds__(NTHREADS, 2) mega(Args a) {
    extern __shared__ __attribute__((aligned(16))) unsigned char lds_raw[];
    LAS unsigned char* lds = (LAS unsigned char*)lds_raw;
    cg::grid_group grid = cg::this_grid();
    const int tid = threadIdx.x, lane0 = tid & 63, wave = __builtin_amdgcn_readfirstlane(tid >> 6);
    const int G = gridDim.x, bx = blockIdx.x;
    const int gw = bx * NWAVES + wave, NGW = G * NWAVES, gthreads = G * NTHREADS;
    const int vcu = (G % 8 == 0) ? (bx % 8) * (G / 8) + bx / 8 : bx;
    unsigned char* ws = a.ws;
    float* ssq = (float*)(ws + WS_SSQ); bf16* hb = (bf16*)(ws + WS_HB);
    unsigned char* R = ws + WS_R;

    volatile LAS unsigned* xb_st = (volatile LAS unsigned*)(lds + 131072 + 64);
    LAS float* rstab = (LAS float*)(lds + 131072 + 256);
    if (tid < 2) xb_st[tid] = 0u;
    unsigned* barw = (unsigned*)(ws + WS_BAR);
    __syncthreads();
    const XcdBarrier xbar = xcd_barrier_post(barw, xb_st);
    convert_layer(a, 0, lds, gw, NGW, wave, lane0);
    for (int m = gw; m < M; m += 2 * NGW) {
        const int lane = lane0; const int m1 = m + NGW; const bool two = m1 < M;
        const f32x4* xr0 = (const f32x4*)(a.in[0] + (size_t)m * D) + lane; const f32x4* xr1 = (const f32x4*)(a.in[0] + (size_t)(two ? m1 : m) * D) + lane;
        f32x4 v0[4], v1[4];
#pragma unroll
        for (int j = 0; j < 4; ++j) { v0[j] = xr0[64 * j]; v1[j] = xr1[64 * j]; }
        float s0 = 0.f, s1 = 0.f;
        unsigned long long* o0 = (unsigned long long*)(hb + (size_t)m * D) + lane; unsigned long long* o1 = (unsigned long long*)(hb + (size_t)m1 * D) + lane;
#pragma unroll
        for (int j = 0; j < 4; ++j) {
            s0 += (v0[j][0] * v0[j][0] + v0[j][1] * v0[j][1]) + (v0[j][2] * v0[j][2] + v0[j][3] * v0[j][3]);
            s1 += (v1[j][0] * v1[j][0] + v1[j][1] * v1[j][1]) + (v1[j][2] * v1[j][2] + v1[j][3] * v1[j][3]);
            o0[64 * j] = (unsigned long long)cvt_pk_bf16(v0[j][0], v0[j][1]) | ((unsigned long long)cvt_pk_bf16(v0[j][2], v0[j][3]) << 32);
            if (two) o1[64 * j] = (unsigned long long)cvt_pk_bf16(v1[j][0], v1[j][1]) | ((unsigned long long)cvt_pk_bf16(v1[j][2], v1[j][3]) << 32);
        }
        s0 = wave_sum(s0); s1 = wave_sum(s1);
        if (lane < 16) { ssq[(size_t)m * 16 + lane] = (lane == 0) ? s0 : 0.f; if (two) ssq[(size_t)m1 * 16 + lane] = (lane == 0) ? s1 : 0.f; }
    }
    if (a.ws == nullptr) grid.sync();
    xcd_barrier(xbar);

    for (int i = 0; i < DEPTH; ++i) {
        const int kind = i % 3, j = i / 3;
        unsigned char* wb = ws + ((i & 1) ? WS_WB1 : WS_WB0);
        int tl_ = threadIdx.x; asm volatile("" : "+v"(tl_));
        const int lane = tl_ & 63, gtid = bx * NTHREADS + tl_;
        {
            const int n_in = kind == 0 ? 1280 : (kind == 1 ? 3072 : 4096);
            pg8::Gemm g{hb, (const bf16*)(wb + WB_IN), M, n_in, D}; pg8::StaticOrder S; S.init(M, n_in, G, bx);
            int kk[4]; FILL_RS_TABLE(S, kk);
            EpiRowScale<0> E{(bf16*)R, kind == 2 ? 2048 : n_in, ssq, kind == 2 ? 2048 : 0, (size_t)(R_V / 2), rstab, kk[0], kk[1], kk[2], kk[3]};
            pg8::gemm_phase<EpiRowScale<0>, pg8::StaticOrder, true, true>(lds, g, S, E);
        }
        xcd_barrier(xbar);
        if (i + 1 < DEPTH) { convert_layer(a, i + 1, lds, gw, NGW, wave, lane); __syncthreads(); }
        if (kind == 0) swa_phase((const bf16*)R, a.in[5] + j * 16, (bf16*)(R + R_O), lds, vcu, G, tl_);
        else if (kind == 1) sb_phase((const bf16*)R, (bf16*)(R + R_O), lds, vcu, G, tl_);
        else {
            ret_scores((bf16*)R, (bf16*)(ws + WS_SC), vcu, G, tl_);
            xcd_barrier(xbar);
            ret_scan((const bf16*)R, (bf16*)(R + R_V), (const bf16*)(ws + WS_SC), (float*)(ws + WS_SSQO), lds, vcu, G, tl_);
            xcd_barrier(xbar);
            pg8::Gemm g{hb, (const bf16*)(wb + WB_IN) + (size_t)4096 * D, M, 2048, D}; pg8::StaticOrder S; S.init(M, 2048, G, bx);
            EpiGate E{(bf16*)R, (const bf16*)(R + R_V), ssq, (const float*)(ws + WS_SSQO)};
            pg8::gemm_phase<EpiGate, pg8::StaticOrder, true, true>(lds, g, S, E);
        }
        xcd_barrier(xbar);
        {
            const int k_o = kind == 2 ? 2048 : 1024;
            pg8::Gemm g{kind == 2 ? (const bf16*)R : (const bf16*)(R + R_O), (const bf16*)(wb + WB_O), M, D, k_o}; pg8::StaticOrder S; S.init(M, D, G, bx);
            if (i == 0) { EpiRes<true> E{a.in[0], hb, ssq}; pg8::gemm_phase<EpiRes<true>, pg8::StaticOrder, true, true>(lds, g, S, E); }
            else { EpiRes<false> E{nullptr, hb, ssq}; pg8::gemm_phase<EpiRes<false>, pg8::StaticOrder, true, true>(lds, g, S, E); }
        }
        xcd_barrier(xbar);
        {
            pg8::Gemm g{hb, (const bf16*)(wb + WB_UP), M, FF, D}; pg8::StaticOrder S; S.init(M, FF, G, bx);
            int kk[4]; FILL_RS_TABLE(S, kk);
            EpiRowScale<1> E{(bf16*)R, FF, ssq, 0, 0, rstab, kk[0], kk[1], kk[2], kk[3]};
            pg8::gemm_phase<EpiRowScale<1>, pg8::StaticOrder, true, true>(lds, g, S, E);
        }
        xcd_barrier(xbar);
        {
            pg8::Gemm g{(const bf16*)R, (const bf16*)(wb + WB_DOWN), M, D, FF}; pg8::StaticOrder S; S.init(M, D, G, bx);
            EpiRes<false> E{nullptr, hb, ssq};
            pg8::gemm_phase<EpiRes<false>, pg8::StaticOrder, true, true>(lds, g, S, E);
        }
        xcd_barrier(xbar);
    }
    for (int m = gw; m < M; m += NGW) {
        const float rs = row_rs(ssq, m); const int lane = lane0;
        const u32x4* hr = (const u32x4*)(hb + (size_t)m * D) + lane; const f32x4* gr = (const f32x4*)a.in[3] + 2 * lane; f32x4* orow = (f32x4*)(a.out + (size_t)m * D) + 2 * lane;
#pragma unroll
        for (int jj = 0; jj < 2; ++jj) { const u32x4 hv = hr[64 * jj]; const f32x4 g0 = gr[128 * jj], g1 = gr[128 * jj + 1];
            const f32x4 v0 = (f32x4){bflo(hv.x), bfhi(hv.x), bflo(hv.y), bfhi(hv.y)}, v1 = (f32x4){bflo(hv.z), bfhi(hv.z), bflo(hv.w), bfhi(hv.w)};
            orow[128 * jj] = v0 * rs * g0; orow[128 * jj + 1] = v1 * rs * g1; }
    }
}

extern "C" void kernel_launch(void* const* d_in, const int* in_sizes, int n_in, void* d_out, int out_size, void* d_ws, size_t ws_size, hipStream_t stream) {
    static int grid = 0;
    if (grid == 0) {
        if (n_in != 13 || out_size != M * D || ws_size < WS_END) { fprintf(stderr, "kernel_launch: unexpected shapes (n_in %d out %d ws %zu)\n", n_in, out_size, ws_size); grid = -1; return; }
        int dev = 0, cus = 0, per_cu = 0;
        hipGetDevice(&dev); hipDeviceGetAttribute(&cus, hipDeviceAttributeMultiprocessorCount, dev);
        hipFuncSetAttribute((const void*)mega, hipFuncAttributeMaxDynamicSharedMemorySize, LDS_BYTES);
        if (hipOccupancyMaxActiveBlocksPerMultiprocessor(&per_cu, (const void*)mega, NTHREADS, LDS_BYTES) != hipSuccess || per_cu < 1) { fprintf(stderr, "kernel_launch: occupancy query gave %d\n", per_cu); per_cu = 1; }
        (void)hipGetLastError();
        grid = cus * per_cu;
        fprintf(stderr, "kernel_launch: grid %d (cus %d x %d)\n", grid, cus, per_cu);
    }
    if (grid < 0) return;
    Args a{};
    for (int i = 0; i < 13; ++i) a.in[i] = (const float*)d_in[i];
    a.out = (float*)d_out; a.ws = (unsigned char*)d_ws;
    if (hipMemsetAsync((char*)d_ws + WS_BAR, 0, XCD_BAR_WORDS * 4, stream) != hipSuccess) { fprintf(stderr, "kernel_launch: memset of the barrier words failed\n"); return; }
    void* args[] = {&a};
    hipError_t e = hipLaunchCooperativeKernel((const void*)mega, dim3(grid), dim3(NTHREADS), args, LDS_BYTES, stream);
    if (e != hipSuccess) fprintf(stderr, "cooperative launch failed: %s (grid %d)\n", hipGetErrorString(e), grid);
}
```

```cpp
#include <hip/hip_runtime.h>
#include <hip/hip_cooperative_groups.h>
#include <cstdio>
#include <cstdint>
namespace cg = cooperative_groups;
namespace pg8 {
#define PG8_LAS __attribute__((address_space(3)))
typedef unsigned short bf16_t;
typedef short bf16x8 __attribute__((ext_vector_type(8)));
typedef float f32x4 __attribute__((ext_vector_type(4)));
typedef unsigned u32x4 __attribute__((ext_vector_type(4)));
constexpr int BM = 256, BK = 64, HALF = 128, HTB = HALF * BK * 2  , STAGE_BYTES = 8 * HTB, NXCD = 8, WGM = 8;

__host__ __device__ __forceinline__ int lds_byte(int r, int c) { const int st = (r >> 4) * 2 + (c >> 5), rr = r & 15, cc = c & 31, ob = rr * 64 + cc * 2; return st * 1024 + (ob ^ (((ob >> 9) & 1) << 5)); }
__host__ __device__ __forceinline__ void stage_rc(int b, int& R, int& C) { const int st = b / 1024, sb = b % 1024, swz = sb ^ (((sb >> 9) & 1) << 5); R = (st >> 1) * 16 + swz / 64; C = (st & 1) * 32 + (swz % 64) / 2; }
__host__ __device__ __forceinline__ int perm32(int rho) { const int n = rho >> 4, i = rho & 15; return 8 * (i >> 2) + 4 * n + (i & 3); }

struct Unit { int pm, pn; };
struct Gemm { const bf16_t* A; const bf16_t* Bt; int M, N, K; };

struct StaticOrder {
    int nM, nN, nwg, G, c;
    __host__ __device__ void init(int M, int N, int G_, int c_) { nM = M / BM; nN = N / BM; nwg = nM * nN; G = G_; c = c_; }
    __host__ __device__ bool next(int i, Unit& u) const {
        const long L = (long)i * G + c; if (L >= nwg) return false;
        int wgid = (int)L; { const int q = nwg / NXCD, r = nwg % NXCD, xcd = wgid % NXCD, off = wgid / NXCD; wgid = (xcd < r ? xcd * (q + 1) : r * (q + 1) + (xcd - r) * q) + off; }
        const int nig = WGM * nN, gid = wgid / nig, fm = gid * WGM, gsz = (nM - fm) < WGM ? (nM - fm) : WGM;
        u.pm = fm + ((wgid % nig) % gsz); u.pn = (wgid % nig) / gsz; return true;
    }
    __device__ __forceinline__ void a_ready(const Unit&) const {}
    __device__ __forceinline__ void done(const Unit&) const {}
};

__device__ __forceinline__ unsigned cvt_pk_bf16(float lo, float hi) { unsigned r; asm volatile("v_cvt_pk_bf16_f32 %0, %1, %2" : "=v"(r) : "v"(lo), "v"(hi)); return r; }
typedef float f32x2 __attribute__((ext_vector_type(2)));
__device__ __forceinline__ f32x2 gelu_pk(f32x2 v) {
    const f32x2 av = __builtin_elementwise_abs(v), d = av * 0.2316418882f + 1.0f;
    f32x2 t; t.x = __builtin_amdgcn_rcpf(d.x); t.y = __builtin_amdgcn_rcpf(d.y);
    f32x2 q = t * 0.5307027145f + (-0.7265760135f); q = q * t + 0.7107068705f; q = q * t + (-0.142248368f); q = q * t + 0.127414796f; q = q * t;
    const f32x2 s = (v * v) * (-0.72134752044f);
    f32x2 e; e.x = __builtin_amdgcn_exp2f(s.x); e.y = __builtin_amdgcn_exp2f(s.y);
    const f32x2 m = v * (q * e), r = v - m;
    f32x2 o; o.x = v.x < 0.f ? m.x : r.x; o.y = v.y < 0.f ? m.y : r.y; return o;
}

template <int ACT  > struct EpiBf16 {
    static constexpr bool PERM = true, AFTER_DRAIN = false; static_assert(ACT == 0 || ACT == 1, "EpiBf16: ACT is 0 (none) or 1 (gelu_pk)");
    bf16_t* O; int ldc; const float* bias; int split_cols; size_t split_stride; float scale0;
    __device__ __forceinline__ void operator()(const f32x4 (&acc)[2][2][4][2], const Unit& u, int wr, int wc, int fr, int fq) const {
        const int row0 = u.pm * BM + wr * 64 + fr; int colt = u.pn * BM; bf16_t* base = O;
        float sc = 1.f; if (split_cols) { const int t = colt / split_cols; base += (size_t)t * split_stride; colt -= t * split_cols; if (t == 0) sc = scale0; }
        const int col0 = colt + wc * 32 + 8 * fq, bcol0 = u.pn * BM + wc * 32 + 8 * fq;
        f32x4 bv[2][2];
#pragma unroll
        for (int bj = 0; bj < 2; ++bj)
#pragma unroll
            for (int n = 0; n < 2; ++n) bv[bj][n] = bias ? *(const f32x4*)(bias + bcol0 + bj * HALF + 4 * n) : (f32x4){0.f, 0.f, 0.f, 0.f};
#pragma unroll
        for (int ai = 0; ai < 2; ++ai)
#pragma unroll
            for (int m = 0; m < 4; ++m) { bf16_t* rowp = base + (size_t)(row0 + ai * HALF + m * 16) * ldc + col0;
#pragma unroll
                for (int bj = 0; bj < 2; ++bj) { f32x4 v0 = acc[ai][bj][m][0] + bv[bj][0], v1 = acc[ai][bj][m][1] + bv[bj][1];
                    if (ACT == 1) { f32x2 a = gelu_pk((f32x2){v0[0], v0[1]}), b = gelu_pk((f32x2){v0[2], v0[3]}), c = gelu_pk((f32x2){v1[0], v1[1]}), d = gelu_pk((f32x2){v1[2], v1[3]});
                        v0 = (f32x4){a.x, a.y, b.x, b.y}; v1 = (f32x4){c.x, c.y, d.x, d.y}; }
                    v0 = v0 * sc; v1 = v1 * sc; u32x4 w; w.x = cvt_pk_bf16(v0[0], v0[1]); w.y = cvt_pk_bf16(v0[2], v0[3]); w.z = cvt_pk_bf16(v1[0], v1[1]); w.w = cvt_pk_bf16(v1[2], v1[3]);
                    *(u32x4*)(rowp + bj * HALF) = w; } }
    }
};

template <class Epi, class Sched, bool ALIGN_EPI = false, bool SP2 = false>
__device__ __forceinline__ void gemm_phase(PG8_LAS unsigned char* lds, const Gemm g, const Sched& S, const Epi& E) {
    int tid_ = threadIdx.x; asm volatile("" : "+v"(tid_));
    const int tid = tid_, wid = __builtin_amdgcn_readfirstlane(tid >> 6), lane = tid & 63, wr = wid >> 2, wc = wid & 3, fr = lane & 15, fq = lane >> 4;
    const int K = g.K, nt = K / BK;
    unsigned voffA[2], voffB[2];
#pragma unroll
    for (int i = 0; i < 2; ++i) { int R, C; stage_rc(tid * 16 + i * 8192, R, C); const int Rb = Epi::PERM ? ((R & ~31) + perm32(R & 31)) : R;
        voffA[i] = (unsigned)(R * K + C) * 2u; voffB[i] = (unsigned)(Rb * K + C) * 2u; }
    const size_t kstep = (size_t)(BK * 2);
    const size_t hstep = (size_t)HALF * K * 2;
    const size_t tstep = 2 * hstep;
    const unsigned ldsw = (unsigned)wid * 1024u;
    const int aoff = lds_byte(wr * 64 + fr, fq * 8), boff = lds_byte(wc * 32 + fr, fq * 8);
#define PG8_SA(b, h) (((b) * 2 + (h)) * HTB)
#define PG8_SB(b, h) ((4 + (b) * 2 + (h)) * HTB)
#define PG8_STAGE(bufoff, gbase, voff) do { _Pragma("unroll") for (int _i = 0; _i < 2; ++_i) \
        __builtin_amdgcn_global_load_lds((const unsigned*)((const char*)(gbase) + (voff)[_i]), (PG8_LAS unsigned*)(lds + (bufoff) + ldsw + _i * 8192), 16, 0, 0); } while (0)
#define PG8_LDA(dst, b, h) do { _Pragma("unroll") for (int m = 0; m < 4; ++m) _Pragma("unroll") for (int k = 0; k < 2; ++k) dst[m][k] = *(const PG8_LAS bf16x8*)(lds + PG8_SA(b, h) + aoff + m * 2048 + k * 1024); } while (0)
#define PG8_LDB(dst, b, h) do { _Pragma("unroll") for (int n = 0; n < 2; ++n) _Pragma("unroll") for (int k = 0; k < 2; ++k) dst[n][k] = *(const PG8_LAS bf16x8*)(lds + PG8_SB(b, h) + boff + n * 2048 + k * 1024); } while (0)
#define PG8_MMA(ai, bj, At, Bt) do { __builtin_amdgcn_s_setprio(1); _Pragma("unroll") for (int m = 0; m < 4; ++m) _Pragma("unroll") for (int n = 0; n < 2; ++n) _Pragma("unroll") for (int k = 0; k < 2; ++k) \
        acc[ai][bj][m][n] = __builtin_amdgcn_mfma_f32_16x16x32_bf16(Bt[n][k], At[m][k], acc[ai][bj][m][n], 0, 0, 0); __builtin_amdgcn_s_setprio(0); } while (0)
#define PG8_WAIT_V(n) asm volatile("s_waitcnt vmcnt(" #n ")" ::: "memory")
#define PG8_WAIT_L(n) asm volatile("s_waitcnt lgkmcnt(" #n ")" ::: "memory")
#define PG8_BAR __builtin_amdgcn_s_barrier()
#define PG8_SCHED __builtin_amdgcn_sched_barrier(0)
    Unit cur, nxt; int ui = 0;
    if (!S.next(0, cur)) return;
    f32x4 acc[2][2][4][2];
#pragma unroll
    for (int a = 0; a < 2; ++a)
#pragma unroll
        for (int b = 0; b < 2; ++b)
#pragma unroll
            for (int m = 0; m < 4; ++m)
#pragma unroll
                for (int n = 0; n < 2; ++n) acc[a][b][m][n] = (f32x4){0.f, 0.f, 0.f, 0.f};
    bf16x8 At[4][2], B0[2][2], B1[2][2];
    const char* cA = (const char*)g.A + (size_t)cur.pm * tstep; const char* cB = (const char*)g.Bt + (size_t)cur.pn * tstep;
    S.a_ready(cur);
    if constexpr (SP2) {
        PG8_STAGE(PG8_SB(0, 0), cB, voffB); PG8_STAGE(PG8_SB(0, 1), cB + hstep, voffB); PG8_STAGE(PG8_SA(0, 0), cA, voffA); PG8_STAGE(PG8_SA(0, 1), cA + hstep, voffA);
        if (wr == 1) PG8_BAR;
        PG8_WAIT_V(2); PG8_BAR;
        PG8_STAGE(PG8_SB(1, 0), cB + kstep, voffB); PG8_STAGE(PG8_SA(1, 0), cA + kstep, voffA); PG8_STAGE(PG8_SB(1, 1), cB + hstep + kstep, voffB);
        PG8_WAIT_V(6); PG8_BAR;
    } else {
        PG8_STAGE(PG8_SB(0, 0), cB, voffB); PG8_STAGE(PG8_SA(0, 0), cA, voffA); PG8_STAGE(PG8_SB(0, 1), cB + hstep, voffB); PG8_STAGE(PG8_SA(0, 1), cA + hstep, voffA);
        if (wr == 1) PG8_BAR;
        PG8_WAIT_V(4); PG8_BAR;
        PG8_STAGE(PG8_SB(1, 0), cB + kstep, voffB); PG8_STAGE(PG8_SA(1, 0), cA + kstep, voffA); PG8_STAGE(PG8_SB(1, 1), cB + hstep + kstep, voffB);
        PG8_WAIT_V(6); PG8_BAR;
    }
    for (;;) {
        const bool has_next = S.next(ui + 1, nxt);
        const char* nA = has_next ? (const char*)g.A + (size_t)nxt.pm * tstep : cA; const char* nB = has_next ? (const char*)g.Bt + (size_t)nxt.pn * tstep : cB;
        for (int t = 0; t < nt; t += 2) {
            const bool last = (t == nt - 2);
            const char* a1 = cA + (size_t)(t + 1) * kstep;
            const char* a2 = last ? nA : cA + (size_t)(t + 2) * kstep; const char* b2 = last ? nB : cB + (size_t)(t + 2) * kstep;
            const char* a3 = a2 + kstep; const char* b3 = b2 + kstep;
            if (last && has_next) S.a_ready(nxt);
            if constexpr (SP2) {
            PG8_LDB(B0, 0, 0); PG8_LDB(B1, 0, 1); PG8_SCHED; PG8_LDA(At, 0, 0); PG8_STAGE(PG8_SA(1, 1), a1 + hstep, voffA);
            PG8_WAIT_V(8); PG8_WAIT_L(0); PG8_BAR; PG8_MMA(0, 0, At, B0); PG8_MMA(0, 1, At, B1); PG8_BAR; PG8_SCHED;
            PG8_LDA(At, 0, 1); PG8_STAGE(PG8_SB(0, 0), b2, voffB); PG8_STAGE(PG8_SB(0, 1), b2 + hstep, voffB); PG8_STAGE(PG8_SA(0, 0), a2, voffA);
            PG8_WAIT_V(8); PG8_WAIT_L(0); PG8_BAR; PG8_MMA(1, 0, At, B0); PG8_MMA(1, 1, At, B1); PG8_BAR; PG8_SCHED;
            PG8_LDB(B0, 1, 0); PG8_LDB(B1, 1, 1); PG8_SCHED; PG8_LDA(At, 1, 0); PG8_STAGE(PG8_SA(0, 1), a2 + hstep, voffA);
            PG8_WAIT_V(8); PG8_WAIT_L(0); PG8_BAR; PG8_MMA(0, 0, At, B0); PG8_MMA(0, 1, At, B1); PG8_BAR; PG8_SCHED;
            PG8_LDA(At, 1, 1); PG8_STAGE(PG8_SB(1, 0), b3, voffB); PG8_STAGE(PG8_SB(1, 1), b3 + hstep, voffB); PG8_STAGE(PG8_SA(1, 0), a3, voffA);
            PG8_WAIT_V(8); PG8_WAIT_L(0); PG8_BAR; PG8_MMA(1, 0, At, B0); PG8_MMA(1, 1, At, B1); PG8_BAR; PG8_SCHED;
            } else {
            PG8_LDB(B0, 0, 0); PG8_SCHED; PG8_LDA(At, 0, 0); PG8_STAGE(PG8_SA(1, 1), a1 + hstep, voffA);
            PG8_WAIT_L(8); PG8_BAR; PG8_WAIT_L(0); PG8_MMA(0, 0, At, B0); PG8_BAR; PG8_SCHED;
            PG8_LDB(B1, 0, 1); PG8_STAGE(PG8_SB(0, 0), b2, voffB);
            PG8_BAR; PG8_WAIT_L(0); PG8_MMA(0, 1, At, B1); PG8_BAR;
            PG8_LDA(At, 0, 1); PG8_STAGE(PG8_SA(0, 0), a2, voffA);
            PG8_BAR; PG8_WAIT_L(0); PG8_MMA(1, 0, At, B0); PG8_BAR; PG8_SCHED;
            PG8_STAGE(PG8_SB(0, 1), b2 + hstep, voffB);
            PG8_WAIT_V(6); PG8_BAR; PG8_MMA(1, 1, At, B1); PG8_BAR;
            PG8_LDB(B0, 1, 0); PG8_SCHED; PG8_LDA(At, 1, 0); PG8_STAGE(PG8_SA(0, 1), a2 + hstep, voffA);
            PG8_WAIT_L(8); PG8_BAR; PG8_WAIT_L(0); PG8_MMA(0, 0, At, B0); PG8_BAR; PG8_SCHED;
            PG8_LDB(B1, 1, 1); PG8_STAGE(PG8_SB(1, 0), b3, voffB);
            PG8_BAR; PG8_WAIT_L(0); PG8_MMA(0, 1, At, B1); PG8_BAR;
            PG8_LDA(At, 1, 1); PG8_STAGE(PG8_SA(1, 0), a3, voffA);
            PG8_BAR; PG8_WAIT_L(0); PG8_MMA(1, 0, At, B0); PG8_BAR; PG8_SCHED;
            PG8_STAGE(PG8_SB(1, 1), b3 + hstep, voffB);
            PG8_WAIT_V(6); PG8_BAR; PG8_MMA(1, 1, At, B1); PG8_BAR;
            }
        }
        if constexpr (ALIGN_EPI) { if (wr == 0) PG8_BAR; }
        if constexpr (!Epi::AFTER_DRAIN) { E(acc, cur, wr, wc, fr, fq); S.done(cur); }
        if (!has_next) break;
#pragma unroll
        for (int a = 0; a < 2; ++a)
#pragma unroll
            for (int b = 0; b < 2; ++b)
#pragma unroll
                for (int m = 0; m < 4; ++m)
#pragma unroll
                    for (int n = 0; n < 2; ++n) acc[a][b][m][n] = (f32x4){0.f, 0.f, 0.f, 0.f};
        cur = nxt; cA = nA; cB = nB; ++ui;
        if constexpr (ALIGN_EPI) { if (wr == 1) PG8_BAR; }
    }
    PG8_WAIT_V(0);
    if constexpr (!ALIGN_EPI) { if (wr == 0) PG8_BAR; }
    PG8_BAR;
    if constexpr (Epi::AFTER_DRAIN) { E.fused(acc, cur, wr, wc, fr, fq, lds, wid, lane); S.done(cur); }
#undef PG8_SA
#undef PG8_SB
#undef PG8_STAGE
#undef PG8_LDA
#undef PG8_LDB
#undef PG8_MMA
#undef PG8_WAIT_V
#undef PG8_WAIT_L
#undef PG8_BAR
#undef PG8_SCHED
}
}

#define LAS __attribute__((address_space(3)))
typedef unsigned short bf16;
typedef pg8::f32x4 f32x4;
typedef pg8::u32x4 u32x4;
typedef unsigned u32x2 __attribute__((ext_vector_type(2)));
typedef float f32x2_t __attribute__((ext_vector_type(2))); typedef __bf16 bf16x2_t __attribute__((ext_vector_type(2)));
__device__ __forceinline__ unsigned cvt_pk_bf16(float lo, float hi) { f32x2_t v = {lo, hi}; bf16x2_t r = __builtin_convertvector(v, bf16x2_t); return __builtin_bit_cast(unsigned, r); }
constexpr int D = 1024, BATCH = 4, SEQ = 4096, M = BATCH * SEQ, FF = 4096, DEPTH = 4;
constexpr int NWAVES = 8, NTHREADS = 512;
constexpr float RMS_EPS = 1e-6f;
constexpr size_t MiB = 1u << 20;
constexpr size_t WS_SSQ = 0;
constexpr size_t WS_BAR = 1 * MiB;
constexpr size_t WS_HB = 2 * MiB;
constexpr size_t WS_WB0 = 34 * MiB, WS_WB1 = 66 * MiB;
constexpr size_t WS_R = 98 * MiB;
constexpr size_t WS_SC = 226 * MiB;
constexpr size_t WS_SSQO = 242 * MiB;
constexpr size_t WS_END = 246 * MiB;
constexpr size_t WB_IN = 0, WB_O = 12 * MiB, WB_UP = 16 * MiB, WB_DOWN = 24 * MiB;
constexpr size_t R_O = 96 * MiB;
constexpr size_t R_V = 64 * MiB;
constexpr int LDS_BYTES = 147456;

__device__ __forceinline__ float bflo(unsigned u) { return __uint_as_float(u << 16); }
__device__ __forceinline__ float bfhi(unsigned u) { return __uint_as_float(u & 0xffff0000u); }
__device__ __forceinline__ float wave_sum(float v) {
#pragma unroll
    for (int o = 1; o < 64; o <<= 1) v += __shfl_xor(v, o);
    return v;
}
__device__ __forceinline__ float row_rs(const float* ssq, int row) {
    const f32x4* p = (const f32x4*)(ssq + (size_t)row * 16);
    const f32x4 a = p[0], b = p[1], c = p[2], d = p[3];
    const float s = (((a[0] + a[1]) + (a[2] + a[3])) + ((b[0] + b[1]) + (b[2] + b[3]))) + (((c[0] + c[1]) + (c[2] + c[3])) + ((d[0] + d[1]) + (d[2] + d[3])));
    return rsqrtf(s * (1.f / 1024.f) + RMS_EPS);
}

template <int ACT> struct EpiRowScale {
    static constexpr bool PERM = true, AFTER_DRAIN = false;
    bf16* O; int ldc; const float* ssq; int split_cols; size_t split_stride;
    const LAS float* tab; int k0, k1, k2, k3;
    __device__ __forceinline__ void operator()(const f32x4 (&acc)[2][2][4][2], const pg8::Unit& u, int wr, int wc, int fr, int fq) const {
        const int row0 = u.pm * 256 + wr * 64 + fr; int colt = u.pn * 256; bf16* base = O;
        if (split_cols) { const int t = colt / split_cols; base += (size_t)t * split_stride; colt -= t * split_cols; }
        const int col0 = colt + wc * 32 + 8 * fq;
        const int slot = (u.pm == k0) ? 0 : (u.pm == k1) ? 1 : (u.pm == k2) ? 2 : (u.pm == k3) ? 3 : -1;
#pragma unroll
        for (int ai = 0; ai < 2; ++ai)
#pragma unroll
            for (int m = 0; m < 4; ++m) {
                const int row = row0 + ai * 128 + m * 16; const float rs = slot >= 0 ? tab[slot * 256 + wr * 64 + fr + ai * 128 + m * 16] : row_rs(ssq, row);
                bf16* rowp = base + (size_t)row * ldc + col0;
#pragma unroll
                for (int bj = 0; bj < 2; ++bj) {
                    f32x4 v0 = acc[ai][bj][m][0] * rs, v1 = acc[ai][bj][m][1] * rs;
                    if (ACT == 1) {
#pragma unroll
                        for (int e = 0; e < 4; ++e) { float a = fmaxf(v0[e], 0.f), b = fmaxf(v1[e], 0.f); v0[e] = a * a; v1[e] = b * b; }
                    }
                    u32x4 w; w.x = cvt_pk_bf16(v0[0], v0[1]); w.y = cvt_pk_bf16(v0[2], v0[3]); w.z = cvt_pk_bf16(v1[0], v1[1]); w.w = cvt_pk_bf16(v1[2], v1[3]);
                    *(u32x4*)(rowp + bj * 128) = w;
                }
            }
    }
};
template <bool BASE_F32> struct EpiRes {
    static constexpr bool PERM = true, AFTER_DRAIN = false;
    const float* xbase; bf16* hb; float* ssq;
    __device__ __forceinline__ void operator()(const f32x4 (&acc)[2][2][4][2], const pg8::Unit& u, int wr, int wc, int fr, int fq) const {
        const int col0 = u.pn * 256 + wc * 32 + 8 * fq;
#pragma unroll
        for (int ai = 0; ai < 2; ++ai)
#pragma unroll
            for (int m = 0; m < 4; ++m) {
                const int row = u.pm * 256 + ai * 128 + wr * 64 + m * 16 + fr; const size_t off = (size_t)row * D + col0; float s = 0.f;
#pragma unroll
                for (int bj = 0; bj < 2; ++bj) {
                    const size_t o = off + bj * 128;
                    f32x4 v0, v1;
                    if (BASE_F32) { v0 = *(const f32x4*)(xbase + o); v1 = *(const f32x4*)(xbase + o + 4); }
                    else { const u32x4 hv = *(const u32x4*)(hb + o); v0 = (f32x4){bflo(hv.x), bfhi(hv.x), bflo(hv.y), bfhi(hv.y)}; v1 = (f32x4){bflo(hv.z), bfhi(hv.z), bflo(hv.w), bfhi(hv.w)}; }
                    v0 = v0 + acc[ai][bj][m][0]; v1 = v1 + acc[ai][bj][m][1];
                    s += ((v0[0] * v0[0] + v0[1] * v0[1]) + (v0[2] * v0[2] + v0[3] * v0[3])) + ((v1[0] * v1[0] + v1[1] * v1[1]) + (v1[2] * v1[2] + v1[3] * v1[3]));
                    u32x4 w; w.x = cvt_pk_bf16(v0[0], v0[1]); w.y = cvt_pk_bf16(v0[2], v0[3]); w.z = cvt_pk_bf16(v1[0], v1[1]); w.w = cvt_pk_bf16(v1[2], v1[3]);
                    *(u32x4*)(hb + o) = w;
                }
                s += __shfl_xor(s, 16); s += __shfl_xor(s, 32);
                if (fq == 0) ssq[(size_t)row * 16 + u.pn * 4 + wc] = s;
            }
    }
};
struct EpiGate {
    static constexpr bool PERM = true, AFTER_DRAIN = false;
    bf16* Y; const bf16* Oin; const float* ssq; const float* rmso;
    __device__ __forceinline__ void operator()(const f32x4 (&acc)[2][2][4][2], const pg8::Unit& u, int wr, int wc, int fr, int fq) const {
        const int row0 = u.pm * 256 + wr * 64 + fr; const int col0 = u.pn * 256 + wc * 32 + 8 * fq;
#pragma unroll
        for (int ai = 0; ai < 2; ++ai)
#pragma unroll
            for (int m = 0; m < 4; ++m) {
                const int row = row0 + ai * 128 + m * 16; const float rs = row_rs(ssq, row);
                float ro; { const f32x4* p = (const f32x4*)(rmso + ((size_t)row * 4 + (u.pn >> 1)) * 16); const f32x4 a = p[0], b = p[1], c = p[2], d = p[3];
                    const float s = (((a[0] + a[1]) + (a[2] + a[3])) + ((b[0] + b[1]) + (b[2] + b[3]))) + (((c[0] + c[1]) + (c[2] + c[3])) + ((d[0] + d[1]) + (d[2] + d[3]))); ro = rsqrtf(s * (1.f / 512.f) + RMS_EPS); }
#pragma unroll
                for (int bj = 0; bj < 2; ++bj) {
                    const int c = col0 + bj * 128;
                    const u32x4 ov = *(const u32x4*)(Oin + (size_t)row * 2048 + c);
                    float o8[8] = {bflo(ov.x), bfhi(ov.x), bflo(ov.y), bfhi(ov.y), bflo(ov.z), bfhi(ov.z), bflo(ov.w), bfhi(ov.w)};
                    float y8[8];
#pragma unroll
                    for (int e = 0; e < 8; ++e) { const float g = (e < 4 ? acc[ai][bj][m][0][e & 3] : acc[ai][bj][m][1][e & 3]) * rs; const float sg = g / (1.f + __expf(-g)); y8[e] = sg * o8[e] * ro; }
                    u32x4 w; w.x = cvt_pk_bf16(y8[0], y8[1]); w.y = cvt_pk_bf16(y8[2], y8[3]); w.z = cvt_pk_bf16(y8[4], y8[5]); w.w = cvt_pk_bf16(y8[6], y8[7]);
                    *(u32x4*)(Y + (size_t)row * 2048 + c) = w;
                }
            }
    }
};

struct Args { const float* in[13]; float* out; unsigned char* ws; };

struct CvItem { const float* src; bf16* dst; const float* gain; float cs; int N, K; };
__device__ __forceinline__ void cv_load(const CvItem& d, float (&r)[32]) {
#pragma unroll
    for (int i = 0; i < 32; ++i) r[i] = __builtin_nontemporal_load(d.src + (size_t)(2 * i) * d.N);
}
__device__ __forceinline__ void cv_store(const CvItem& d, const float (&r)[32], LAS float* scr, int lane) {
#pragma unroll
    for (int i = 0; i < 32; ++i) scr[(2 * i + (lane >> 5)) * 33 + (lane & 31)] = r[i] * d.cs;
    asm volatile("s_waitcnt lgkmcnt(0)" ::: "memory");
    const int c = lane & 7;
    f32x4 g0 = (f32x4){1.f, 1.f, 1.f, 1.f}, g1 = g0;
    if (d.gain) { g0 = *(const f32x4*)(d.gain + 8 * c); g1 = *(const f32x4*)(d.gain + 8 * c + 4); }
#pragma unroll
    for (int j = 0; j < 4; ++j) { const int nn = (lane >> 3) + 8 * j; const LAS float* s = scr + (8 * c) * 33 + nn;
        u32x4 o; o.x = cvt_pk_bf16(s[0 * 33] * g0[0], s[1 * 33] * g0[1]); o.y = cvt_pk_bf16(s[2 * 33] * g0[2], s[3 * 33] * g0[3]);
        o.z = cvt_pk_bf16(s[4 * 33] * g1[0], s[5 * 33] * g1[1]); o.w = cvt_pk_bf16(s[6 * 33] * g1[2], s[7 * 33] * g1[3]);
        *(u32x4*)(d.dst + (size_t)nn * d.K + 8 * c) = o; }
    asm volatile("s_waitcnt lgkmcnt(0)" ::: "memory");
}
__device__ __forceinline__ void convert_layer(const Args& a, int i, LAS unsigned char* lds, int gw, int NGW, int wave, int lane) {
    const int kind = i % 3, j = i / 3;
    const float* w_in; int n_in; const float* w_o; int k_o; int sc_lo, sc_hi; float sc;
    if (kind == 0) { w_in = a.in[4] + (size_t)j * D * 1280; n_in = 1280; w_o = a.in[6] + (size_t)j * D * D; k_o = 1024; sc_lo = 0; sc_hi = 1024; sc = 0.125f; }
    else if (kind == 1) { w_in = a.in[7] + (size_t)j * D * 3072; n_in = 3072; w_o = a.in[8] + (size_t)j * D * D; k_o = 1024; sc_lo = 0; sc_hi = 1024; sc = 0.125f * 1.4426950408889634f; }
    else { w_in = a.in[9] + (size_t)j * D * 6144; n_in = 6144; w_o = a.in[10] + (size_t)j * 2048 * D; k_o = 2048; sc_lo = 1024; sc_hi = 2048; sc = 0.0625f; }
    const float* w_up = a.in[11] + (size_t)i * D * FF; const float* w_dn = a.in[12] + (size_t)i * FF * D;
    const float* g_attn = a.in[1] + (size_t)i * D; const float* g_mlp = a.in[2] + (size_t)i * D;
    unsigned char* wb = a.ws + ((i & 1) ? WS_WB1 : WS_WB0);
    LAS float* scr = (LAS float*)(lds + wave * 16384);
    const int I_in = (D / 64) * (n_in / 32), I_o = (k_o / 64) * (D / 32), I_up = (D / 64) * (FF / 32), I_dn = (FF / 64) * (D / 32);
    const int NITEMS = I_in + I_o + I_up + I_dn;
#define CV_DECODE(dsc, itv) do { int r_ = (itv); const float* W_; int K_, N_; bf16* WT_; const float* gn_; int lo_ = 0, hi_ = 0; \
        if (r_ < I_in) { W_ = w_in; K_ = D; N_ = n_in; WT_ = (bf16*)(wb + WB_IN); gn_ = g_attn; lo_ = sc_lo; hi_ = sc_hi; } \
        else if ((r_ -= I_in) < I_o) { W_ = w_o; K_ = k_o; N_ = D; WT_ = (bf16*)(wb + WB_O); gn_ = nullptr; } \
        else if ((r_ -= I_o) < I_up) { W_ = w_up; K_ = D; N_ = FF; WT_ = (bf16*)(wb + WB_UP); gn_ = g_mlp; } \
        else { r_ -= I_up; W_ = w_dn; K_ = FF; N_ = D; WT_ = (bf16*)(wb + WB_DOWN); gn_ = nullptr; } \
        const int nblk_ = N_ / 32, kb_ = r_ / nblk_, nb_ = r_ % nblk_, k0_ = 64 * kb_, n0_ = 32 * nb_, n_ = n0_ + (lane & 31); \
        (dsc).src = W_ + (size_t)(k0_ + (lane >> 5)) * N_ + n_; (dsc).dst = WT_ + (size_t)n0_ * K_ + k0_; (dsc).gain = gn_ ? gn_ + k0_ : nullptr; \
        (dsc).cs = (n_ >= lo_ && n_ < hi_) ? sc : 1.f; (dsc).N = N_; (dsc).K = K_; } while (0)
    for (int it = gw; it < NITEMS; it += 2 * NGW) {
        CvItem d0, d1; float r0[32], r1[32];
        CV_DECODE(d0, it); cv_load(d0, r0);
        const bool two = it + NGW < NITEMS;
        if (two) { CV_DECODE(d1, it + NGW); cv_load(d1, r1); }
        cv_store(d0, r0, scr, lane);
        if (two) cv_store(d1, r1, scr, lane);
    }
#undef CV_DECODE
}

#define UNPACK8(dst, vv_) do { (dst)[0] = bflo((vv_)[0]); (dst)[1] = bfhi((vv_)[0]); (dst)[2] = bflo((vv_)[1]); (dst)[3] = bfhi((vv_)[1]); (dst)[4] = bflo((vv_)[2]); (dst)[5] = bfhi((vv_)[2]); (dst)[6] = bflo((vv_)[3]); (dst)[7] = bfhi((vv_)[3]); } while (0)
__device__ __forceinline__ void swa_naive(const bf16* qkv, const float* sinks, bf16* o, int gtid, int gthreads) {
    for (int idx = gtid; idx < M * 16; idx += gthreads) {
        const int head = idx & 15, m = idx >> 4, t = m & (SEQ - 1), kv = head >> 3;
        float q[64], acc[64];
        { const u32x4* qp = (const u32x4*)(qkv + (size_t)m * 1280 + head * 64);
#pragma unroll
          for (int c = 0; c < 8; ++c) { const u32x4 w = qp[c]; UNPACK8(q + 8 * c, w); } }
#pragma unroll
        for (int d = 0; d < 64; ++d) acc[d] = 0.f;
        const float slope = exp2f(-0.5f * (float)(head + 1));
        float mr = sinks[head], l = 1.f;
        const int s0 = t - 127 < 0 ? 0 : t - 127;
        for (int s = s0; s <= t; ++s) {
            const bf16* kp = qkv + (size_t)(m - (t - s)) * 1280 + 1024 + kv * 64; const bf16* vp = kp + 128;
            float z = 0.f;
#pragma unroll
            for (int c = 0; c < 8; ++c) { const u32x4 w = ((const u32x4*)kp)[c]; float k8[8]; UNPACK8(k8, w);
#pragma unroll
                for (int e = 0; e < 8; ++e) z += q[8 * c + e] * k8[e]; }
            z -= slope * (float)(t - s);
            const float mn = fmaxf(mr, z), corr = __expf(mr - mn), p = __expf(z - mn);
            l = l * corr + p; mr = mn;
#pragma unroll
            for (int c = 0; c < 8; ++c) { const u32x4 w = ((const u32x4*)vp)[c]; float v8[8]; UNPACK8(v8, w);
#pragma unroll
                for (int e = 0; e < 8; ++e) acc[8 * c + e] = acc[8 * c + e] * corr + p * v8[e]; }
        }
        const float inv = 1.f / l;
        u32x4* op = (u32x4*)(o + (size_t)m * 1024 + head * 64);
#pragma unroll
        for (int c = 0; c < 8; ++c) { u32x4 w; w.x = cvt_pk_bf16(acc[8 * c] * inv, acc[8 * c + 1] * inv); w.y = cvt_pk_bf16(acc[8 * c + 2] * inv, acc[8 * c + 3] * inv);
            w.z = cvt_pk_bf16(acc[8 * c + 4] * inv, acc[8 * c + 5] * inv); w.w = cvt_pk_bf16(acc[8 * c + 6] * inv, acc[8 * c + 7] * inv); op[c] = w; }
    }
}
__device__ __forceinline__ void sb_naive(const bf16* qkv, bf16* o, int gtid, int gthreads) {
    int it = 0; const bool mir = (gthreads % (SEQ * 16)) == 0;
    for (int idx = gtid; idx < M * 16; idx += gthreads, ++it) {
        const int head = idx & 15; int m = idx >> 4; int t = m & (SEQ - 1);
        if (mir && (it & 1)) { t = SEQ - 1 - t; m = (m & ~(SEQ - 1)) + t; }
        float q[64], acc[64];
        { const u32x4* qp = (const u32x4*)(qkv + (size_t)m * 3072 + head * 64);
#pragma unroll
          for (int c = 0; c < 8; ++c) { const u32x4 w = qp[c]; UNPACK8(q + 8 * c, w); } }
#pragma unroll
        for (int d = 0; d < 64; ++d) acc[d] = 0.f;
        float carry = 0.f;
        for (int s = t - 1; s >= 0; --s) {
            const bf16* kp = qkv + (size_t)(m - (t - s)) * 3072 + 1024 + head * 64; const bf16* vp = kp + 1024;
            float z = 0.f;
#pragma unroll
            for (int c = 0; c < 8; ++c) { const u32x4 w = ((const u32x4*)kp)[c]; float k8[8]; UNPACK8(k8, w);
#pragma unroll
                for (int e = 0; e < 8; ++e) z += q[8 * c + e] * k8[e]; }
            const float sp = fmaxf(z, 0.f) + __logf(1.f + __expf(-fabsf(z)));
            const float p = __expf(z - sp + carry);
            carry -= sp;
#pragma unroll
            for (int c = 0; c < 8; ++c) { const u32x4 w = ((const u32x4*)vp)[c]; float v8[8]; UNPACK8(v8, w);
#pragma unroll
                for (int e = 0; e < 8; ++e) acc[8 * c + e] += p * v8[e]; }
        }
        u32x4* op = (u32x4*)(o + (size_t)m * 1024 + head * 64);
#pragma unroll
        for (int c = 0; c < 8; ++c) { u32x4 w; w.x = cvt_pk_bf16(acc[8 * c], acc[8 * c + 1]); w.y = cvt_pk_bf16(acc[8 * c + 2], acc[8 * c + 3]);
            w.z = cvt_pk_bf16(acc[8 * c + 4], acc[8 * c + 5]); w.w = cvt_pk_bf16(acc[8 * c + 6], acc[8 * c + 7]); op[c] = w; }
    }
}
__device__ __forceinline__ void ret_naive(const bf16* qk, bf16* vo, int gtid, int gthreads) {
    for (int idx = gtid; idx < 16 * 512 * 16; idx += gthreads) {
        const int dqi = idx & 15, e = (idx >> 4) & 511, bh = idx >> 13, b = bh >> 2, h = bh & 3;
        const float gamma = 1.f - exp2f(-5.f - (float)h);
        float S[16];
#pragma unroll
        for (int j = 0; j < 16; ++j) S[j] = 0.f;
        for (int t = 0; t < SEQ; ++t) {
            const size_t row = (size_t)b * SEQ + t;
            const u32x4* qp = (const u32x4*)(qk + row * 2048 + h * 256 + dqi * 16);
            const u32x4* kp = (const u32x4*)(qk + row * 2048 + 1024 + h * 256 + dqi * 16);
            bf16* vp = vo + row * 2048 + h * 512 + e;
            const float v = __uint_as_float((unsigned)(*vp) << 16);
            float q16[16], k16[16];
            { const u32x4 w0 = qp[0], w1 = qp[1]; UNPACK8(q16, w0); UNPACK8(q16 + 8, w1); }
            { const u32x4 w0 = kp[0], w1 = kp[1]; UNPACK8(k16, w0); UNPACK8(k16 + 8, w1); }
            float part = 0.f;
#pragma unroll
            for (int j = 0; j < 16; ++j) { S[j] = gamma * S[j] + k16[j] * v; part += q16[j] * S[j]; }
            part += __shfl_xor(part, 1); part += __shfl_xor(part, 2); part += __shfl_xor(part, 4); part += __shfl_xor(part, 8);
            if (dqi == 0) *vp = (bf16)(cvt_pk_bf16(part, 0.f) & 0xffffu);
        }
    }
}

typedef short bf16x8 __attribute__((ext_vector_type(8)));
typedef short s16x4 __attribute__((ext_vector_type(4)));
typedef float f32x16 __attribute__((ext_vector_type(16)));
#define MFMA32(a, b, c) __builtin_amdgcn_mfma_f32_32x32x16_bf16((a), (b), (c), 0, 0, 0)
__device__ __forceinline__ s16x4 tr16(const LAS unsigned char* p) { return __builtin_bit_cast(s16x4, __builtin_amdgcn_ds_read_tr16_b64_v4i16((LAS s16x4*)p)); }
__device__ __forceinline__ bf16x8 pack8(const float* a) {
    u32x4 w; w.x = cvt_pk_bf16(a[0], a[1]); w.y = cvt_pk_bf16(a[2], a[3]); w.z = cvt_pk_bf16(a[4], a[5]); w.w = cvt_pk_bf16(a[6], a[7]);
    return __builtin_bit_cast(bf16x8, w);
}
constexpr int SB_ROW = 144, SB_TILE = 64 * SB_ROW;
__device__ __forceinline__ void sb_phase(const bf16* qkv, bf16* o, LAS unsigned char* lds, int vcu, int G, int tid) {
    const int lane = tid & 63, wave = __builtin_amdgcn_readfirstlane(tid >> 6), r32 = lane & 31, hi = lane >> 5;
    const int srow = tid >> 3, sch = tid & 7;
    const int i16 = lane & 15, tq = i16 >> 2, tp = i16 & 3, blk = (lane >> 4) & 1;
    const int vtr_off = (4 * hi + tq) * SB_ROW + (16 * blk + 4 * tp) * 2;
    LAS unsigned* flg = (LAS unsigned*)(lds + 4 * SB_TILE);
    for (int P = vcu; P < 512; P += G) {
        const int bh = P >> 3, jj = P & 7, b = bh >> 4, h = bh & 15;
        for (int half = 0; half < 2; ++half) {
            const int jq = half ? 15 - jj : jj;
            const size_t mb = (size_t)b * SEQ;
            const bf16* kbase = qkv + mb * 3072 + 1024 + h * 64; const bf16* vbase = kbase + 1024;
            const int tq0 = 256 * jq + 32 * wave;
            bf16x8 qf[4];
            { const bf16* qp = qkv + (mb + tq0 + r32) * 3072 + h * 64 + 8 * hi;
#pragma unroll
              for (int d0 = 0; d0 < 4; ++d0) qf[d0] = *(const bf16x8*)(qp + 16 * d0); }
            f32x16 o0, o1;
#pragma unroll
            for (int r = 0; r < 16; ++r) { o0[r] = 0.f; o1[r] = 0.f; }
            float carry = 0.f; bool mydone = false;
            const int nst = 4 * jq + 4;
            { const size_t roff = (size_t)(64 * (nst - 1) + srow) * 3072 + sch * 8;
              const u32x4 kk = *(const u32x4*)(kbase + roff), vv = *(const u32x4*)(vbase + roff);
              *(LAS u32x4*)(lds + srow * SB_ROW + sch * 16) = kk; *(LAS u32x4*)(lds + 2 * SB_TILE + srow * SB_ROW + sch * 16) = vv; }
            __syncthreads();
            for (int st = nst - 1, it = 0; st >= 0; --st, ++it) {
                const int cb = it & 1;
                const LAS unsigned char* Kb = lds + cb * SB_TILE; const LAS unsigned char* Vb = lds + 2 * SB_TILE + cb * SB_TILE;
                u32x4 kk, vv;
                if (st > 0) { const size_t roff = (size_t)(64 * (st - 1) + srow) * 3072 + sch * 8; kk = *(const u32x4*)(kbase + roff); vv = *(const u32x4*)(vbase + roff); }
                if (64 * st < tq0 + 32 && !mydone) {
                    const bool diag = (64 * st + 63 >= tq0);
#pragma unroll
                    for (int sub = 1; sub >= 0; --sub) {
                        f32x16 p;
#pragma unroll
                        for (int r = 0; r < 16; ++r) p[r] = 0.f;
                        const LAS unsigned char* kp = Kb + (32 * sub + r32) * SB_ROW + 16 * hi;
#pragma unroll
                        for (int d0 = 0; d0 < 4; ++d0) p = MFMA32(*(const LAS bf16x8*)(kp + 32 * d0), qf[d0], p);
                        float l[16]; const int sg0 = 64 * st + 32 * sub + 4 * hi, tg = tq0 + r32;
#pragma unroll
                        for (int r = 0; r < 16; ++r) {
                            const float z = p[r]; const float e = __builtin_amdgcn_exp2f(z); float lg = __builtin_amdgcn_logf(1.f + e); lg = z > 32.f ? z : lg;
                            const bool valid = !diag || (sg0 + (r & 3) + 8 * (r >> 2) < tg);
                            l[r] = valid ? -lg : 0.f;
                        }
                        float gs[4], ot[4], ps[4];
#pragma unroll
                        for (int g = 0; g < 4; ++g) { gs[g] = (l[4 * g] + l[4 * g + 1]) + (l[4 * g + 2] + l[4 * g + 3]); ot[g] = __shfl_xor(gs[g], 32); ps[g] = gs[g] + ot[g]; }
                        float T[4]; T[3] = 0.f; T[2] = ps[3]; T[1] = ps[3] + ps[2]; T[0] = T[1] + ps[1];
                        const float total = T[0] + ps[0];
                        float A[16];
#pragma unroll
                        for (int g = 0; g < 4; ++g) {
                            const float base = carry + T[g] + (hi == 0 ? ot[g] : 0.f);
                            const float i3 = base + l[4 * g + 3], i2 = i3 + l[4 * g + 2], i1 = i2 + l[4 * g + 1], i0 = i1 + l[4 * g];
                            A[4 * g + 3] = __builtin_amdgcn_exp2f(p[4 * g + 3] + i3); A[4 * g + 2] = __builtin_amdgcn_exp2f(p[4 * g + 2] + i2);
                            A[4 * g + 1] = __builtin_amdgcn_exp2f(p[4 * g + 1] + i1); A[4 * g] = __builtin_amdgcn_exp2f(p[4 * g] + i0);
                        }
                        if (diag) {
#pragma unroll
                            for (int r = 0; r < 16; ++r) A[r] = (sg0 + (r & 3) + 8 * (r >> 2) < tg) ? A[r] : 0.f;
                        }
                        carry += total;
                        const bf16x8 pf0 = pack8(A), pf1 = pack8(A + 8);
#pragma unroll
                        for (int s = 0; s < 2; ++s) {
                            const LAS unsigned char* vp = Vb + (32 * sub + 16 * s) * SB_ROW + vtr_off;
                            const s16x4 a0 = tr16(vp), a1 = tr16(vp + 8 * SB_ROW), b0 = tr16(vp + 64), b1 = tr16(vp + 64 + 8 * SB_ROW);
                            const bf16x8 vf0 = __builtin_shufflevector(a0, a1, 0, 1, 2, 3, 4, 5, 6, 7), vf1 = __builtin_shufflevector(b0, b1, 0, 1, 2, 3, 4, 5, 6, 7);
                            o0 = MFMA32(vf0, s ? pf1 : pf0, o0); o1 = MFMA32(vf1, s ? pf1 : pf0, o1);
                        }
                    }
                }
                if (64 * st < tq0 + 32) mydone = __all(carry <= -150.f);
                if (lane == 0) flg[(it & 1) * 8 + wave] = mydone ? 1u : 0u;
                if (st > 0) { LAS unsigned char* Kn = lds + (cb ^ 1) * SB_TILE; *(LAS u32x4*)(Kn + srow * SB_ROW + sch * 16) = kk; *(LAS u32x4*)(Kn + 2 * SB_TILE + srow * SB_ROW + sch * 16) = vv; }
                __syncthreads();
                { const u32x4 f0 = *(const LAS u32x4*)(flg + (it & 1) * 8), f1 = *(const LAS u32x4*)(flg + (it & 1) * 8 + 4);
                  if ((f0.x & f0.y & f0.z & f0.w & f1.x & f1.y & f1.z & f1.w) != 0u) break; }
            }
            bf16* op = o + (mb + tq0 + r32) * 1024 + h * 64 + 4 * hi;
#pragma unroll
            for (int g = 0; g < 4; ++g) {
                u32x2 w0, w1; w0.x = cvt_pk_bf16(o0[4 * g], o0[4 * g + 1]); w0.y = cvt_pk_bf16(o0[4 * g + 2], o0[4 * g + 3]);
                w1.x = cvt_pk_bf16(o1[4 * g], o1[4 * g + 1]); w1.y = cvt_pk_bf16(o1[4 * g + 2], o1[4 * g + 3]);
                *(u32x2*)(op + 8 * g) = w0; *(u32x2*)(op + 32 + 8 * g) = w1;
            }
        }
    }
}

__device__ __forceinline__ void swa_phase(const bf16* qkv, const float* sinks, bf16* o, LAS unsigned char* lds, int vcu, int G, int tid) {
    const int lane = tid & 63, wave = __builtin_amdgcn_readfirstlane(tid >> 6), r32 = lane & 31, hi = lane >> 5;
    const int i16 = lane & 15, tq = i16 >> 2, tp = i16 & 3, blk = (lane >> 4) & 1;
    const int vtr_off = (4 * hi + tq) * SB_ROW + (16 * blk + 4 * tp) * 2;
    LAS unsigned char* Kb = lds; LAS unsigned char* Vb = lds + 256 * SB_ROW;
    for (int u = vcu; u < 256; u += G) {
        const int kv = u & 1, n = (u >> 1) & 31, b = u >> 6;
        const int head = kv * 8 + wave;
        const float slope = exp2f(-0.5f * (float)(head + 1)), sink = sinks[head];
        __syncthreads();
#pragma unroll
        for (int c4 = 0; c4 < 4; ++c4) {
            const int idx = tid + NTHREADS * c4, kr = idx >> 3, ch = idx & 7;
            u32x4 kk = (u32x4){0u, 0u, 0u, 0u}, vv = kk;
            if (n > 0 || kr >= 128) { const bf16* p = qkv + ((size_t)b * SEQ + 128 * (n - 1) + kr) * 1280 + 1024 + kv * 64 + ch * 8; kk = *(const u32x4*)p; vv = *(const u32x4*)(p + 128); }
            *(LAS u32x4*)(Kb + kr * SB_ROW + ch * 16) = kk; *(LAS u32x4*)(Vb + kr * SB_ROW + ch * 16) = vv;
        }
        __syncthreads();
        for (int sb = 0; sb < 4; ++sb) {
            const size_t qrow = (size_t)b * SEQ + 128 * n + 32 * sb + r32;
            bf16x8 qf[4];
            { const bf16* qp = qkv + qrow * 1280 + head * 64 + 8 * hi;
#pragma unroll
              for (int d0 = 0; d0 < 4; ++d0) qf[d0] = *(const bf16x8*)(qp + 16 * d0); }
            const int kl = 128 + 32 * sb + r32;
            float lg[5][16]; float mx = sink;
#pragma unroll
            for (int kt = 0; kt < 5; ++kt) {
                f32x16 p;
#pragma unroll
                for (int r = 0; r < 16; ++r) p[r] = 0.f;
                const LAS unsigned char* kp = Kb + (32 * (sb + kt) + r32) * SB_ROW + 16 * hi;
#pragma unroll
                for (int d0 = 0; d0 < 4; ++d0) p = MFMA32(*(const LAS bf16x8*)(kp + 32 * d0), qf[d0], p);
#pragma unroll
                for (int r = 0; r < 16; ++r) {
                    const int kvl = 32 * (sb + kt) + (r & 3) + 8 * (r >> 2) + 4 * hi, dist = kl - kvl;
                    const bool valid = dist >= 0 && dist < 128 && (n > 0 || kvl >= 128);
                    const float v = valid ? p[r] - slope * (float)dist : -1e30f;
                    lg[kt][r] = v; mx = fmaxf(mx, v);
                }
            }
            mx = fmaxf(mx, __shfl_xor(mx, 32));
            float l = 0.f;
            f32x16 o0, o1;
#pragma unroll
            for (int r = 0; r < 16; ++r) { o0[r] = 0.f; o1[r] = 0.f; }
#pragma unroll
            for (int kt = 0; kt < 5; ++kt) {
#pragma unroll
                for (int r = 0; r < 16; ++r) { const float e = __expf(lg[kt][r] - mx); lg[kt][r] = e; l += e; }
                const bf16x8 pf0 = pack8(&lg[kt][0]), pf1 = pack8(&lg[kt][8]);
#pragma unroll
                for (int s = 0; s < 2; ++s) {
                    const LAS unsigned char* vp = Vb + (32 * (sb + kt) + 16 * s) * SB_ROW + vtr_off;
                    const s16x4 a0 = tr16(vp), a1 = tr16(vp + 8 * SB_ROW), b0 = tr16(vp + 64), b1 = tr16(vp + 64 + 8 * SB_ROW);
                    const bf16x8 vf0 = __builtin_shufflevector(a0, a1, 0, 1, 2, 3, 4, 5, 6, 7), vf1 = __builtin_shufflevector(b0, b1, 0, 1, 2, 3, 4, 5, 6, 7);
                    o0 = MFMA32(vf0, s ? pf1 : pf0, o0); o1 = MFMA32(vf1, s ? pf1 : pf0, o1);
                }
            }
            l += __shfl_xor(l, 32);
            const float inv = 1.f / (l + __expf(sink - mx));
            bf16* op = o + qrow * 1024 + head * 64 + 4 * hi;
#pragma unroll
            for (int g = 0; g < 4; ++g) {
                u32x2 w0, w1; w0.x = cvt_pk_bf16(o0[4 * g] * inv, o0[4 * g + 1] * inv); w0.y = cvt_pk_bf16(o0[4 * g + 2] * inv, o0[4 * g + 3] * inv);
                w1.x = cvt_pk_bf16(o1[4 * g] * inv, o1[4 * g + 1] * inv); w1.y = cvt_pk_bf16(o1[4 * g + 2] * inv, o1[4 * g + 3] * inv);
                *(u32x2*)(op + 8 * g) = w0; *(u32x2*)(op + 32 + 8 * g) = w1;
            }
        }
    }
}

__device__ __forceinline__ void ret_scores(bf16* qk, bf16* sc, int vcu, int G, int tid) {
    const int lane = tid & 63, wave = __builtin_amdgcn_readfirstlane(tid >> 6), r32 = lane & 31, hi = lane >> 5;
    const int it = wave >> 1, jh = wave & 1;
    for (int u = vcu; u < 512; u += G) {
        const int bh = u >> 5, n = u & 31, b = bh >> 2, h = bh & 3;
        const float lg = log2f(1.f - exp2f(-5.f - (float)h));
        const size_t row0 = (size_t)b * SEQ + n * 128;
        const bf16* qp = qk + (row0 + 32 * it + r32) * 2048 + h * 256 + 8 * hi;
        bf16x8 qf[16];
#pragma unroll
        for (int ks = 0; ks < 16; ++ks) qf[ks] = *(const bf16x8*)(qp + 16 * ks);
#pragma unroll
        for (int jt2 = 0; jt2 < 2; ++jt2) {
            const int jt = 2 * jh + jt2;
            if (jt <= it) {
                const bf16* kp = qk + (row0 + 32 * jt + r32) * 2048 + 1024 + h * 256 + 8 * hi;
                f32x16 p;
#pragma unroll
                for (int r = 0; r < 16; ++r) p[r] = 0.f;
#pragma unroll
                for (int ks = 0; ks < 16; ++ks) p = MFMA32(*(const bf16x8*)(kp + 16 * ks), qf[ks], p);
                const int i = 32 * it + r32;
                bf16* sp = sc + (size_t)u * 16384 + (size_t)(it * 8 + 2 * jt) * 512 + r32 * 8 + 4 * hi;
#pragma unroll
                for (int g = 0; g < 4; ++g) {
                    float v[4];
#pragma unroll
                    for (int e = 0; e < 4; ++e) { const int j = 32 * jt + 8 * g + 4 * hi + e; v[e] = (i >= j) ? p[4 * g + e] * exp2f((float)(i - j) * lg) : 0.f; }
                    u32x2 w; w.x = cvt_pk_bf16(v[0], v[1]); w.y = cvt_pk_bf16(v[2], v[3]);
                    *(u32x2*)(sp + (g >> 1) * 512 + (g & 1) * 256) = w;
                }
            }
        }
        __syncthreads();
        if (jh == 0) {
            char* qc = (char*)(qk + row0 * 2048 + h * 256) + (size_t)(it * 32 + hi) * 4096 + r32 * 16;
#pragma unroll
            for (int ks = 0; ks < 16; ++ks) *(bf16x8*)(qc + ks * 8192) = qf[ks];
        }
    }
}
constexpr int RT_ST_ROW = 528, RT_V_ROW = 80, RT_K_ROW = 144;
constexpr int RT_OFF_ST = 0, RT_OFF_V = 32 * RT_ST_ROW, RT_OFF_VD = RT_OFF_V + 128 * RT_V_ROW, RT_OFF_K = RT_OFF_VD + 128 * RT_V_ROW, RT_SLAB = 64 * RT_K_ROW;
__device__ __forceinline__ void ret_scan(const bf16* qk, bf16* vo, const bf16* sc, float* ssqo, LAS unsigned char* lds, int vcu, int G, int tid) {
    const int lane = tid & 63, wave = __builtin_amdgcn_readfirstlane(tid >> 6), r32 = lane & 31, hi = lane >> 5;
    const int i16 = lane & 15, tq = i16 >> 2, tp = i16 & 3, blk = (lane >> 4) & 1;
    const int trv = (8 * hi + tq) * RT_V_ROW + (16 * blk + 4 * tp) * 2, trk = (8 * hi + tq) * RT_K_ROW + (16 * blk + 4 * tp) * 2;
    const int vj = tid >> 2, vch = tid & 3;
    const int krj = lane >> 3, kch = lane & 7, uw = wave & 3;
    const bool owave = wave < 4;
    LAS unsigned char* slab = lds + RT_OFF_K + uw * RT_SLAB;
    for (int u = vcu; u < 256; u += G) {
        const int bh = u >> 4, es = u & 15, b = bh >> 2, h = bh & 3, e0 = 32 * es;
        const float lg = log2f(1.f - exp2f(-5.f - (float)h)), cdec = exp2f(128.f * lg);
        const float kd = exp2f((float)(127 - vj) * lg);
        const size_t rowb = (size_t)b * SEQ;
        const int i = 32 * uw + r32;
        const float qd = exp2f((float)(i + 1) * lg);
        f32x16 st0, st1;
#pragma unroll
        for (int r = 0; r < 16; ++r) { st0[r] = 0.f; st1[r] = 0.f; }
        u32x4 kreg[16], vreg; bf16x8 qreg[16], sreg[8];
        unsigned offq = (unsigned)(hi * 4096 + r32 * 16), offs = (unsigned)(lane * 16), offk = (unsigned)(krj * 2048 + 8 * kch) * 2u, offv = (unsigned)(vj * 2048 + 8 * vch) * 2u;
        unsigned offo = (unsigned)(i * 2048 + 4 * hi) * 2u, offsq = (unsigned)(i * 64) * 4u;
        const char* const qbase = (const char*)(qk + rowb * 2048 + h * 256);
        const char* const kbase = (const char*)(qk + rowb * 2048 + 1024 + h * 256 + 64 * uw);
        const char* const sbase = (const char*)(sc + (size_t)(bh * 32) * 16384);
        char* const vbase = (char*)(vo + rowb * 2048 + h * 512 + e0);
        char* const sqbase = (char*)(ssqo + (rowb * 4 + h) * 16 + es);
#define RT_LOAD_K(nn, half) do { const char* kb_ = kbase + (size_t)(128 * (nn) + 64 * (half)) * 4096; _Pragma("unroll") for (int c8 = 0; c8 < 8; ++c8) \
            kreg[8 * (half) + c8] = *(const u32x4*)(kb_ + c8 * 32768 + offk); } while (0)
#define RT_LOAD_QS(nn) do { const char* qb_ = qbase + (size_t)(128 * (nn) + 32 * uw) * 4096; \
            _Pragma("unroll") for (int ks = 0; ks < 16; ++ks) qreg[ks] = *(const bf16x8*)(qb_ + 8192 * ks + offq); \
            const char* sb_ = sbase + (size_t)(nn) * 32768 + uw * 8192; \
            _Pragma("unroll") for (int ks = 0; ks < 8; ++ks) if (ks < 2 * uw + 2) sreg[ks] = *(const bf16x8*)(sb_ + 1024 * ks + offs); } while (0)
#define RT_LOAD_V(nn) do { vreg = *(const u32x4*)(vbase + (size_t)(128 * (nn)) * 4096 + offv); } while (0)
#define RT_WRITE_V() do { *(LAS u32x4*)(lds + RT_OFF_V + vj * RT_V_ROW + vch * 16) = vreg; float f8[8]; UNPACK8(f8, vreg); \
            u32x4 wd; wd.x = cvt_pk_bf16(f8[0] * kd, f8[1] * kd); wd.y = cvt_pk_bf16(f8[2] * kd, f8[3] * kd); wd.z = cvt_pk_bf16(f8[4] * kd, f8[5] * kd); wd.w = cvt_pk_bf16(f8[6] * kd, f8[7] * kd); \
            *(LAS u32x4*)(lds + RT_OFF_VD + vj * RT_V_ROW + vch * 16) = wd; } while (0)
        __syncthreads();
        for (int x = tid * 16; x < 32 * RT_ST_ROW; x += NTHREADS * 16) *(LAS u32x4*)(lds + RT_OFF_ST + x) = (u32x4){0u, 0u, 0u, 0u};
        RT_LOAD_V(0); RT_WRITE_V();
#define RT_BAR() do { asm volatile("s_waitcnt lgkmcnt(0)" ::: "memory"); __builtin_amdgcn_s_barrier(); asm volatile("" ::: "memory"); } while (0)
        if (owave) {
            RT_LOAD_QS(0);
            for (int n = 0; n < 32; ++n) {
                RT_BAR();
                asm volatile("" : "+v"(offq), "+v"(offs), "+v"(offv), "+v"(offo), "+v"(offsq));
                if (n < 31) RT_LOAD_V(n + 1);
                f32x16 oc, oi;
#pragma unroll
                for (int r = 0; r < 16; ++r) { oc[r] = 0.f; oi[r] = 0.f; }
                const LAS unsigned char* sp = lds + RT_OFF_ST + r32 * RT_ST_ROW + 16 * hi;
#pragma unroll
                for (int ks = 0; ks < 16; ++ks) oc = MFMA32(*(const LAS bf16x8*)(sp + 32 * ks), qreg[ks], oc);
#pragma unroll
                for (int ks = 0; ks < 8; ++ks) if (ks < 2 * uw + 2) {
                    const LAS unsigned char* vp = lds + RT_OFF_V + 16 * ks * RT_V_ROW + trv;
                    const s16x4 a0 = tr16(vp), a1 = tr16(vp + 4 * RT_V_ROW);
                    const bf16x8 vf = __builtin_shufflevector(a0, a1, 0, 1, 2, 3, 4, 5, 6, 7);
                    oi = MFMA32(vf, sreg[ks], oi);
                }
                if (n < 31) RT_LOAD_QS(n + 1);
                float s = 0.f;
                char* const op = vbase + (size_t)(128 * n) * 4096 + offo;
#pragma unroll
                for (int g = 0; g < 4; ++g) {
                    float v[4];
#pragma unroll
                    for (int e = 0; e < 4; ++e) { v[e] = oi[4 * g + e] + qd * oc[4 * g + e]; s += v[e] * v[e]; }
                    u32x2 w; w.x = cvt_pk_bf16(v[0], v[1]); w.y = cvt_pk_bf16(v[2], v[3]);
                    *(u32x2*)(op + 16 * g) = w;
                }
                s += __shfl_xor(s, 32);
                if (hi == 0) *(float*)(sqbase + (size_t)(128 * n) * 256 + offsq) = s;
                RT_BAR();
                if (n < 31) RT_WRITE_V();
            }
        } else {
            RT_LOAD_K(0, 0); RT_LOAD_K(0, 1);
            for (int n = 0; n < 32; ++n) {
                RT_BAR();
                asm volatile("" : "+v"(offk), "+v"(offv));
                if (n < 31) RT_LOAD_V(n + 1);
#pragma unroll
                for (int r = 0; r < 16; ++r) { st0[r] *= cdec; st1[r] *= cdec; }
#pragma unroll
                for (int half = 0; half < 2; ++half) {
#pragma unroll
                    for (int c8 = 0; c8 < 8; ++c8) *(LAS u32x4*)(slab + (krj + 8 * c8) * RT_K_ROW + kch * 16) = kreg[8 * half + c8];
                    if (n < 31) { if (half == 0) RT_LOAD_K(n + 1, 0); else RT_LOAD_K(n + 1, 1); }
#pragma unroll
                    for (int ks = 0; ks < 4; ++ks) {
                        const LAS unsigned char* kp = slab + 16 * ks * RT_K_ROW + trk;
                        const LAS unsigned char* vp = lds + RT_OFF_VD + (64 * half + 16 * ks) * RT_V_ROW + trv;
                        const s16x4 v0 = tr16(vp), v1 = tr16(vp + 4 * RT_V_ROW);
                        const s16x4 k0 = tr16(kp), k1 = tr16(kp + 4 * RT_K_ROW), k2 = tr16(kp + 64), k3 = tr16(kp + 64 + 4 * RT_K_ROW);
                        const bf16x8 vf = __builtin_shufflevector(v0, v1, 0, 1, 2, 3, 4, 5, 6, 7);
                        const bf16x8 kf0 = __builtin_shufflevector(k0, k1, 0, 1, 2, 3, 4, 5, 6, 7), kf1 = __builtin_shufflevector(k2, k3, 0, 1, 2, 3, 4, 5, 6, 7);
                        st0 = MFMA32(kf0, vf, st0); st1 = MFMA32(kf1, vf, st1);
                    }
                }
                RT_BAR();
                { LAS unsigned char* wp = lds + RT_OFF_ST + r32 * RT_ST_ROW + (64 * uw + 4 * hi) * 2;
#pragma unroll
                  for (int g = 0; g < 4; ++g) {
                    u32x2 w0, w1; w0.x = cvt_pk_bf16(st0[4 * g], st0[4 * g + 1]); w0.y = cvt_pk_bf16(st0[4 * g + 2], st0[4 * g + 3]);
                    w1.x = cvt_pk_bf16(st1[4 * g], st1[4 * g + 1]); w1.y = cvt_pk_bf16(st1[4 * g + 2], st1[4 * g + 3]);
                    *(LAS u32x2*)(wp + 16 * g) = w0; *(LAS u32x2*)(wp + 64 + 16 * g) = w1;
                  } }
                if (n < 31) RT_WRITE_V();
            }
        }
#undef RT_BAR
#undef RT_LOAD_K
#undef RT_LOAD_QS
#undef RT_LOAD_V
#undef RT_WRITE_V
    }
}

#define XB_TMO      128
#define XB_XCNT(j)  (256  + 64 * (j))
#define XB_XSUB(j)  (1280 + 64 * (j))
#define XB_XGEN(j)  (2304 + 64 * (j))
#define XB_TOP      3328
#define XB_TOPGEN   3392
#define XCD_BAR_WORDS 3456
#define XB_SPIN_CAP (1u << 18)

__device__ __forceinline__ unsigned xb_ld(unsigned* p)              { return __hip_atomic_load(p, __ATOMIC_RELAXED, __HIP_MEMORY_SCOPE_AGENT); }
__device__ __forceinline__ unsigned xb_add(unsigned* p, unsigned v) { return __hip_atomic_fetch_add(p, v, __ATOMIC_RELAXED, __HIP_MEMORY_SCOPE_AGENT); }
__device__ __forceinline__ unsigned xb_xcc_id() { return (unsigned)__builtin_amdgcn_s_getreg((3 << 11) | 20) & 0xFu; }
#define XB_SPIN(cond, bar) do { unsigned _sp = 0; while (cond) { __builtin_amdgcn_s_sleep(1); \
    if ((++_sp & 255u) == 0u) { if (xb_ld(&(bar)[XB_TMO])) break; if (_sp > XB_SPIN_CAP) { atomicAdd(&(bar)[XB_TMO], 1u); break; } } } } while (0)

struct XcdBarrier {
    unsigned* bar; unsigned x;
    volatile LAS unsigned* st;
};

__device__ __forceinline__ XcdBarrier xcd_barrier_post(unsigned* bar, volatile LAS unsigned* st) {
    XcdBarrier b; b.bar = bar; b.x = xb_xcc_id(); b.st = st;
    if (threadIdx.x == 0) (void)xb_add(&bar[XB_XCNT(b.x)], 1u);
    return b;
}
__device__ __forceinline__ void xcd_barrier_complete(unsigned* bar, unsigned x, unsigned& nloc, unsigned& nx) {
    const unsigned G = gridDim.x * gridDim.y * gridDim.z;
    unsigned sum, cnt, mine, sp = 0u;
    for (;;) {
        sum = 0u; cnt = 0u; mine = 0u;
#pragma unroll
        for (unsigned j = 0; j < 16; ++j) { const unsigned c = xb_ld(&bar[XB_XCNT(j)]); sum += c; cnt += (c > 0u) ? 1u : 0u; mine = (j == x) ? c : mine; }
        if (sum == G) break;
        __builtin_amdgcn_s_sleep(1);
        if ((++sp & 255u) == 0u) { if (xb_ld(&bar[XB_TMO])) break; if (sp > XB_SPIN_CAP) { atomicAdd(&bar[XB_TMO], 1u); break; } }
    }
    nloc = mine > 0u ? mine : 1u; nx = cnt > 0u ? cnt : 1u;
}

__device__ __forceinline__ void xcd_barrier(const XcdBarrier& b) {
    asm volatile("s_waitcnt vmcnt(0)" ::: "memory");
    __syncthreads();
    if (threadIdx.x == 0) {
        unsigned* bar = b.bar;
        __builtin_amdgcn_s_waitcnt(0);
        unsigned nloc = b.st[0], nx = b.st[1];
        if (nloc == 0u) { xcd_barrier_complete(bar, b.x, nloc, nx); b.st[0] = nloc; b.st[1] = nx; }
        const unsigned old = xb_add(&bar[XB_XSUB(b.x)], 1u);
        const unsigned gen = old / nloc;
        if (old + 1u == (gen + 1u) * nloc) {
            __builtin_amdgcn_fence(__ATOMIC_RELEASE, "agent");
            asm volatile("s_waitcnt vmcnt(0)" ::: "memory");
            const unsigned og = xb_add(&bar[XB_TOP], 1u);
            const unsigned tg = og / nx;
            if (og + 1u == (tg + 1u) * nx) xb_add(&bar[XB_TOPGEN], 1u);
            else XB_SPIN(xb_ld(&bar[XB_TOPGEN]) == tg, bar);
            __builtin_amdgcn_fence(__ATOMIC_ACQUIRE, "agent");
            xb_add(&bar[XB_XGEN(b.x)], 1u);
            asm volatile("s_waitcnt vmcnt(0)" ::: "memory");
        } else {
            XB_SPIN(xb_ld(&bar[XB_XGEN(b.x)]) == gen, bar);
            __builtin_amdgcn_fence(__ATOMIC_ACQUIRE, "agent");
            asm volatile("s_waitcnt vmcnt(0)" ::: "memory");
        }
    }
    __syncthreads();
}

#define FILL_RS_TABLE(S_, kk_) do { _Pragma("unroll") for (int ui_ = 0; ui_ < 4; ++ui_) { pg8::Unit u_; kk_[ui_] = -1; \
        if (S_.next(ui_, u_)) { kk_[ui_] = u_.pm; if (tl_ < 256) rstab[ui_ * 256 + tl_] = row_rs(ssq, u_.pm * 256 + tl_); } } __syncthreads(); } while (0)
__global__ void __launch_bounds__(NTHREADS, 2) mega(Args a) {
    extern __shared__ __attribute__((aligned(16))) unsigned char lds_raw[];
    LAS unsigned char* lds = (LAS unsigned char*)lds_raw;
    cg::grid_group grid = cg::this_grid();
    const int tid = threadIdx.x, lane0 = tid & 63, wave = __builtin_amdgcn_readfirstlane(tid >> 6);
    const int G = gridDim.x, bx = blockIdx.x;
    const int gw = bx * NWAVES + wave, NGW = G * NWAVES, gthreads = G * NTHREADS;
    const int vcu = (G % 8 == 0) ? (bx % 8) * (G / 8) + bx / 8 : bx;
    unsigned char* ws = a.ws;
    float* ssq = (float*)(ws + WS_SSQ); bf16* hb = (bf16*)(ws + WS_HB);
    unsigned char* R = ws + WS_R;

    volatile LAS unsigned* xb_st = (volatile LAS unsigned*)(lds + 131072 + 64);
    LAS float* rstab = (LAS float*)(lds + 131072 + 256);
    if (tid < 2) xb_st[tid] = 0u;
    unsigned* barw = (unsigned*)(ws + WS_BAR);
    __syncthreads();
    const XcdBarrier xbar = xcd_barrier_post(barw, xb_st);
    convert_layer(a, 0, lds, gw, NGW, wave, lane0);
    for (int m = gw; m < M; m += 2 * NGW) {
        const int lane = lane0; const int m1 = m + NGW; const bool two = m1 < M;
        const f32x4* xr0 = (const f32x4*)(a.in[0] + (size_t)m * D) + lane; const f32x4* xr1 = (const f32x4*)(a.in[0] + (size_t)(two ? m1 : m) * D) + lane;
        f32x4 v0[4], v1[4];
#pragma unroll
        for (int j = 0; j < 4; ++j) { v0[j] = xr0[64 * j]; v1[j] = xr1[64 * j]; }
        float s0 = 0.f, s1 = 0.f;
        unsigned long long* o0 = (unsigned long long*)(hb + (size_t)m * D) + lane; unsigned long long* o1 = (unsigned long long*)(hb + (size_t)m1 * D) + lane;
#pragma unroll
        for (int j = 0; j < 4; ++j) {
            s0 += (v0[j][0] * v0[j][0] + v0[j][1] * v0[j][1]) + (v0[j][2] * v0[j][2] + v0[j][3] * v0[j][3]);
            s1 += (v1[j][0] * v1[j][0] + v1[j][1] * v1[j][1]) + (v1[j][2] * v1[j][2] + v1[j][3] * v1[j][3]);
            o0[64 * j] = (unsigned long long)cvt_pk_bf16(v0[j][0], v0[j][1]) | ((unsigned long long)cvt_pk_bf16(v0[j][2], v0[j][3]) << 32);
            if (two) o1[64 * j] = (unsigned long long)cvt_pk_bf16(v1[j][0], v1[j][1]) | ((unsigned long long)cvt_pk_bf16(v1[j][2], v1[j][3]) << 32);
        }
        s0 = wave_sum(s0); s1 = wave_sum(s1);
        if (lane < 16) { ssq[(size_t)m * 16 + lane] = (lane == 0) ? s0 : 0.f; if (two) ssq[(size_t)m1 * 16 + lane] = (lane == 0) ? s1 : 0.f; }
    }
    if (a.ws == nullptr) grid.sync();
    xcd_barrier(xbar);

    for (int i = 0; i < DEPTH; ++i) {
        const int kind = i % 3, j = i / 3;
        unsigned char* wb = ws + ((i & 1) ? WS_WB1 : WS_WB0);
        int tl_ = threadIdx.x; asm volatile("" : "+v"(tl_));
        const int lane = tl_ & 63, gtid = bx * NTHREADS + tl_;
        {
            const int n_in = kind == 0 ? 1280 : (kind == 1 ? 3072 : 4096);
            pg8::Gemm g{hb, (const bf16*)(wb + WB_IN), M, n_in, D}; pg8::StaticOrder S; S.init(M, n_in, G, bx);
            int kk[4]; FILL_RS_TABLE(S, kk);
            EpiRowScale<0> E{(bf16*)R, kind == 2 ? 2048 : n_in, ssq, kind == 2 ? 2048 : 0, (size_t)(R_V / 2), rstab, kk[0], kk[1], kk[2], kk[3]};
            pg8::gemm_phase<EpiRowScale<0>, pg8::StaticOrder, true, true>(lds, g, S, E);
        }
        xcd_barrier(xbar);
        if (i + 1 < DEPTH) { convert_layer(a, i + 1, lds, gw, NGW, wave, lane); __syncthreads(); }
        if (kind == 0) swa_phase((const bf16*)R, a.in[5] + j * 16, (bf16*)(R + R_O), lds, vcu, G, tl_);
        else if (kind == 1) sb_phase((const bf16*)R, (bf16*)(R + R_O), lds, vcu, G, tl_);
        else {
            ret_scores((bf16*)R, (bf16*)(ws + WS_SC), vcu, G, tl_);
            xcd_barrier(xbar);
            ret_scan((const bf16*)R, (bf16*)(R + R_V), (const bf16*)(ws + WS_SC), (float*)(ws + WS_SSQO), lds, vcu, G, tl_);
            xcd_barrier(xbar);
            pg8::Gemm g{hb, (const bf16*)(wb + WB_IN) + (size_t)4096 * D, M, 2048, D}; pg8::StaticOrder S; S.init(M, 2048, G, bx);
            EpiGate E{(bf16*)R, (const bf16*)(R + R_V), ssq, (const float*)(ws + WS_SSQO)};
            pg8::gemm_phase<EpiGate, pg8::StaticOrder, true, true>(lds, g, S, E);
        }
        xcd_barrier(xbar);
        {
            const int k_o = kind == 2 ? 2048 : 1024;
            pg8::Gemm g{kind == 2 ? (const bf16*)R : (const bf16*)(R + R_O), (const bf16*)(wb + WB_O), M, D, k_o}; pg8::StaticOrder S; S.init(M, D, G, bx);
            if (i == 0) { EpiRes<true> E{a.in[0], hb, ssq}; pg8::gemm_phase<EpiRes<true>, pg8::StaticOrder, true, true>(lds, g, S, E); }
            else { EpiRes<false> E{nullptr, hb, ssq}; pg8::gemm_phase<EpiRes<false>, pg8::StaticOrder, true, true>(lds, g, S, E); }
        }
        xcd_barrier(xbar);
        {
            pg8::Gemm g{hb, (const bf16*)(wb + WB_UP), M, FF, D}; pg8::StaticOrder S; S.init(M, FF, G, bx);
            int kk[4]; FILL_RS_TABLE(S, kk);
            EpiRowScale<1> E{(bf16*)R, FF, ssq, 0, 0, rstab, kk[0], kk[1], kk[2], kk[3]};
            pg8::gemm_phase<EpiRowScale<1>, pg8::StaticOrder, true, true>(lds, g, S, E);
        }
        xcd_barrier(xbar);
        {
            pg8::Gemm g{(const bf16*)R, (const bf16*)(wb + WB_DOWN), M, D, FF}; pg8::StaticOrder S; S.init(M, D, G, bx);
            EpiRes<false> E{nullptr, hb, ssq};
            pg8::gemm_phase<EpiRes<false>, pg8::StaticOrder, true, true>(lds, g, S, E);
        }
        xcd_barrier(xbar);
    }
    for (int m = gw; m < M; m += NGW) {
        const float rs = row_rs(ssq, m); const int lane = lane0;
        const u32x4* hr = (const u32x4*)(hb + (size_t)m * D) + lane; const f32x4* gr = (const f32x4*)a.in[3] + 2 * lane; f32x4* orow = (f32x4*)(a.out + (size_t)m * D) + 2 * lane;
#pragma unroll
        for (int jj = 0; jj < 2; ++jj) { const u32x4 hv = hr[64 * jj]; const f32x4 g0 = gr[128 * jj], g1 = gr[128 * jj + 1];
            const f32x4 v0 = (f32x4){bflo(hv.x), bfhi(hv.x), bflo(hv.y), bfhi(hv.y)}, v1 = (f32x4){bflo(hv.z), bfhi(hv.z), bflo(hv.w), bfhi(hv.w)};
            __builtin_nontemporal_store(v0 * rs * g0, orow + 128 * jj); __builtin_nontemporal_store(v1 * rs * g1, orow + 128 * jj + 1); }
    }
}

extern "C" void kernel_launch(void* const* d_in, const int* in_sizes, int n_in, void* d_out, int out_size, void* d_ws, size_t ws_size, hipStream_t stream) {
    static int grid = 0;
    if (grid == 0) {
        if (n_in != 13 || out_size != M * D || ws_size < WS_END) { fprintf(stderr, "kernel_launch: unexpected shapes (n_in %d out %d ws %zu)\n", n_in, out_size, ws_size); grid = -1; return; }
        int dev = 0, cus = 0, per_cu = 0;
        hipGetDevice(&dev); hipDeviceGetAttribute(&cus, hipDeviceAttributeMultiprocessorCount, dev);
        hipFuncSetAttribute((const void*)mega, hipFuncAttributeMaxDynamicSharedMemorySize, LDS_BYTES);
        if (hipOccupancyMaxActiveBlocksPerMultiprocessor(&per_cu, (const void*)mega, NTHREADS, LDS_BYTES) != hipSuccess || per_cu < 1) { fprintf(stderr, "kernel_launch: occupancy query gave %d\n", per_cu); per_cu = 1; }
        (void)hipGetLastError();
        grid = cus * per_cu;
        fprintf(stderr, "kernel_launch: grid %d (cus %d x %d)\n", grid, cus, per_cu);
    }
    if (grid < 0) return;
    Args a{};
    for (int i = 0; i < 13; ++i) a.in[i] = (const float*)d_in[i];
    a.out = (float*)d_out; a.ws = (unsigned char*)d_ws;
    if (hipMemsetAsync((char*)d_ws + WS_BAR, 0, XCD_BAR_WORDS * 4, stream) != hipSuccess) { fprintf(stderr, "kernel_launch: memset of the barrier words failed\n"); return; }
    void* args[] = {&a};
    hipError_t e = hipLaunchCooperativeKernel((const void*)mega, dim3(grid), dim3(NTHREADS), args, LDS_BYTES, stream);
    if (e != hipSuccess) fprintf(stderr, "cooperative launch failed: %s (grid %d)\n", hipGetErrorString(e), grid);
}
```

```cpp
#include <hip/hip_runtime.h>
#include <hip/hip_cooperative_groups.h>
#include <cstdio>
#include <cstdint>
namespace cg = cooperative_groups;
namespace pg8 {
#define PG8_LAS __attribute__((address_space(3)))
typedef unsigned short bf16_t;
typedef short bf16x8 __attribute__((ext_vector_type(8)));
typedef float f32x4 __attribute__((ext_vector_type(4)));
typedef unsigned u32x4 __attribute__((ext_vector_type(4)));
constexpr int BM = 256, BK = 64, HALF = 128, HTB = HALF * BK * 2  , STAGE_BYTES = 8 * HTB, NXCD = 8, WGM = 8;

__host__ __device__ __forceinline__ int lds_byte(int r, int c) { const int st = (r >> 4) * 2 + (c >> 5), rr = r & 15, cc = c & 31, ob = rr * 64 + cc * 2; return st * 1024 + (ob ^ (((ob >> 9) & 1) << 5)); }
__host__ __device__ __forceinline__ void stage_rc(int b, int& R, int& C) { const int st = b / 1024, sb = b % 1024, swz = sb ^ (((sb >> 9) & 1) << 5); R = (st >> 1) * 16 + swz / 64; C = (st & 1) * 32 + (swz % 64) / 2; }
__host__ __device__ __forceinline__ int perm32(int rho) { const int n = rho >> 4, i = rho & 15; return 8 * (i >> 2) + 4 * n + (i & 3); }

struct Unit { int pm, pn; };
struct Gemm { const bf16_t* A; const bf16_t* Bt; int M, N, K; };

struct StaticOrder {
    int nM, nN, nwg, G, c;
    __host__ __device__ void init(int M, int N, int G_, int c_) { nM = M / BM; nN = N / BM; nwg = nM * nN; G = G_; c = c_; }
    __host__ __device__ bool next(int i, Unit& u) const {
        const long L = (long)i * G + c; if (L >= nwg) return false;
        int wgid = (int)L; { const int q = nwg / NXCD, r = nwg % NXCD, xcd = wgid % NXCD, off = wgid / NXCD; wgid = (xcd < r ? xcd * (q + 1) : r * (q + 1) + (xcd - r) * q) + off; }
        const int nig = WGM * nN, gid = wgid / nig, fm = gid * WGM, gsz = (nM - fm) < WGM ? (nM - fm) : WGM;
        u.pm = fm + ((wgid % nig) % gsz); u.pn = (wgid % nig) / gsz; return true;
    }
    __device__ __forceinline__ void a_ready(const Unit&) const {}
    __device__ __forceinline__ void done(const Unit&) const {}
};

__device__ __forceinline__ unsigned cvt_pk_bf16(float lo, float hi) { unsigned r; asm volatile("v_cvt_pk_bf16_f32 %0, %1, %2" : "=v"(r) : "v"(lo), "v"(hi)); return r; }
typedef float f32x2 __attribute__((ext_vector_type(2)));
__device__ __forceinline__ f32x2 gelu_pk(f32x2 v) {
    const f32x2 av = __builtin_elementwise_abs(v), d = av * 0.2316418882f + 1.0f;
    f32x2 t; t.x = __builtin_amdgcn_rcpf(d.x); t.y = __builtin_amdgcn_rcpf(d.y);
    f32x2 q = t * 0.5307027145f + (-0.7265760135f); q = q * t + 0.7107068705f; q = q * t + (-0.142248368f); q = q * t + 0.127414796f; q = q * t;
    const f32x2 s = (v * v) * (-0.72134752044f);
    f32x2 e; e.x = __builtin_amdgcn_exp2f(s.x); e.y = __builtin_amdgcn_exp2f(s.y);
    const f32x2 m = v * (q * e), r = v - m;
    f32x2 o; o.x = v.x < 0.f ? m.x : r.x; o.y = v.y < 0.f ? m.y : r.y; return o;
}

template <int ACT  > struct EpiBf16 {
    static constexpr bool PERM = true, AFTER_DRAIN = false; static_assert(ACT == 0 || ACT == 1, "EpiBf16: ACT is 0 (none) or 1 (gelu_pk)");
    bf16_t* O; int ldc; const float* bias; int split_cols; size_t split_stride; float scale0;
    __device__ __forceinline__ void operator()(const f32x4 (&acc)[2][2][4][2], const Unit& u, int wr, int wc, int fr, int fq) const {
        const int row0 = u.pm * BM + wr * 64 + fr; int colt = u.pn * BM; bf16_t* base = O;
        float sc = 1.f; if (split_cols) { const int t = colt / split_cols; base += (size_t)t * split_stride; colt -= t * split_cols; if (t == 0) sc = scale0; }
        const int col0 = colt + wc * 32 + 8 * fq, bcol0 = u.pn * BM + wc * 32 + 8 * fq;
        f32x4 bv[2][2];
#pragma unroll
        for (int bj = 0; bj < 2; ++bj)
#pragma unroll
            for (int n = 0; n < 2; ++n) bv[bj][n] = bias ? *(const f32x4*)(bias + bcol0 + bj * HALF + 4 * n) : (f32x4){0.f, 0.f, 0.f, 0.f};
#pragma unroll
        for (int ai = 0; ai < 2; ++ai)
#pragma unroll
            for (int m = 0; m < 4; ++m) { bf16_t* rowp = base + (size_t)(row0 + ai * HALF + m * 16) * ldc + col0;
#pragma unroll
                for (int bj = 0; bj < 2; ++bj) { f32x4 v0 = acc[ai][bj][m][0] + bv[bj][0], v1 = acc[ai][bj][m][1] + bv[bj][1];
                    if (ACT == 1) { f32x2 a = gelu_pk((f32x2){v0[0], v0[1]}), b = gelu_pk((f32x2){v0[2], v0[3]}), c = gelu_pk((f32x2){v1[0], v1[1]}), d = gelu_pk((f32x2){v1[2], v1[3]});
                        v0 = (f32x4){a.x, a.y, b.x, b.y}; v1 = (f32x4){c.x, c.y, d.x, d.y}; }
                    v0 = v0 * sc; v1 = v1 * sc; u32x4 w; w.x = cvt_pk_bf16(v0[0], v0[1]); w.y = cvt_pk_bf16(v0[2], v0[3]); w.z = cvt_pk_bf16(v1[0], v1[1]); w.w = cvt_pk_bf16(v1[2], v1[3]);
                    *(u32x4*)(rowp + bj * HALF) = w; } }
    }
};

template <class Epi, class Sched, bool ALIGN_EPI = false, bool SP2 = false>
__device__ __forceinline__ void gemm_phase(PG8_LAS unsigned char* lds, const Gemm g, const Sched& S, const Epi& E) {
    int tid_ = threadIdx.x; asm volatile("" : "+v"(tid_));
    const int tid = tid_, wid = __builtin_amdgcn_readfirstlane(tid >> 6), lane = tid & 63, wr = wid >> 2, wc = wid & 3, fr = lane & 15, fq = lane >> 4;
    const int K = g.K, nt = K / BK;
    unsigned voffA[2], voffB[2];
#pragma unroll
    for (int i = 0; i < 2; ++i) { int R, C; stage_rc(tid * 16 + i * 8192, R, C); const int Rb = Epi::PERM ? ((R & ~31) + perm32(R & 31)) : R;
        voffA[i] = (unsigned)(R * K + C) * 2u; voffB[i] = (unsigned)(Rb * K + C) * 2u; }
    const size_t kstep = (size_t)(BK * 2);
    const size_t hstep = (size_t)HALF * K * 2;
    const size_t tstep = 2 * hstep;
    const unsigned ldsw = (unsigned)wid * 1024u;
    const int aoff = lds_byte(wr * 64 + fr, fq * 8), boff = lds_byte(wc * 32 + fr, fq * 8);
#define PG8_SA(b, h) (((b) * 2 + (h)) * HTB)
#define PG8_SB(b, h) ((4 + (b) * 2 + (h)) * HTB)
#define PG8_STAGE(bufoff, gbase, voff) do { _Pragma("unroll") for (int _i = 0; _i < 2; ++_i) \
        __builtin_amdgcn_global_load_lds((const unsigned*)((const char*)(gbase) + (voff)[_i]), (PG8_LAS unsigned*)(lds + (bufoff) + ldsw + _i * 8192), 16, 0, 0); } while (0)
#define PG8_LDA(dst, b, h) do { _Pragma("unroll") for (int m = 0; m < 4; ++m) _Pragma("unroll") for (int k = 0; k < 2; ++k) dst[m][k] = *(const PG8_LAS bf16x8*)(lds + PG8_SA(b, h) + aoff + m * 2048 + k * 1024); } while (0)
#define PG8_LDB(dst, b, h) do { _Pragma("unroll") for (int n = 0; n < 2; ++n) _Pragma("unroll") for (int k = 0; k < 2; ++k) dst[n][k] = *(const PG8_LAS bf16x8*)(lds + PG8_SB(b, h) + boff + n * 2048 + k * 1024); } while (0)
#define PG8_MMA(ai, bj, At, Bt) do { __builtin_amdgcn_s_setprio(1); _Pragma("unroll") for (int m = 0; m < 4; ++m) _Pragma("unroll") for (int n = 0; n < 2; ++n) _Pragma("unroll") for (int k = 0; k < 2; ++k) \
        acc[ai][bj][m][n] = __builtin_amdgcn_mfma_f32_16x16x32_bf16(Bt[n][k], At[m][k], acc[ai][bj][m][n], 0, 0, 0); __builtin_amdgcn_s_setprio(0); } while (0)
#define PG8_WAIT_V(n) asm volatile("s_waitcnt vmcnt(" #n ")" ::: "memory")
#define PG8_WAIT_L(n) asm volatile("s_waitcnt lgkmcnt(" #n ")" ::: "memory")
#define PG8_BAR __builtin_amdgcn_s_barrier()
#define PG8_SCHED __builtin_amdgcn_sched_barrier(0)
    Unit cur, nxt; int ui = 0;
    if (!S.next(0, cur)) return;
    f32x4 acc[2][2][4][2];
#pragma unroll
    for (int a = 0; a < 2; ++a)
#pragma unroll
        for (int b = 0; b < 2; ++b)
#pragma unroll
            for (int m = 0; m < 4; ++m)
#pragma unroll
                for (int n = 0; n < 2; ++n) acc[a][b][m][n] = (f32x4){0.f, 0.f, 0.f, 0.f};
    bf16x8 At[4][2], B0[2][2], B1[2][2];
    const char* cA = (const char*)g.A + (size_t)cur.pm * tstep; const char* cB = (const char*)g.Bt + (size_t)cur.pn * tstep;
    S.a_ready(cur);
    if constexpr (SP2) {
        PG8_STAGE(PG8_SB(0, 0), cB, voffB); PG8_STAGE(PG8_SB(0, 1), cB + hstep, voffB); PG8_STAGE(PG8_SA(0, 0), cA, voffA); PG8_STAGE(PG8_SA(0, 1), cA + hstep, voffA);
        if (wr == 1) PG8_BAR;
        PG8_WAIT_V(2); PG8_BAR;
        PG8_STAGE(PG8_SB(1, 0), cB + kstep, voffB); PG8_STAGE(PG8_SA(1, 0), cA + kstep, voffA); PG8_STAGE(PG8_SB(1, 1), cB + hstep + kstep, voffB);
        PG8_WAIT_V(6); PG8_BAR;
    } else {
        PG8_STAGE(PG8_SB(0, 0), cB, voffB); PG8_STAGE(PG8_SA(0, 0), cA, voffA); PG8_STAGE(PG8_SB(0, 1), cB + hstep, voffB); PG8_STAGE(PG8_SA(0, 1), cA + hstep, voffA);
        if (wr == 1) PG8_BAR;
        PG8_WAIT_V(4); PG8_BAR;
        PG8_STAGE(PG8_SB(1, 0), cB + kstep, voffB); PG8_STAGE(PG8_SA(1, 0), cA + kstep, voffA); PG8_STAGE(PG8_SB(1, 1), cB + hstep + kstep, voffB);
        PG8_WAIT_V(6); PG8_BAR;
    }
    for (;;) {
        const bool has_next = S.next(ui + 1, nxt);
        const char* nA = has_next ? (const char*)g.A + (size_t)nxt.pm * tstep : cA; const char* nB = has_next ? (const char*)g.Bt + (size_t)nxt.pn * tstep : cB;
        for (int t = 0; t < nt; t += 2) {
            const bool last = (t == nt - 2);
            const char* a1 = cA + (size_t)(t + 1) * kstep;
            const char* a2 = last ? nA : cA + (size_t)(t + 2) * kstep; const char* b2 = last ? nB : cB + (size_t)(t + 2) * kstep;
            const char* a3 = a2 + kstep; const char* b3 = b2 + kstep;
            if (last && has_next) S.a_ready(nxt);
            if constexpr (SP2) {
            PG8_LDB(B0, 0, 0); PG8_LDB(B1, 0, 1); PG8_SCHED; PG8_LDA(At, 0, 0); PG8_STAGE(PG8_SA(1, 1), a1 + hstep, voffA);
            PG8_WAIT_V(8); PG8_WAIT_L(0); PG8_BAR; PG8_MMA(0, 0, At, B0); PG8_MMA(0, 1, At, B1); PG8_BAR; PG8_SCHED;
            PG8_LDA(At, 0, 1); PG8_STAGE(PG8_SB(0, 0), b2, voffB); PG8_STAGE(PG8_SB(0, 1), b2 + hstep, voffB); PG8_STAGE(PG8_SA(0, 0), a2, voffA);
            PG8_WAIT_V(8); PG8_WAIT_L(0); PG8_BAR; PG8_MMA(1, 0, At, B0); PG8_MMA(1, 1, At, B1); PG8_BAR; PG8_SCHED;
            PG8_LDB(B0, 1, 0); PG8_LDB(B1, 1, 1); PG8_SCHED; PG8_LDA(At, 1, 0); PG8_STAGE(PG8_SA(0, 1), a2 + hstep, voffA);
            PG8_WAIT_V(8); PG8_WAIT_L(0); PG8_BAR; PG8_MMA(0, 0, At, B0); PG8_MMA(0, 1, At, B1); PG8_BAR; PG8_SCHED;
            PG8_LDA(At, 1, 1); PG8_STAGE(PG8_SB(1, 0), b3, voffB); PG8_STAGE(PG8_SB(1, 1), b3 + hstep, voffB); PG8_STAGE(PG8_SA(1, 0), a3, voffA);
            PG8_WAIT_V(8); PG8_WAIT_L(0); PG8_BAR; PG8_MMA(1, 0, At, B0); PG8_MMA(1, 1, At, B1); PG8_BAR; PG8_SCHED;
            } else {
            PG8_LDB(B0, 0, 0); PG8_SCHED; PG8_LDA(At, 0, 0); PG8_STAGE(PG8_SA(1, 1), a1 + hstep, voffA);
            PG8_WAIT_L(8); PG8_BAR; PG8_WAIT_L(0); PG8_MMA(0, 0, At, B0); PG8_BAR; PG8_SCHED;
            PG8_LDB(B1, 0, 1); PG8_STAGE(PG8_SB(0, 0), b2, voffB);
            PG8_BAR; PG8_WAIT_L(0); PG8_MMA(0, 1, At, B1); PG8_BAR;
            PG8_LDA(At, 0, 1); PG8_STAGE(PG8_SA(0, 0), a2, voffA);
            PG8_BAR; PG8_WAIT_L(0); PG8_MMA(1, 0, At, B0); PG8_BAR; PG8_SCHED;
            PG8_STAGE(PG8_SB(0, 1), b2 + hstep, voffB);
            PG8_WAIT_V(6); PG8_BAR; PG8_MMA(1, 1, At, B1); PG8_BAR;
            PG8_LDB(B0, 1, 0); PG8_SCHED; PG8_LDA(At, 1, 0); PG8_STAGE(PG8_SA(0, 1), a2 + hstep, voffA);
            PG8_WAIT_L(8); PG8_BAR; PG8_WAIT_L(0); PG8_MMA(0, 0, At, B0); PG8_BAR; PG8_SCHED;
            PG8_LDB(B1, 1, 1); PG8_STAGE(PG8_SB(1, 0), b3, voffB);
            PG8_BAR; PG8_WAIT_L(0); PG8_MMA(0, 1, At, B1); PG8_BAR;
            PG8_LDA(At, 1, 1); PG8_STAGE(PG8_SA(1, 0), a3, voffA);
            PG8_BAR; PG8_WAIT_L(0); PG8_MMA(1, 0, At, B0); PG8_BAR; PG8_SCHED;
            PG8_STAGE(PG8_SB(1, 1), b3 + hstep, voffB);
            PG8_WAIT_V(6); PG8_BAR; PG8_MMA(1, 1, At, B1); PG8_BAR;
            }
        }
        if constexpr (ALIGN_EPI) { if (wr == 0) PG8_BAR; }
        if constexpr (!Epi::AFTER_DRAIN) { E(acc, cur, wr, wc, fr, fq); S.done(cur); }
        if (!has_next) break;
#pragma unroll
        for (int a = 0; a < 2; ++a)
#pragma unroll
            for (int b = 0; b < 2; ++b)
#pragma unroll
                for (int m = 0; m < 4; ++m)
#pragma unroll
                    for (int n = 0; n < 2; ++n) acc[a][b][m][n] = (f32x4){0.f, 0.f, 0.f, 0.f};
        cur = nxt; cA = nA; cB = nB; ++ui;
        if constexpr (ALIGN_EPI) { if (wr == 1) PG8_BAR; }
    }
    PG8_WAIT_V(0);
    if constexpr (!ALIGN_EPI) { if (wr == 0) PG8_BAR; }
    PG8_BAR;
    if constexpr (Epi::AFTER_DRAIN) { E.fused(acc, cur, wr, wc, fr, fq, lds, wid, lane); S.done(cur); }
#undef PG8_SA
#undef PG8_SB
#undef PG8_STAGE
#undef PG8_LDA
#undef PG8_LDB
#undef PG8_MMA
#undef PG8_WAIT_V
#undef PG8_WAIT_L
#undef PG8_BAR
#undef PG8_SCHED
}
}

#define LAS __attribute__((address_space(3)))
typedef unsigned short bf16;
typedef pg8::f32x4 f32x4;
typedef pg8::u32x4 u32x4;
typedef unsigned u32x2 __attribute__((ext_vector_type(2)));
typedef float f32x2_t __attribute__((ext_vector_type(2))); typedef __bf16 bf16x2_t __attribute__((ext_vector_type(2)));
__device__ __forceinline__ unsigned cvt_pk_bf16(float lo, float hi) { f32x2_t v = {lo, hi}; bf16x2_t r = __builtin_convertvector(v, bf16x2_t); return __builtin_bit_cast(unsigned, r); }
constexpr int D = 1024, BATCH = 4, SEQ = 4096, M = BATCH * SEQ, FF = 4096, DEPTH = 4;
constexpr int NWAVES = 8, NTHREADS = 512;
constexpr float RMS_EPS = 1e-6f;
constexpr size_t MiB = 1u << 20;
constexpr size_t WS_SSQ = 0;
constexpr size_t WS_BAR = 1 * MiB;
constexpr size_t WS_HB = 2 * MiB;
constexpr size_t WS_WB0 = 34 * MiB, WS_WB1 = 66 * MiB;
constexpr size_t WS_R = 98 * MiB;
constexpr size_t WS_SC = 226 * MiB;
constexpr size_t WS_SSQO = 242 * MiB;
constexpr size_t WS_END = 246 * MiB;
constexpr size_t WB_IN = 0, WB_O = 12 * MiB, WB_UP = 16 * MiB, WB_DOWN = 24 * MiB;
constexpr size_t R_O = 96 * MiB;
constexpr size_t R_V = 64 * MiB;
constexpr int LDS_BYTES = 147456;

__device__ __forceinline__ float bflo(unsigned u) { return __uint_as_float(u << 16); }
__device__ __forceinline__ float bfhi(unsigned u) { return __uint_as_float(u & 0xffff0000u); }
__device__ __forceinline__ float wave_sum(float v) {
#pragma unroll
    for (int o = 1; o < 64; o <<= 1) v += __shfl_xor(v, o);
    return v;
}
__device__ __forceinline__ float row_rs(const float* ssq, int row) {
    const f32x4* p = (const f32x4*)(ssq + (size_t)row * 16);
    const f32x4 a = p[0], b = p[1], c = p[2], d = p[3];
    const float s = (((a[0] + a[1]) + (a[2] + a[3])) + ((b[0] + b[1]) + (b[2] + b[3]))) + (((c[0] + c[1]) + (c[2] + c[3])) + ((d[0] + d[1]) + (d[2] + d[3])));
    return rsqrtf(s * (1.f / 1024.f) + RMS_EPS);
}

template <int ACT> struct EpiRowScale {
    static constexpr bool PERM = true, AFTER_DRAIN = false;
    bf16* O; int ldc; const float* ssq; int split_cols; size_t split_stride;
    const LAS float* tab; int k0, k1, k2, k3;
    __device__ __forceinline__ void operator()(const f32x4 (&acc)[2][2][4][2], const pg8::Unit& u, int wr, int wc, int fr, int fq) const {
        const int row0 = u.pm * 256 + wr * 64 + fr; int colt = u.pn * 256; bf16* base = O;
        if (split_cols) { const int t = colt / split_cols; base += (size_t)t * split_stride; colt -= t * split_cols; }
        const int col0 = colt + wc * 32 + 8 * fq;
        const int slot = (u.pm == k0) ? 0 : (u.pm == k1) ? 1 : (u.pm == k2) ? 2 : (u.pm == k3) ? 3 : -1;
#pragma unroll
        for (int ai = 0; ai < 2; ++ai)
#pragma unroll
            for (int m = 0; m < 4; ++m) {
                const int row = row0 + ai * 128 + m * 16; const float rs = slot >= 0 ? tab[slot * 256 + wr * 64 + fr + ai * 128 + m * 16] : row_rs(ssq, row);
                bf16* rowp = base + (size_t)row * ldc + col0;
#pragma unroll
                for (int bj = 0; bj < 2; ++bj) {
                    f32x4 v0 = acc[ai][bj][m][0] * rs, v1 = acc[ai][bj][m][1] * rs;
                    if (ACT == 1) {
#pragma unroll
                        for (int e = 0; e < 4; ++e) { float a = fmaxf(v0[e], 0.f), b = fmaxf(v1[e], 0.f); v0[e] = a * a; v1[e] = b * b; }
                    }
                    u32x4 w; w.x = cvt_pk_bf16(v0[0], v0[1]); w.y = cvt_pk_bf16(v0[2], v0[3]); w.z = cvt_pk_bf16(v1[0], v1[1]); w.w = cvt_pk_bf16(v1[2], v1[3]);
                    *(u32x4*)(rowp + bj * 128) = w;
                }
            }
    }
};
template <bool BASE_F32> struct EpiRes {
    static constexpr bool PERM = true, AFTER_DRAIN = false;
    const float* xbase; bf16* hb; float* ssq;
    __device__ __forceinline__ void operator()(const f32x4 (&acc)[2][2][4][2], const pg8::Unit& u, int wr, int wc, int fr, int fq) const {
        const int col0 = u.pn * 256 + wc * 32 + 8 * fq;
#pragma unroll
        for (int ai = 0; ai < 2; ++ai)
#pragma unroll
            for (int m = 0; m < 4; ++m) {
                const int row = u.pm * 256 + ai * 128 + wr * 64 + m * 16 + fr; const size_t off = (size_t)row * D + col0; float s = 0.f;
#pragma unroll
                for (int bj = 0; bj < 2; ++bj) {
                    const size_t o = off + bj * 128;
                    f32x4 v0, v1;
                    if (BASE_F32) { v0 = *(const f32x4*)(xbase + o); v1 = *(const f32x4*)(xbase + o + 4); }
                    else { const u32x4 hv = *(const u32x4*)(hb + o); v0 = (f32x4){bflo(hv.x), bfhi(hv.x), bflo(hv.y), bfhi(hv.y)}; v1 = (f32x4){bflo(hv.z), bfhi(hv.z), bflo(hv.w), bfhi(hv.w)}; }
                    v0 = v0 + acc[ai][bj][m][0]; v1 = v1 + acc[ai][bj][m][1];
                    s += ((v0[0] * v0[0] + v0[1] * v0[1]) + (v0[2] * v0[2] + v0[3] * v0[3])) + ((v1[0] * v1[0] + v1[1] * v1[1]) + (v1[2] * v1[2] + v1[3] * v1[3]));
                    u32x4 w; w.x = cvt_pk_bf16(v0[0], v0[1]); w.y = cvt_pk_bf16(v0[2], v0[3]); w.z = cvt_pk_bf16(v1[0], v1[1]); w.w = cvt_pk_bf16(v1[2], v1[3]);
                    *(u32x4*)(hb + o) = w;
                }
                s += __shfl_xor(s, 16); s += __shfl_xor(s, 32);
                if (fq == 0) ssq[(size_t)row * 16 + u.pn * 4 + wc] = s;
            }
    }
};
struct EpiGate {
    static constexpr bool PERM = true, AFTER_DRAIN = false;
    bf16* Y; const bf16* Oin; const float* ssq; const float* rmso;
    __device__ __forceinline__ void operator()(const f32x4 (&acc)[2][2][4][2], const pg8::Unit& u, int wr, int wc, int fr, int fq) const {
        const int row0 = u.pm * 256 + wr * 64 + fr; const int col0 = u.pn * 256 + wc * 32 + 8 * fq;
#pragma unroll
        for (int ai = 0; ai < 2; ++ai)
#pragma unroll
            for (int m = 0; m < 4; ++m) {
                const int row = row0 + ai * 128 + m * 16; const float rs = row_rs(ssq, row);
                float ro; { const f32x4* p = (const f32x4*)(rmso + ((size_t)row * 4 + (u.pn >> 1)) * 16); const f32x4 a = p[0], b = p[1], c = p[2], d = p[3];
                    const float s = (((a[0] + a[1]) + (a[2] + a[3])) + ((b[0] + b[1]) + (b[2] + b[3]))) + (((c[0] + c[1]) + (c[2] + c[3])) + ((d[0] + d[1]) + (d[2] + d[3]))); ro = rsqrtf(s * (1.f / 512.f) + RMS_EPS); }
#pragma unroll
                for (int bj = 0; bj < 2; ++bj) {
                    const int c = col0 + bj * 128;
                    const u32x4 ov = *(const u32x4*)(Oin + (size_t)row * 2048 + c);
                    float o8[8] = {bflo(ov.x), bfhi(ov.x), bflo(ov.y), bfhi(ov.y), bflo(ov.z), bfhi(ov.z), bflo(ov.w), bfhi(ov.w)};
                    float y8[8];
#pragma unroll
                    for (int e = 0; e < 8; ++e) { const float g = (e < 4 ? acc[ai][bj][m][0][e & 3] : acc[ai][bj][m][1][e & 3]) * rs; const float sg = g / (1.f + __expf(-g)); y8[e] = sg * o8[e] * ro; }
                    u32x4 w; w.x = cvt_pk_bf16(y8[0], y8[1]); w.y = cvt_pk_bf16(y8[2], y8[3]); w.z = cvt_pk_bf16(y8[4], y8[5]); w.w = cvt_pk_bf16(y8[6], y8[7]);
                    *(u32x4*)(Y + (size_t)row * 2048 + c) = w;
                }
            }
    }
};

struct Args { const float* in[13]; float* out; unsigned char* ws; };

struct CvItem { const float* src; bf16* dst; const float* gain; float cs; int N, K; };
__device__ __forceinline__ void cv_load(const CvItem& d, float (&r)[32]) {
#pragma unroll
    for (int i = 0; i < 32; ++i) r[i] = __builtin_nontemporal_load(d.src + (size_t)(2 * i) * d.N);
}
__device__ __forceinline__ void cv_store(const CvItem& d, const float (&r)[32], LAS float* scr, int lane) {
#pragma unroll
    for (int i = 0; i < 32; ++i) scr[(2 * i + (lane >> 5)) * 33 + (lane & 31)] = r[i] * d.cs;
    asm volatile("s_waitcnt lgkmcnt(0)" ::: "memory");
    const int c = lane & 7;
    f32x4 g0 = (f32x4){1.f, 1.f, 1.f, 1.f}, g1 = g0;
    if (d.gain) { g0 = *(const f32x4*)(d.gain + 8 * c); g1 = *(const f32x4*)(d.gain + 8 * c + 4); }
#pragma unroll
    for (int j = 0; j < 4; ++j) { const int nn = (lane >> 3) + 8 * j; const LAS float* s = scr + (8 * c) * 33 + nn;
        u32x4 o; o.x = cvt_pk_bf16(s[0 * 33] * g0[0], s[1 * 33] * g0[1]); o.y = cvt_pk_bf16(s[2 * 33] * g0[2], s[3 * 33] * g0[3]);
        o.z = cvt_pk_bf16(s[4 * 33] * g1[0], s[5 * 33] * g1[1]); o.w = cvt_pk_bf16(s[6 * 33] * g1[2], s[7 * 33] * g1[3]);
        *(u32x4*)(d.dst + (size_t)nn * d.K + 8 * c) = o; }
    asm volatile("s_waitcnt lgkmcnt(0)" ::: "memory");
}
__device__ __forceinline__ void convert_layer(const Args& a, int i, LAS unsigned char* lds, int gw, int NGW, int wave, int lane) {
    const int kind = i % 3, j = i / 3;
    const float* w_in; int n_in; const float* w_o; int k_o; int sc_lo, sc_hi; float sc;
    if (kind == 0) { w_in = a.in[4] + (size_t)j * D * 1280; n_in = 1280; w_o = a.in[6] + (size_t)j * D * D; k_o = 1024; sc_lo = 0; sc_hi = 1024; sc = 0.125f; }
    else if (kind == 1) { w_in = a.in[7] + (size_t)j * D * 3072; n_in = 3072; w_o = a.in[8] + (size_t)j * D * D; k_o = 1024; sc_lo = 0; sc_hi = 1024; sc = 0.125f * 1.4426950408889634f; }
    else { w_in = a.in[9] + (size_t)j * D * 6144; n_in = 6144; w_o = a.in[10] + (size_t)j * 2048 * D; k_o = 2048; sc_lo = 1024; sc_hi = 2048; sc = 0.0625f; }
    const float* w_up = a.in[11] + (size_t)i * D * FF; const float* w_dn = a.in[12] + (size_t)i * FF * D;
    const float* g_attn = a.in[1] + (size_t)i * D; const float* g_mlp = a.in[2] + (size_t)i * D;
    unsigned char* wb = a.ws + ((i & 1) ? WS_WB1 : WS_WB0);
    LAS float* scr = (LAS float*)(lds + wave * 16384);
    const int I_in = (D / 64) * (n_in / 32), I_o = (k_o / 64) * (D / 32), I_up = (D / 64) * (FF / 32), I_dn = (FF / 64) * (D / 32);
    const int NITEMS = I_in + I_o + I_up + I_dn;
#define CV_DECODE(dsc, itv) do { int r_ = (itv); const float* W_; int K_, N_; bf16* WT_; const float* gn_; int lo_ = 0, hi_ = 0; \
        if (r_ < I_in) { W_ = w_in; K_ = D; N_ = n_in; WT_ = (bf16*)(wb + WB_IN); gn_ = g_attn; lo_ = sc_lo; hi_ = sc_hi; } \
        else if ((r_ -= I_in) < I_o) { W_ = w_o; K_ = k_o; N_ = D; WT_ = (bf16*)(wb + WB_O); gn_ = nullptr; } \
        else if ((r_ -= I_o) < I_up) { W_ = w_up; K_ = D; N_ = FF; WT_ = (bf16*)(wb + WB_UP); gn_ = g_mlp; } \
        else { r_ -= I_up; W_ = w_dn; K_ = FF; N_ = D; WT_ = (bf16*)(wb + WB_DOWN); gn_ = nullptr; } \
        const int nblk_ = N_ / 32, kb_ = r_ / nblk_, nb_ = r_ % nblk_, k0_ = 64 * kb_, n0_ = 32 * nb_, n_ = n0_ + (lane & 31); \
        (dsc).src = W_ + (size_t)(k0_ + (lane >> 5)) * N_ + n_; (dsc).dst = WT_ + (size_t)n0_ * K_ + k0_; (dsc).gain = gn_ ? gn_ + k0_ : nullptr; \
        (dsc).cs = (n_ >= lo_ && n_ < hi_) ? sc : 1.f; (dsc).N = N_; (dsc).K = K_; } while (0)
    for (int it = gw; it < NITEMS; it += 2 * NGW) {
        CvItem d0, d1; float r0[32], r1[32];
        CV_DECODE(d0, it); cv_load(d0, r0);
        const bool two = it + NGW < NITEMS;
        if (two) { CV_DECODE(d1, it + NGW); cv_load(d1, r1); }
        cv_store(d0, r0, scr, lane);
        if (two) cv_store(d1, r1, scr, lane);
    }
#undef CV_DECODE
}

#define UNPACK8(dst, vv_) do { (dst)[0] = bflo((vv_)[0]); (dst)[1] = bfhi((vv_)[0]); (dst)[2] = bflo((vv_)[1]); (dst)[3] = bfhi((vv_)[1]); (dst)[4] = bflo((vv_)[2]); (dst)[5] = bfhi((vv_)[2]); (dst)[6] = bflo((vv_)[3]); (dst)[7] = bfhi((vv_)[3]); } while (0)
__device__ __forceinline__ void swa_naive(const bf16* qkv, const float* sinks, bf16* o, int gtid, int gthreads) {
    for (int idx = gtid; idx < M * 16; idx += gthreads) {
        const int head = idx & 15, m = idx >> 4, t = m & (SEQ - 1), kv = head >> 3;
        float q[64], acc[64];
        { const u32x4* qp = (const u32x4*)(qkv + (size_t)m * 1280 + head * 64);
#pragma unroll
          for (int c = 0; c < 8; ++c) { const u32x4 w = qp[c]; UNPACK8(q + 8 * c, w); } }
#pragma unroll
        for (int d = 0; d < 64; ++d) acc[d] = 0.f;
        const float slope = exp2f(-0.5f * (float)(head + 1));
        float mr = sinks[head], l = 1.f;
        const int s0 = t - 127 < 0 ? 0 : t - 127;
        for (int s = s0; s <= t; ++s) {
            const bf16* kp = qkv + (size_t)(m - (t - s)) * 1280 + 1024 + kv * 64; const bf16* vp = kp + 128;
            float z = 0.f;
#pragma unroll
            for (int c = 0; c < 8; ++c) { const u32x4 w = ((const u32x4*)kp)[c]; float k8[8]; UNPACK8(k8, w);
#pragma unroll
                for (int e = 0; e < 8; ++e) z += q[8 * c + e] * k8[e]; }
            z -= slope * (float)(t - s);
            const float mn = fmaxf(mr, z), corr = __expf(mr - mn), p = __expf(z - mn);
            l = l * corr + p; mr = mn;
#pragma unroll
            for (int c = 0; c < 8; ++c) { const u32x4 w = ((const u32x4*)vp)[c]; float v8[8]; UNPACK8(v8, w);
#pragma unroll
                for (int e = 0; e < 8; ++e) acc[8 * c + e] = acc[8 * c + e] * corr + p * v8[e]; }
        }
        const float inv = 1.f / l;
        u32x4* op = (u32x4*)(o + (size_t)m * 1024 + head * 64);
#pragma unroll
        for (int c = 0; c < 8; ++c) { u32x4 w; w.x = cvt_pk_bf16(acc[8 * c] * inv, acc[8 * c + 1] * inv); w.y = cvt_pk_bf16(acc[8 * c + 2] * inv, acc[8 * c + 3] * inv);
            w.z = cvt_pk_bf16(acc[8 * c + 4] * inv, acc[8 * c + 5] * inv); w.w = cvt_pk_bf16(acc[8 * c + 6] * inv, acc[8 * c + 7] * inv); op[c] = w; }
    }
}
__device__ __forceinline__ void sb_naive(const bf16* qkv, bf16* o, int gtid, int gthreads) {
    int it = 0; const bool mir = (gthreads % (SEQ * 16)) == 0;
    for (int idx = gtid; idx < M * 16; idx += gthreads, ++it) {
        const int head = idx & 15; int m = idx >> 4; int t = m & (SEQ - 1);
        if (mir && (it & 1)) { t = SEQ - 1 - t; m = (m & ~(SEQ - 1)) + t; }
        float q[64], acc[64];
        { const u32x4* qp = (const u32x4*)(qkv + (size_t)m * 3072 + head * 64);
#pragma unroll
          for (int c = 0; c < 8; ++c) { const u32x4 w = qp[c]; UNPACK8(q + 8 * c, w); } }
#pragma unroll
        for (int d = 0; d < 64; ++d) acc[d] = 0.f;
        float carry = 0.f;
        for (int s = t - 1; s >= 0; --s) {
            const bf16* kp = qkv + (size_t)(m - (t - s)) * 3072 + 1024 + head * 64; const bf16* vp = kp + 1024;
            float z = 0.f;
#pragma unroll
            for (int c = 0; c < 8; ++c) { const u32x4 w = ((const u32x4*)kp)[c]; float k8[8]; UNPACK8(k8, w);
#pragma unroll
                for (int e = 0; e < 8; ++e) z += q[8 * c + e] * k8[e]; }
            const float sp = fmaxf(z, 0.f) + __logf(1.f + __expf(-fabsf(z)));
            const float p = __expf(z - sp + carry);
            carry -= sp;
#pragma unroll
            for (int c = 0; c < 8; ++c) { const u32x4 w = ((const u32x4*)vp)[c]; float v8[8]; UNPACK8(v8, w);
#pragma unroll
                for (int e = 0; e < 8; ++e) acc[8 * c + e] += p * v8[e]; }
        }
        u32x4* op = (u32x4*)(o + (size_t)m * 1024 + head * 64);
#pragma unroll
        for (int c = 0; c < 8; ++c) { u32x4 w; w.x = cvt_pk_bf16(acc[8 * c], acc[8 * c + 1]); w.y = cvt_pk_bf16(acc[8 * c + 2], acc[8 * c + 3]);
            w.z = cvt_pk_bf16(acc[8 * c + 4], acc[8 * c + 5]); w.w = cvt_pk_bf16(acc[8 * c + 6], acc[8 * c + 7]); op[c] = w; }
    }
}
__device__ __forceinline__ void ret_naive(const bf16* qk, bf16* vo, int gtid, int gthreads) {
    for (int idx = gtid; idx < 16 * 512 * 16; idx += gthreads) {
        const int dqi = idx & 15, e = (idx >> 4) & 511, bh = idx >> 13, b = bh >> 2, h = bh & 3;
        const float gamma = 1.f - exp2f(-5.f - (float)h);
        float S[16];
#pragma unroll
        for (int j = 0; j < 16; ++j) S[j] = 0.f;
        for (int t = 0; t < SEQ; ++t) {
            const size_t row = (size_t)b * SEQ + t;
            const u32x4* qp = (const u32x4*)(qk + row * 2048 + h * 256 + dqi * 16);
            const u32x4* kp = (const u32x4*)(qk + row * 2048 + 1024 + h * 256 + dqi * 16);
            bf16* vp = vo + row * 2048 + h * 512 + e;
            const float v = __uint_as_float((unsigned)(*vp) << 16);
            float q16[16], k16[16];
            { const u32x4 w0 = qp[0], w1 = qp[1]; UNPACK8(q16, w0); UNPACK8(q16 + 8, w1); }
            { const u32x4 w0 = kp[0], w1 = kp[1]; UNPACK8(k16, w0); UNPACK8(k16 + 8, w1); }
            float part = 0.f;
#pragma unroll
            for (int j = 0; j < 16; ++j) { S[j] = gamma * S[j] + k16[j] * v; part += q16[j] * S[j]; }
            part += __shfl_xor(part, 1); part += __shfl_xor(part, 2); part += __shfl_xor(part, 4); part += __shfl_xor(part, 8);
            if (dqi == 0) *vp = (bf16)(cvt_pk_bf16(part, 0.f) & 0xffffu);
        }
    }
}

typedef short bf16x8 __attribute__((ext_vector_type(8)));
typedef short s16x4 __attribute__((ext_vector_type(4)));
typedef float f32x16 __attribute__((ext_vector_type(16)));
#define MFMA32(a, b, c) __builtin_amdgcn_mfma_f32_32x32x16_bf16((a), (b), (c), 0, 0, 0)
__device__ __forceinline__ s16x4 tr16(const LAS unsigned char* p) { return __builtin_bit_cast(s16x4, __builtin_amdgcn_ds_read_tr16_b64_v4i16((LAS s16x4*)p)); }
__device__ __forceinline__ bf16x8 pack8(const float* a) {
    u32x4 w; w.x = cvt_pk_bf16(a[0], a[1]); w.y = cvt_pk_bf16(a[2], a[3]); w.z = cvt_pk_bf16(a[4], a[5]); w.w = cvt_pk_bf16(a[6], a[7]);
    return __builtin_bit_cast(bf16x8, w);
}
constexpr int SB_ROW = 144, SB_TILE = 64 * SB_ROW;
__device__ __forceinline__ void sb_phase(const bf16* qkv, bf16* o, LAS unsigned char* lds, int vcu, int G, int tid) {
    const int lane = tid & 63, wave = __builtin_amdgcn_readfirstlane(tid >> 6), r32 = lane & 31, hi = lane >> 5;
    const int srow = tid >> 3, sch = tid & 7;
    const int i16 = lane & 15, tq = i16 >> 2, tp = i16 & 3, blk = (lane >> 4) & 1;
    const int vtr_off = (4 * hi + tq) * SB_ROW + (16 * blk + 4 * tp) * 2;
    LAS unsigned* flg = (LAS unsigned*)(lds + 4 * SB_TILE);
    for (int P = vcu; P < 512; P += G) {
        const int bh = P >> 3, jj = P & 7, b = bh >> 4, h = bh & 15;
        for (int half = 0; half < 2; ++half) {
            const int jq = half ? 15 - jj : jj;
            const size_t mb = (size_t)b * SEQ;
            const bf16* kbase = qkv + mb * 3072 + 1024 + h * 64; const bf16* vbase = kbase + 1024;
            const int tq0 = 256 * jq + 32 * wave;
            bf16x8 qf[4];
            { const bf16* qp = qkv + (mb + tq0 + r32) * 3072 + h * 64 + 8 * hi;
#pragma unroll
              for (int d0 = 0; d0 < 4; ++d0) qf[d0] = *(const bf16x8*)(qp + 16 * d0); }
            f32x16 o0, o1;
#pragma unroll
            for (int r = 0; r < 16; ++r) { o0[r] = 0.f; o1[r] = 0.f; }
            float carry = 0.f; bool mydone = false;
            const int nst = 4 * jq + 4;
            { const size_t roff = (size_t)(64 * (nst - 1) + srow) * 3072 + sch * 8;
              const u32x4 kk = *(const u32x4*)(kbase + roff), vv = *(const u32x4*)(vbase + roff);
              *(LAS u32x4*)(lds + srow * SB_ROW + sch * 16) = kk; *(LAS u32x4*)(lds + 2 * SB_TILE + srow * SB_ROW + sch * 16) = vv; }
            __syncthreads();
            for (int st = nst - 1, it = 0; st >= 0; --st, ++it) {
                const int cb = it & 1;
                const LAS unsigned char* Kb = lds + cb * SB_TILE; const LAS unsigned char* Vb = lds + 2 * SB_TILE + cb * SB_TILE;
                u32x4 kk, vv;
                if (st > 0) { const size_t roff = (size_t)(64 * (st - 1) + srow) * 3072 + sch * 8; kk = *(const u32x4*)(kbase + roff); vv = *(const u32x4*)(vbase + roff); }
                if (64 * st < tq0 + 32 && !mydone) {
                    const bool diag = (64 * st + 63 >= tq0);
#pragma unroll
                    for (int sub = 1; sub >= 0; --sub) {
                        f32x16 p;
#pragma unroll
                        for (int r = 0; r < 16; ++r) p[r] = 0.f;
                        const LAS unsigned char* kp = Kb + (32 * sub + r32) * SB_ROW + 16 * hi;
#pragma unroll
                        for (int d0 = 0; d0 < 4; ++d0) p = MFMA32(*(const LAS bf16x8*)(kp + 32 * d0), qf[d0], p);
                        float l[16]; const int sg0 = 64 * st + 32 * sub + 4 * hi, tg = tq0 + r32;
#pragma unroll
                        for (int r = 0; r < 16; ++r) {
                            const float z = p[r]; const float e = __builtin_amdgcn_exp2f(z); float lg = __builtin_amdgcn_logf(1.f + e); lg = z > 32.f ? z : lg;
                            const bool valid = !diag || (sg0 + (r & 3) + 8 * (r >> 2) < tg);
                            l[r] = valid ? -lg : 0.f;
                        }
                        float gs[4], ot[4], ps[4];
#pragma unroll
                        for (int g = 0; g < 4; ++g) { gs[g] = (l[4 * g] + l[4 * g + 1]) + (l[4 * g + 2] + l[4 * g + 3]); ot[g] = __shfl_xor(gs[g], 32); ps[g] = gs[g] + ot[g]; }
                        float T[4]; T[3] = 0.f; T[2] = ps[3]; T[1] = ps[3] + ps[2]; T[0] = T[1] + ps[1];
                        const float total = T[0] + ps[0];
                        float A[16];
#pragma unroll
                        for (int g = 0; g < 4; ++g) {
                            const float base = carry + T[g] + (hi == 0 ? ot[g] : 0.f);
                            const float i3 = base + l[4 * g + 3], i2 = i3 + l[4 * g + 2], i1 = i2 + l[4 * g + 1], i0 = i1 + l[4 * g];
                            A[4 * g + 3] = __builtin_amdgcn_exp2f(p[4 * g + 3] + i3); A[4 * g + 2] = __builtin_amdgcn_exp2f(p[4 * g + 2] + i2);
                            A[4 * g + 1] = __builtin_amdgcn_exp2f(p[4 * g + 1] + i1); A[4 * g] = __builtin_amdgcn_exp2f(p[4 * g] + i0);
                        }
                        if (diag) {
#pragma unroll
                            for (int r = 0; r < 16; ++r) A[r] = (sg0 + (r & 3) + 8 * (r >> 2) < tg) ? A[r] : 0.f;
                        }
                        carry += total;
                        const bf16x8 pf0 = pack8(A), pf1 = pack8(A + 8);
#pragma unroll
                        for (int s = 0; s < 2; ++s) {
                            const LAS unsigned char* vp = Vb + (32 * sub + 16 * s) * SB_ROW + vtr_off;
                            const s16x4 a0 = tr16(vp), a1 = tr16(vp + 8 * SB_ROW), b0 = tr16(vp + 64), b1 = tr16(vp + 64 + 8 * SB_ROW);
                            const bf16x8 vf0 = __builtin_shufflevector(a0, a1, 0, 1, 2, 3, 4, 5, 6, 7), vf1 = __builtin_shufflevector(b0, b1, 0, 1, 2, 3, 4, 5, 6, 7);
                            o0 = MFMA32(vf0, s ? pf1 : pf0, o0); o1 = MFMA32(vf1, s ? pf1 : pf0, o1);
                        }
                    }
                }
                if (64 * st < tq0 + 32) mydone = __all(carry <= -150.f);
                if (lane == 0) flg[(it & 1) * 8 + wave] = mydone ? 1u : 0u;
                if (st > 0) { LAS unsigned char* Kn = lds + (cb ^ 1) * SB_TILE; *(LAS u32x4*)(Kn + srow * SB_ROW + sch * 16) = kk; *(LAS u32x4*)(Kn + 2 * SB_TILE + srow * SB_ROW + sch * 16) = vv; }
                __syncthreads();
                { const u32x4 f0 = *(const LAS u32x4*)(flg + (it & 1) * 8), f1 = *(const LAS u32x4*)(flg + (it & 1) * 8 + 4);
                  if ((f0.x & f0.y & f0.z & f0.w & f1.x & f1.y & f1.z & f1.w) != 0u) break; }
            }
            bf16* op = o + (mb + tq0 + r32) * 1024 + h * 64 + 4 * hi;
#pragma unroll
            for (int g = 0; g < 4; ++g) {
                u32x2 w0, w1; w0.x = cvt_pk_bf16(o0[4 * g], o0[4 * g + 1]); w0.y = cvt_pk_bf16(o0[4 * g + 2], o0[4 * g + 3]);
                w1.x = cvt_pk_bf16(o1[4 * g], o1[4 * g + 1]); w1.y = cvt_pk_bf16(o1[4 * g + 2], o1[4 * g + 3]);
                *(u32x2*)(op + 8 * g) = w0; *(u32x2*)(op + 32 + 8 * g) = w1;
            }
        }
    }
}

__device__ __forceinline__ void swa_phase(const bf16* qkv, const float* sinks, bf16* o, LAS unsigned char* lds, int vcu, int G, int tid) {
    const int lane = tid & 63, wave = __builtin_amdgcn_readfirstlane(tid >> 6), r32 = lane & 31, hi = lane >> 5;
    const int i16 = lane & 15, tq = i16 >> 2, tp = i16 & 3, blk = (lane >> 4) & 1;
    const int vtr_off = (4 * hi + tq) * SB_ROW + (16 * blk + 4 * tp) * 2;
    LAS unsigned char* Kb = lds; LAS unsigned char* Vb = lds + 256 * SB_ROW;
    for (int u = vcu; u < 256; u += G) {
        const int kv = u & 1, n = (u >> 1) & 31, b = u >> 6;
        const int head = kv * 8 + wave;
        const float slope = exp2f(-0.5f * (float)(head + 1)), sink = sinks[head];
        __syncthreads();
#pragma unroll
        for (int c4 = 0; c4 < 4; ++c4) {
            const int idx = tid + NTHREADS * c4, kr = idx >> 3, ch = idx & 7;
            u32x4 kk = (u32x4){0u, 0u, 0u, 0u}, vv = kk;
            if (n > 0 || kr >= 128) { const bf16* p = qkv + ((size_t)b * SEQ + 128 * (n - 1) + kr) * 1280 + 1024 + kv * 64 + ch * 8; kk = *(const u32x4*)p; vv = *(const u32x4*)(p + 128); }
            *(LAS u32x4*)(Kb + kr * SB_ROW + ch * 16) = kk; *(LAS u32x4*)(Vb + kr * SB_ROW + ch * 16) = vv;
        }
        __syncthreads();
        for (int sb = 0; sb < 4; ++sb) {
            const size_t qrow = (size_t)b * SEQ + 128 * n + 32 * sb + r32;
            bf16x8 qf[4];
            { const bf16* qp = qkv + qrow * 1280 + head * 64 + 8 * hi;
#pragma unroll
              for (int d0 = 0; d0 < 4; ++d0) qf[d0] = *(const bf16x8*)(qp + 16 * d0); }
            const int kl = 128 + 32 * sb + r32;
            float lg[5][16]; float mx = sink;
#pragma unroll
            for (int kt = 0; kt < 5; ++kt) {
                f32x16 p;
#pragma unroll
                for (int r = 0; r < 16; ++r) p[r] = 0.f;
                const LAS unsigned char* kp = Kb + (32 * (sb + kt) + r32) * SB_ROW + 16 * hi;
#pragma unroll
                for (int d0 = 0; d0 < 4; ++d0) p = MFMA32(*(const LAS bf16x8*)(kp + 32 * d0), qf[d0], p);
#pragma unroll
                for (int r = 0; r < 16; ++r) {
                    const int kvl = 32 * (sb + kt) + (r & 3) + 8 * (r >> 2) + 4 * hi, dist = kl - kvl;
                    const bool valid = dist >= 0 && dist < 128 && (n > 0 || kvl >= 128);
                    const float v = valid ? p[r] - slope * (float)dist : -1e30f;
                    lg[kt][r] = v; mx = fmaxf(mx, v);
                }
            }
            mx = fmaxf(mx, __shfl_xor(mx, 32));
            float l = 0.f;
            f32x16 o0, o1;
#pragma unroll
            for (int r = 0; r < 16; ++r) { o0[r] = 0.f; o1[r] = 0.f; }
#pragma unroll
            for (int kt = 0; kt < 5; ++kt) {
#pragma unroll
                for (int r = 0; r < 16; ++r) { const float e = __expf(lg[kt][r] - mx); lg[kt][r] = e; l += e; }
                const bf16x8 pf0 = pack8(&lg[kt][0]), pf1 = pack8(&lg[kt][8]);
#pragma unroll
                for (int s = 0; s < 2; ++s) {
                    const LAS unsigned char* vp = Vb + (32 * (sb + kt) + 16 * s) * SB_ROW + vtr_off;
                    const s16x4 a0 = tr16(vp), a1 = tr16(vp + 8 * SB_ROW), b0 = tr16(vp + 64), b1 = tr16(vp + 64 + 8 * SB_ROW);
                    const bf16x8 vf0 = __builtin_shufflevector(a0, a1, 0, 1, 2, 3, 4, 5, 6, 7), vf1 = __builtin_shufflevector(b0, b1, 0, 1, 2, 3, 4, 5, 6, 7);
                    o0 = MFMA32(vf0, s ? pf1 : pf0, o0); o1 = MFMA32(vf1, s ? pf1 : pf0, o1);
                }
            }
            l += __shfl_xor(l, 32);
            const float inv = 1.f / (l + __expf(sink - mx));
            bf16* op = o + qrow * 1024 + head * 64 + 4 * hi;
#pragma unroll
            for (int g = 0; g < 4; ++g) {
                u32x2 w0, w1; w0.x = cvt_pk_bf16(o0[4 * g] * inv, o0[4 * g + 1] * inv); w0.y = cvt_pk_bf16(o0[4 * g + 2] * inv, o0[4 * g + 3] * inv);
                w1.x = cvt_pk_bf16(o1[4 * g] * inv, o1[4 * g + 1] * inv); w1.y = cvt_pk_bf16(o1[4 * g + 2] * inv, o1[4 * g + 3] * inv);
                *(u32x2*)(op + 8 * g) = w0; *(u32x2*)(op + 32 + 8 * g) = w1;
            }
        }
    }
}

__device__ __forceinline__ void ret_scores(bf16* qk, bf16* sc, int vcu, int G, int tid) {
    const int lane = tid & 63, wave = __builtin_amdgcn_readfirstlane(tid >> 6), r32 = lane & 31, hi = lane >> 5;
    const int it = wave >> 1, jh = wave & 1;
    for (int u = vcu; u < 512; u += G) {
        const int bh = u >> 5, n = u & 31, b = bh >> 2, h = bh & 3;
        const float lg = log2f(1.f - exp2f(-5.f - (float)h));
        const size_t row0 = (size_t)b * SEQ + n * 128;
        const bf16* qp = qk + (row0 + 32 * it + r32) * 2048 + h * 256 + 8 * hi;
        bf16x8 qf[16];
#pragma unroll
        for (int ks = 0; ks < 16; ++ks) qf[ks] = *(const bf16x8*)(qp + 16 * ks);
#pragma unroll
        for (int jt2 = 0; jt2 < 2; ++jt2) {
            const int jt = 2 * jh + jt2;
            if (jt <= it) {
                const bf16* kp = qk + (row0 + 32 * jt + r32) * 2048 + 1024 + h * 256 + 8 * hi;
                f32x16 p;
#pragma unroll
                for (int r = 0; r < 16; ++r) p[r] = 0.f;
#pragma unroll
                for (int ks = 0; ks < 16; ++ks) p = MFMA32(*(const bf16x8*)(kp + 16 * ks), qf[ks], p);
                const int i = 32 * it + r32;
                bf16* sp = sc + (size_t)u * 16384 + (size_t)(it * 8 + 2 * jt) * 512 + r32 * 8 + 4 * hi;
#pragma unroll
                for (int g = 0; g < 4; ++g) {
                    float v[4];
#pragma unroll
                    for (int e = 0; e < 4; ++e) { const int j = 32 * jt + 8 * g + 4 * hi + e; v[e] = (i >= j) ? p[4 * g + e] * exp2f((float)(i - j) * lg) : 0.f; }
                    u32x2 w; w.x = cvt_pk_bf16(v[0], v[1]); w.y = cvt_pk_bf16(v[2], v[3]);
                    *(u32x2*)(sp + (g >> 1) * 512 + (g & 1) * 256) = w;
                }
            }
        }
        __syncthreads();
        if (jh == 0) {
            char* qc = (char*)(qk + row0 * 2048 + h * 256) + (size_t)(it * 32 + hi) * 4096 + r32 * 16;
#pragma unroll
            for (int ks = 0; ks < 16; ++ks) *(bf16x8*)(qc + ks * 8192) = qf[ks];
        }
    }
}
constexpr int RT_ST_ROW = 528, RT_V_ROW = 80, RT_K_ROW = 144;
constexpr int RT_OFF_ST = 0, RT_OFF_V = 32 * RT_ST_ROW, RT_OFF_VD = RT_OFF_V + 128 * RT_V_ROW, RT_OFF_K = RT_OFF_VD + 128 * RT_V_ROW, RT_SLAB = 64 * RT_K_ROW;
__device__ __forceinline__ void ret_scan(const bf16* qk, bf16* vo, const bf16* sc, float* ssqo, LAS unsigned char* lds, int vcu, int G, int tid) {
    const int lane = tid & 63, wave = __builtin_amdgcn_readfirstlane(tid >> 6), r32 = lane & 31, hi = lane >> 5;
    const int i16 = lane & 15, tq = i16 >> 2, tp = i16 & 3, blk = (lane >> 4) & 1;
    const int trv = (8 * hi + tq) * RT_V_ROW + (16 * blk + 4 * tp) * 2, trk = (8 * hi + tq) * RT_K_ROW + (16 * blk + 4 * tp) * 2;
    const int vj = tid >> 2, vch = tid & 3;
    const int krj = lane >> 3, kch = lane & 7, uw = wave & 3;
    const bool owave = wave < 4;
    LAS unsigned char* slab = lds + RT_OFF_K + uw * RT_SLAB;
    for (int u = vcu; u < 256; u += G) {
        const int bh = u >> 4, es = u & 15, b = bh >> 2, h = bh & 3, e0 = 32 * es;
        const float lg = log2f(1.f - exp2f(-5.f - (float)h)), cdec = exp2f(128.f * lg);
        const float kd = exp2f((float)(127 - vj) * lg);
        const size_t rowb = (size_t)b * SEQ;
        const int i = 32 * uw + r32;
        const float qd = exp2f((float)(i + 1) * lg);
        f32x16 st0, st1;
#pragma unroll
        for (int r = 0; r < 16; ++r) { st0[r] = 0.f; st1[r] = 0.f; }
        u32x4 kreg[16], vreg; bf16x8 qreg[16], sreg[8];
        unsigned offq = (unsigned)(hi * 4096 + r32 * 16), offs = (unsigned)(lane * 16), offk = (unsigned)(krj * 2048 + 8 * kch) * 2u, offv = (unsigned)(vj * 2048 + 8 * vch) * 2u;
        unsigned offo = (unsigned)(i * 2048 + 4 * hi) * 2u, offsq = (unsigned)(i * 64) * 4u;
        const char* const qbase = (const char*)(qk + rowb * 2048 + h * 256);
        const char* const kbase = (const char*)(qk + rowb * 2048 + 1024 + h * 256 + 64 * uw);
        const char* const sbase = (const char*)(sc + (size_t)(bh * 32) * 16384);
        char* const vbase = (char*)(vo + rowb * 2048 + h * 512 + e0);
        char* const sqbase = (char*)(ssqo + (rowb * 4 + h) * 16 + es);
#define RT_LOAD_K(nn, half) do { const char* kb_ = kbase + (size_t)(128 * (nn) + 64 * (half)) * 4096; _Pragma("unroll") for (int c8 = 0; c8 < 8; ++c8) \
            kreg[8 * (half) + c8] = *(const u32x4*)(kb_ + c8 * 32768 + offk); } while (0)
#define RT_LOAD_QS(nn) do { const char* qb_ = qbase + (size_t)(128 * (nn) + 32 * uw) * 4096; \
            _Pragma("unroll") for (int ks = 0; ks < 16; ++ks) qreg[ks] = *(const bf16x8*)(qb_ + 8192 * ks + offq); \
            const char* sb_ = sbase + (size_t)(nn) * 32768 + uw * 8192; \
            _Pragma("unroll") for (int ks = 0; ks < 8; ++ks) if (ks < 2 * uw + 2) sreg[ks] = *(const bf16x8*)(sb_ + 1024 * ks + offs); } while (0)
#define RT_LOAD_V(nn) do { vreg = *(const u32x4*)(vbase + (size_t)(128 * (nn)) * 4096 + offv); } while (0)
#define RT_WRITE_V() do { *(LAS u32x4*)(lds + RT_OFF_V + vj * RT_V_ROW + vch * 16) = vreg; float f8[8]; UNPACK8(f8, vreg); \
            u32x4 wd; wd.x = cvt_pk_bf16(f8[0] * kd, f8[1] * kd); wd.y = cvt_pk_bf16(f8[2] * kd, f8[3] * kd); wd.z = cvt_pk_bf16(f8[4] * kd, f8[5] * kd); wd.w = cvt_pk_bf16(f8[6] * kd, f8[7] * kd); \
            *(LAS u32x4*)(lds + RT_OFF_VD + vj * RT_V_ROW + vch * 16) = wd; } while (0)
        __syncthreads();
        for (int x = tid * 16; x < 32 * RT_ST_ROW; x += NTHREADS * 16) *(LAS u32x4*)(lds + RT_OFF_ST + x) = (u32x4){0u, 0u, 0u, 0u};
        RT_LOAD_V(0); RT_WRITE_V();
#define RT_BAR() do { asm volatile("s_waitcnt lgkmcnt(0)" ::: "memory"); __builtin_amdgcn_s_barrier(); asm volatile("" ::: "memory"); } while (0)
        if (owave) {
            RT_LOAD_QS(0);
            for (int n = 0; n < 32; ++n) {
                RT_BAR();
                asm volatile("" : "+v"(offq), "+v"(offs), "+v"(offv), "+v"(offo), "+v"(offsq));
                if (n < 31) RT_LOAD_V(n + 1);
                f32x16 oc, oi;
#pragma unroll
                for (int r = 0; r < 16; ++r) { oc[r] = 0.f; oi[r] = 0.f; }
                const LAS unsigned char* sp = lds + RT_OFF_ST + r32 * RT_ST_ROW + 16 * hi;
#pragma unroll
                for (int ks = 0; ks < 16; ++ks) oc = MFMA32(*(const LAS bf16x8*)(sp + 32 * ks), qreg[ks], oc);
#pragma unroll
                for (int ks = 0; ks < 8; ++ks) if (ks < 2 * uw + 2) {
                    const LAS unsigned char* vp = lds + RT_OFF_V + 16 * ks * RT_V_ROW + trv;
                    const s16x4 a0 = tr16(vp), a1 = tr16(vp + 4 * RT_V_ROW);
                    const bf16x8 vf = __builtin_shufflevector(a0, a1, 0, 1, 2, 3, 4, 5, 6, 7);
                    oi = MFMA32(vf, sreg[ks], oi);
                }
                if (n < 31) RT_LOAD_QS(n + 1);
                float s = 0.f;
                char* const op = vbase + (size_t)(128 * n) * 4096 + offo;
#pragma unroll
                for (int g = 0; g < 4; ++g) {
                    float v[4];
#pragma unroll
                    for (int e = 0; e < 4; ++e) { v[e] = oi[4 * g + e] + qd * oc[4 * g + e]; s += v[e] * v[e]; }
                    u32x2 w; w.x = cvt_pk_bf16(v[0], v[1]); w.y = cvt_pk_bf16(v[2], v[3]);
                    *(u32x2*)(op + 16 * g) = w;
                }
                s += __shfl_xor(s, 32);
                if (hi == 0) *(float*)(sqbase + (size_t)(128 * n) * 256 + offsq) = s;
                RT_BAR();
                if (n < 31) RT_WRITE_V();
            }
        } else {
            RT_LOAD_K(0, 0); RT_LOAD_K(0, 1);
            for (int n = 0; n < 32; ++n) {
                RT_BAR();
                asm volatile("" : "+v"(offk), "+v"(offv));
                if (n < 31) RT_LOAD_V(n + 1);
#pragma unroll
                for (int r = 0; r < 16; ++r) { st0[r] *= cdec; st1[r] *= cdec; }
#pragma unroll
                for (int half = 0; half < 2; ++half) {
#pragma unroll
                    for (int c8 = 0; c8 < 8; ++c8) *(LAS u32x4*)(slab + (krj + 8 * c8) * RT_K_ROW + kch * 16) = kreg[8 * half + c8];
                    if (n < 31) { if (half == 0) RT_LOAD_K(n + 1, 0); else RT_LOAD_K(n + 1, 1); }
#pragma unroll
                    for (int ks = 0; ks < 4; ++ks) {
                        const LAS unsigned char* kp = slab + 16 * ks * RT_K_ROW + trk;
                        const LAS unsigned char* vp = lds + RT_OFF_VD + (64 * half + 16 * ks) * RT_V_ROW + trv;
                        const s16x4 v0 = tr16(vp), v1 = tr16(vp + 4 * RT_V_ROW);
                        const s16x4 k0 = tr16(kp), k1 = tr16(kp + 4 * RT_K_ROW), k2 = tr16(kp + 64), k3 = tr16(kp + 64 + 4 * RT_K_ROW);
                        const bf16x8 vf = __builtin_shufflevector(v0, v1, 0, 1, 2, 3, 4, 5, 6, 7);
                        const bf16x8 kf0 = __builtin_shufflevector(k0, k1, 0, 1, 2, 3, 4, 5, 6, 7), kf1 = __builtin_shufflevector(k2, k3, 0, 1, 2, 3, 4, 5, 6, 7);
                        st0 = MFMA32(kf0, vf, st0); st1 = MFMA32(kf1, vf, st1);
                    }
                }
                RT_BAR();
                { LAS unsigned char* wp = lds + RT_OFF_ST + r32 * RT_ST_ROW + (64 * uw + 4 * hi) * 2;
#pragma unroll
                  for (int g = 0; g < 4; ++g) {
                    u32x2 w0, w1; w0.x = cvt_pk_bf16(st0[4 * g], st0[4 * g + 1]); w0.y = cvt_pk_bf16(st0[4 * g + 2], st0[4 * g + 3]);
                    w1.x = cvt_pk_bf16(st1[4 * g], st1[4 * g + 1]); w1.y = cvt_pk_bf16(st1[4 * g + 2], st1[4 * g + 3]);
                    *(LAS u32x2*)(wp + 16 * g) = w0; *(LAS u32x2*)(wp + 64 + 16 * g) = w1;
                  } }
                if (n < 31) RT_WRITE_V();
            }
        }
#undef RT_BAR
#undef RT_LOAD_K
#undef RT_LOAD_QS
#undef RT_LOAD_V
#undef RT_WRITE_V
    }
}

#define XB_TMO      128
#define XB_XCNT(j)  (256  + 64 * (j))
#define XB_XSUB(j)  (1280 + 64 * (j))
#define XB_XGEN(j)  (2304 + 64 * (j))
#define XB_TOP      3328
#define XB_TOPGEN   3392
#define XCD_BAR_WORDS 3456
#define XB_SPIN_CAP (1u << 18)

__device__ __forceinline__ unsigned xb_ld(unsigned* p)              { return __hip_atomic_load(p, __ATOMIC_RELAXED, __HIP_MEMORY_SCOPE_AGENT); }
__device__ __forceinline__ unsigned xb_add(unsigned* p, unsigned v) { return __hip_atomic_fetch_add(p, v, __ATOMIC_RELAXED, __HIP_MEMORY_SCOPE_AGENT); }
__device__ __forceinline__ unsigned xb_xcc_id() { return (unsigned)__builtin_amdgcn_s_getreg((3 << 11) | 20) & 0xFu; }
#define XB_SPIN(cond, bar) do { unsigned _sp = 0; while (cond) { __builtin_amdgcn_s_sleep(1); \
    if ((++_sp & 255u) == 0u) { if (xb_ld(&(bar)[XB_TMO])) break; if (_sp > XB_SPIN_CAP) { atomicAdd(&(bar)[XB_TMO], 1u); break; } } } } while (0)

struct XcdBarrier {
    unsigned* bar; unsigned x;
    volatile LAS unsigned* st;
};

__device__ __forceinline__ XcdBarrier xcd_barrier_post(unsigned* bar, volatile LAS unsigned* st) {
    XcdBarrier b; b.bar = bar; b.x = xb_xcc_id(); b.st = st;
    if (threadIdx.x == 0) (void)xb_add(&bar[XB_XCNT(b.x)], 1u);
    return b;
}
__device__ __forceinline__ void xcd_barrier_complete(unsigned* bar, unsigned x, unsigned& nloc, unsigned& nx) {
    const unsigned G = gridDim.x * gridDim.y * gridDim.z;
    unsigned sum, cnt, mine, sp = 0u;
    for (;;) {
        sum = 0u; cnt = 0u; mine = 0u;
#pragma unroll
        for (unsigned j = 0; j < 16; ++j) { const unsigned c = xb_ld(&bar[XB_XCNT(j)]); sum += c; cnt += (c > 0u) ? 1u : 0u; mine = (j == x) ? c : mine; }
        if (sum == G) break;
        __builtin_amdgcn_s_sleep(1);
        if ((++sp & 255u) == 0u) { if (xb_ld(&bar[XB_TMO])) break; if (sp > XB_SPIN_CAP) { atomicAdd(&bar[XB_TMO], 1u); break; } }
    }
    nloc = mine > 0u ? mine : 1u; nx = cnt > 0u ? cnt : 1u;
}

__device__ __forceinline__ void xcd_barrier(const XcdBarrier& b) {
    asm volatile("s_waitcnt vmcnt(0)" ::: "memory");
    __syncthreads();
    if (threadIdx.x == 0) {
        unsigned* bar = b.bar;
        __builtin_amdgcn_s_waitcnt(0);
        unsigned nloc = b.st[0], nx = b.st[1];
        if (nloc == 0u) { xcd_barrier_complete(bar, b.x, nloc, nx); b.st[0] = nloc; b.st[1] = nx; }
        const unsigned old = xb_add(&bar[XB_XSUB(b.x)], 1u);
        const unsigned gen = old / nloc;
        if (old + 1u == (gen + 1u) * nloc) {
            __builtin_amdgcn_fence(__ATOMIC_RELEASE, "agent");
            asm volatile("s_waitcnt vmcnt(0)" ::: "memory");
            const unsigned og = xb_add(&bar[XB_TOP], 1u);
            const unsigned tg = og / nx;
            if (og + 1u == (tg + 1u) * nx) xb_add(&bar[XB_TOPGEN], 1u);
            else XB_SPIN(xb_ld(&bar[XB_TOPGEN]) == tg, bar);
            __builtin_amdgcn_fence(__ATOMIC_ACQUIRE, "agent");
            xb_add(&bar[XB_XGEN(b.x)], 1u);
            asm volatile("s_waitcnt vmcnt(0)" ::: "memory");
        } else {
            XB_SPIN(xb_ld(&bar[XB_XGEN(b.x)]) == gen, bar);
            __builtin_amdgcn_fence(__ATOMIC_ACQUIRE, "agent");
            asm volatile("s_waitcnt vmcnt(0)" ::: "memory");
        }
    }
    __syncthreads();
}

#define FILL_RS_TABLE(S_, kk_) do { _Pragma("unroll") for (int ui_ = 0; ui_ < 4; ++ui_) { pg8::Unit u_; kk_[ui_] = -1; \
        if (S_.next(ui_, u_)) { kk_[ui_] = u_.pm; if (tl_ < 256) rstab[ui_ * 256 + tl_] = row_rs(ssq, u_.pm * 256 + tl_); } } __syncthreads(); } while (0)
__global__ void __launch_bounds__(NTHREADS, 2) mega(Args a) {
    extern __shared__ __attribute__((aligned(16))) unsigned char lds_raw[];
    LAS unsigned char* lds = (LAS unsigned char*)lds_raw;
    cg::grid_group grid = cg::this_grid();
    const int tid = threadIdx.x, lane0 = tid & 63, wave = __builtin_amdgcn_readfirstlane(tid >> 6);
    const int G = gridDim.x, bx = blockIdx.x;
    const int gw = bx * NWAVES + wave, NGW = G * NWAVES, gthreads = G * NTHREADS;
    const int vcu = (G % 8 == 0) ? (bx % 8) * (G / 8) + bx / 8 : bx;
    unsigned char* ws = a.ws;
    float* ssq = (float*)(ws + WS_SSQ); bf16* hb = (bf16*)(ws + WS_HB);
    unsigned char* R = ws + WS_R;

    volatile LAS unsigned* xb_st = (volatile LAS unsigned*)(lds + 131072 + 64);
    LAS float* rstab = (LAS float*)(lds + 131072 + 256);
    if (tid < 2) xb_st[tid] = 0u;
    unsigned* barw = (unsigned*)(ws + WS_BAR);
    __syncthreads();
    const XcdBarrier xbar = xcd_barrier_post(barw, xb_st);
    convert_layer(a, 0, lds, gw, NGW, wave, lane0);
    for (int m = gw; m < M; m += 2 * NGW) {
        const int lane = lane0; const int m1 = m + NGW; const bool two = m1 < M;
        const f32x4* xr0 = (const f32x4*)(a.in[0] + (size_t)m * D) + lane; const f32x4* xr1 = (const f32x4*)(a.in[0] + (size_t)(two ? m1 : m) * D) + lane;
        f32x4 v0[4], v1[4];
#pragma unroll
        for (int j = 0; j < 4; ++j) { v0[j] = __builtin_nontemporal_load(xr0 + 64 * j); v1[j] = __builtin_nontemporal_load(xr1 + 64 * j); }
        float s0 = 0.f, s1 = 0.f;
        unsigned long long* o0 = (unsigned long long*)(hb + (size_t)m * D) + lane; unsigned long long* o1 = (unsigned long long*)(hb + (size_t)m1 * D) + lane;
#pragma unroll
        for (int j = 0; j < 4; ++j) {
            s0 += (v0[j][0] * v0[j][0] + v0[j][1] * v0[j][1]) + (v0[j][2] * v0[j][2] + v0[j][3] * v0[j][3]);
            s1 += (v1[j][0] * v1[j][0] + v1[j][1] * v1[j][1]) + (v1[j][2] * v1[j][2] + v1[j][3] * v1[j][3]);
            o0[64 * j] = (unsigned long long)cvt_pk_bf16(v0[j][0], v0[j][1]) | ((unsigned long long)cvt_pk_bf16(v0[j][2], v0[j][3]) << 32);
            if (two) o1[64 * j] = (unsigned long long)cvt_pk_bf16(v1[j][0], v1[j][1]) | ((unsigned long long)cvt_pk_bf16(v1[j][2], v1[j][3]) << 32);
        }
        s0 = wave_sum(s0); s1 = wave_sum(s1);
        if (lane < 16) { ssq[(size_t)m * 16 + lane] = (lane == 0) ? s0 : 0.f; if (two) ssq[(size_t)m1 * 16 + lane] = (lane == 0) ? s1 : 0.f; }
    }
    if (a.ws == nullptr) grid.sync();
    xcd_barrier(xbar);

    for (int i = 0; i < DEPTH; ++i) {
        const int kind = i % 3, j = i / 3;
        unsigned char* wb = ws + ((i & 1) ? WS_WB1 : WS_WB0);
        int tl_ = threadIdx.x; asm volatile("" : "+v"(tl_));
        const int lane = tl_ & 63, gtid = bx * NTHREADS + tl_;
        {
            const int n_in = kind == 0 ? 1280 : (kind == 1 ? 3072 : 4096);
            pg8::Gemm g{hb, (const bf16*)(wb + WB_IN), M, n_in, D}; pg8::StaticOrder S; S.init(M, n_in, G, bx);
            int kk[4]; FILL_RS_TABLE(S, kk);
            EpiRowScale<0> E{(bf16*)R, kind == 2 ? 2048 : n_in, ssq, kind == 2 ? 2048 : 0, (size_t)(R_V / 2), rstab, kk[0], kk[1], kk[2], kk[3]};
            pg8::gemm_phase<EpiRowScale<0>, pg8::StaticOrder, true, true>(lds, g, S, E);
        }
        xcd_barrier(xbar);
        if (i + 1 < DEPTH) { convert_layer(a, i + 1, lds, gw, NGW, wave, lane); __syncthreads(); }
        if (kind == 0) swa_phase((const bf16*)R, a.in[5] + j * 16, (bf16*)(R + R_O), lds, vcu, G, tl_);
        else if (kind == 1) sb_phase((const bf16*)R, (bf16*)(R + R_O), lds, vcu, G, tl_);
        else {
            ret_scores((bf16*)R, (bf16*)(ws + WS_SC), vcu, G, tl_);
            xcd_barrier(xbar);
            ret_scan((const bf16*)R, (bf16*)(R + R_V), (const bf16*)(ws + WS_SC), (float*)(ws + WS_SSQO), lds, vcu, G, tl_);
            xcd_barrier(xbar);
            pg8::Gemm g{hb, (const bf16*)(wb + WB_IN) + (size_t)4096 * D, M, 2048, D}; pg8::StaticOrder S; S.init(M, 2048, G, bx);
            EpiGate E{(bf16*)R, (const bf16*)(R + R_V), ssq, (const float*)(ws + WS_SSQO)};
            pg8::gemm_phase<EpiGate, pg8::StaticOrder, true, true>(lds, g, S, E);
        }
        xcd_barrier(xbar);
        {
            const int k_o = kind == 2 ? 2048 : 1024;
            pg8::Gemm g{kind == 2 ? (const bf16*)R : (const bf16*)(R + R_O), (const bf16*)(wb + WB_O), M, D, k_o}; pg8::StaticOrder S; S.init(M, D, G, bx);
            EpiRes<false> E{nullptr, hb, ssq}; pg8::gemm_phase<EpiRes<false>, pg8::StaticOrder, true, true>(lds, g, S, E);
        }
        xcd_barrier(xbar);
        {
            pg8::Gemm g{hb, (const bf16*)(wb + WB_UP), M, FF, D}; pg8::StaticOrder S; S.init(M, FF, G, bx);
            int kk[4]; FILL_RS_TABLE(S, kk);
            EpiRowScale<1> E{(bf16*)R, FF, ssq, 0, 0, rstab, kk[0], kk[1], kk[2], kk[3]};
            pg8::gemm_phase<EpiRowScale<1>, pg8::StaticOrder, true, true>(lds, g, S, E);
        }
        xcd_barrier(xbar);
        {
            pg8::Gemm g{(const bf16*)R, (const bf16*)(wb + WB_DOWN), M, D, FF}; pg8::StaticOrder S; S.init(M, D, G, bx);
            EpiRes<false> E{nullptr, hb, ssq};
            pg8::gemm_phase<EpiRes<false>, pg8::StaticOrder, true, true>(lds, g, S, E);
        }
        xcd_barrier(xbar);
    }
    for (int m = gw; m < M; m += NGW) {
        const float rs = row_rs(ssq, m); const int lane = lane0;
        const u32x4* hr = (const u32x4*)(hb + (size_t)m * D) + lane; const f32x4* gr = (const f32x4*)a.in[3] + 2 * lane; f32x4* orow = (f32x4*)(a.out + (size_t)m * D) + 2 * lane;
#pragma unroll
        for (int jj = 0; jj < 2; ++jj) { const u32x4 hv = hr[64 * jj]; const f32x4 g0 = gr[128 * jj], g1 = gr[128 * jj + 1];
            const f32x4 v0 = (f32x4){bflo(hv.x), bfhi(hv.x), bflo(hv.y), bfhi(hv.y)}, v1 = (f32x4){bflo(hv.z), bfhi(hv.z), bflo(hv.w), bfhi(hv.w)};
            __builtin_nontemporal_store(v0 * rs * g0, orow + 128 * jj); __builtin_nontemporal_store(v1 * rs * g1, orow + 128 * jj + 1); }
    }
}

extern "C" void kernel_launch(void* const* d_in, const int* in_sizes, int n_in, void* d_out, int out_size, void* d_ws, size_t ws_size, hipStream_t stream) {
    static int grid = 0;
    if (grid == 0) {
        if (n_in != 13 || out_size != M * D || ws_size < WS_END) { fprintf(stderr, "kernel_launch: unexpected shapes (n_in %d out %d ws %zu)\n", n_in, out_size, ws_size); grid = -1; return; }
        int dev = 0, cus = 0, per_cu = 0;
        hipGetDevice(&dev); hipDeviceGetAttribute(&cus, hipDeviceAttributeMultiprocessorCount, dev);
        hipFuncSetAttribute((const void*)mega, hipFuncAttributeMaxDynamicSharedMemorySize, LDS_BYTES);
        if (hipOccupancyMaxActiveBlocksPerMultiprocessor(&per_cu, (const void*)mega, NTHREADS, LDS_BYTES) != hipSuccess || per_cu < 1) { fprintf(stderr, "kernel_launch: occupancy query gave %d\n", per_cu); per_cu = 1; }
        (void)hipGetLastError();
        grid = cus * per_cu;
        fprintf(stderr, "kernel_launch: grid %d (cus %d x %d)\n", grid, cus, per_cu);
    }
    if (grid < 0) return;
    Args a{};
    for (int i = 0; i < 13; ++i) a.in[i] = (const float*)d_in[i];
    a.out = (float*)d_out; a.ws = (unsigned char*)d_ws;
    if (hipMemsetAsync((char*)d_ws + WS_BAR, 0, XCD_BAR_WORDS * 4, stream) != hipSuccess) { fprintf(stderr, "kernel_launch: memset of the barrier words failed\n"); return; }
    void* args[] = {&a};
    hipError_t e = hipLaunchCooperativeKernel((const void*)mega, dim3(grid), dim3(NTHREADS), args, LDS_BYTES, stream);
    if (e != hipSuccess) fprintf(stderr, "cooperative launch failed: %s (grid %d)\n", hipGetErrorString(e), grid);
}
```

```cpp
#include <hip/hip_runtime.h>
#include <hip/hip_cooperative_groups.h>
#include <cstdio>
#include <cstdint>
namespace cg = cooperative_groups;
namespace pg8 {
#define PG8_LAS __attribute__((address_space(3)))
typedef unsigned short bf16_t;
typedef short bf16x8 __attribute__((ext_vector_type(8)));
typedef float f32x4 __attribute__((ext_vector_type(4)));
typedef unsigned u32x4 __attribute__((ext_vector_type(4)));
constexpr int BM = 256, BK = 64, HALF = 128, HTB = HALF * BK * 2  , STAGE_BYTES = 8 * HTB, NXCD = 8, WGM = 8;

__host__ __device__ __forceinline__ int lds_byte(int r, int c) { const int st = (r >> 4) * 2 + (c >> 5), rr = r & 15, cc = c & 31, ob = rr * 64 + cc * 2; return st * 1024 + (ob ^ (((ob >> 9) & 1) << 5)); }
__host__ __device__ __forceinline__ void stage_rc(int b, int& R, int& C) { const int st = b / 1024, sb = b % 1024, swz = sb ^ (((sb >> 9) & 1) << 5); R = (st >> 1) * 16 + swz / 64; C = (st & 1) * 32 + (swz % 64) / 2; }
__host__ __device__ __forceinline__ int perm32(int rho) { const int n = rho >> 4, i = rho & 15; return 8 * (i >> 2) + 4 * n + (i & 3); }

struct Unit { int pm, pn; };
struct Gemm { const bf16_t* A; const bf16_t* Bt; int M, N, K; };

struct StaticOrder {
    int nM, nN, nwg, G, c;
    __host__ __device__ void init(int M, int N, int G_, int c_) { nM = M / BM; nN = N / BM; nwg = nM * nN; G = G_; c = c_; }
    __host__ __device__ bool next(int i, Unit& u) const {
        const long L = (long)i * G + c; if (L >= nwg) return false;
        int wgid = (int)L; { const int q = nwg / NXCD, r = nwg % NXCD, xcd = wgid % NXCD, off = wgid / NXCD; wgid = (xcd < r ? xcd * (q + 1) : r * (q + 1) + (xcd - r) * q) + off; }
        const int nig = WGM * nN, gid = wgid / nig, fm = gid * WGM, gsz = (nM - fm) < WGM ? (nM - fm) : WGM;
        u.pm = fm + ((wgid % nig) % gsz); u.pn = (wgid % nig) / gsz; return true;
    }
    __device__ __forceinline__ void a_ready(const Unit&) const {}
    __device__ __forceinline__ void done(const Unit&) const {}
};

__device__ __forceinline__ unsigned cvt_pk_bf16(float lo, float hi) { unsigned r; asm volatile("v_cvt_pk_bf16_f32 %0, %1, %2" : "=v"(r) : "v"(lo), "v"(hi)); return r; }
typedef float f32x2 __attribute__((ext_vector_type(2)));
__device__ __forceinline__ f32x2 gelu_pk(f32x2 v) {
    const f32x2 av = __builtin_elementwise_abs(v), d = av * 0.2316418882f + 1.0f;
    f32x2 t; t.x = __builtin_amdgcn_rcpf(d.x); t.y = __builtin_amdgcn_rcpf(d.y);
    f32x2 q = t * 0.5307027145f + (-0.7265760135f); q = q * t + 0.7107068705f; q = q * t + (-0.142248368f); q = q * t + 0.127414796f; q = q * t;
    const f32x2 s = (v * v) * (-0.72134752044f);
    f32x2 e; e.x = __builtin_amdgcn_exp2f(s.x); e.y = __builtin_amdgcn_exp2f(s.y);
    const f32x2 m = v * (q * e), r = v - m;
    f32x2 o; o.x = v.x < 0.f ? m.x : r.x; o.y = v.y < 0.f ? m.y : r.y; return o;
}

template <int ACT  > struct EpiBf16 {
    static constexpr bool PERM = true, AFTER_DRAIN = false; static_assert(ACT == 0 || ACT == 1, "EpiBf16: ACT is 0 (none) or 1 (gelu_pk)");
    bf16_t* O; int ldc; const float* bias; int split_cols; size_t split_stride; float scale0;
    __device__ __forceinline__ void operator()(const f32x4 (&acc)[2][2][4][2], const Unit& u, int wr, int wc, int fr, int fq) const {
        const int row0 = u.pm * BM + wr * 64 + fr; int colt = u.pn * BM; bf16_t* base = O;
        float sc = 1.f; if (split_cols) { const int t = colt / split_cols; base += (size_t)t * split_stride; colt -= t * split_cols; if (t == 0) sc = scale0; }
        const int col0 = colt + wc * 32 + 8 * fq, bcol0 = u.pn * BM + wc * 32 + 8 * fq;
        f32x4 bv[2][2];
#pragma unroll
        for (int bj = 0; bj < 2; ++bj)
#pragma unroll
            for (int n = 0; n < 2; ++n) bv[bj][n] = bias ? *(const f32x4*)(bias + bcol0 + bj * HALF + 4 * n) : (f32x4){0.f, 0.f, 0.f, 0.f};
#pragma unroll
        for (int ai = 0; ai < 2; ++ai)
#pragma unroll
            for (int m = 0; m < 4; ++m) { bf16_t* rowp = base + (size_t)(row0 + ai * HALF + m * 16) * ldc + col0;
#pragma unroll
                for (int bj = 0; bj < 2; ++bj) { f32x4 v0 = acc[ai][bj][m][0] + bv[bj][0], v1 = acc[ai][bj][m][1] + bv[bj][1];
                    if (ACT == 1) { f32x2 a = gelu_pk((f32x2){v0[0], v0[1]}), b = gelu_pk((f32x2){v0[2], v0[3]}), c = gelu_pk((f32x2){v1[0], v1[1]}), d = gelu_pk((f32x2){v1[2], v1[3]});
                        v0 = (f32x4){a.x, a.y, b.x, b.y}; v1 = (f32x4){c.x, c.y, d.x, d.y}; }
                    v0 = v0 * sc; v1 = v1 * sc; u32x4 w; w.x = cvt_pk_bf16(v0[0], v0[1]); w.y = cvt_pk_bf16(v0[2], v0[3]); w.z = cvt_pk_bf16(v1[0], v1[1]); w.w = cvt_pk_bf16(v1[2], v1[3]);
                    *(u32x4*)(rowp + bj * HALF) = w; } }
    }
};

template <class Epi, class Sched, bool ALIGN_EPI = false, bool SP2 = false>
__device__ __forceinline__ void gemm_phase(PG8_LAS unsigned char* lds, const Gemm g, const Sched& S, const Epi& E) {
    int tid_ = threadIdx.x; asm volatile("" : "+v"(tid_));
    const int tid = tid_, wid = __builtin_amdgcn_readfirstlane(tid >> 6), lane = tid & 63, wr = wid >> 2, wc = wid & 3, fr = lane & 15, fq = lane >> 4;
    const int K = g.K, nt = K / BK;
    unsigned voffA[2], voffB[2];
#pragma unroll
    for (int i = 0; i < 2; ++i) { int R, C; stage_rc(tid * 16 + i * 8192, R, C); const int Rb = Epi::PERM ? ((R & ~31) + perm32(R & 31)) : R;
        voffA[i] = (unsigned)(R * K + C) * 2u; voffB[i] = (unsigned)(Rb * K + C) * 2u; }
    const size_t kstep = (size_t)(BK * 2);
    const size_t hstep = (size_t)HALF * K * 2;
    const size_t tstep = 2 * hstep;
    const unsigned ldsw = (unsigned)wid * 1024u;
    const int aoff = lds_byte(wr * 64 + fr, fq * 8), boff = lds_byte(wc * 32 + fr, fq * 8);
#define PG8_SA(b, h) (((b) * 2 + (h)) * HTB)
#define PG8_SB(b, h) ((4 + (b) * 2 + (h)) * HTB)
#define PG8_STAGE(bufoff, gbase, voff) do { _Pragma("unroll") for (int _i = 0; _i < 2; ++_i) \
        __builtin_amdgcn_global_load_lds((const unsigned*)((const char*)(gbase) + (voff)[_i]), (PG8_LAS unsigned*)(lds + (bufoff) + ldsw + _i * 8192), 16, 0, 0); } while (0)
#define PG8_LDA(dst, b, h) do { _Pragma("unroll") for (int m = 0; m < 4; ++m) _Pragma("unroll") for (int k = 0; k < 2; ++k) dst[m][k] = *(const PG8_LAS bf16x8*)(lds + PG8_SA(b, h) + aoff + m * 2048 + k * 1024); } while (0)
#define PG8_LDB(dst, b, h) do { _Pragma("unroll") for (int n = 0; n < 2; ++n) _Pragma("unroll") for (int k = 0; k < 2; ++k) dst[n][k] = *(const PG8_LAS bf16x8*)(lds + PG8_SB(b, h) + boff + n * 2048 + k * 1024); } while (0)
#define PG8_MMA(ai, bj, At, Bt) do { __builtin_amdgcn_s_setprio(1); _Pragma("unroll") for (int m = 0; m < 4; ++m) _Pragma("unroll") for (int n = 0; n < 2; ++n) _Pragma("unroll") for (int k = 0; k < 2; ++k) \
        acc[ai][bj][m][n] = __builtin_amdgcn_mfma_f32_16x16x32_bf16(Bt[n][k], At[m][k], acc[ai][bj][m][n], 0, 0, 0); __builtin_amdgcn_s_setprio(0); } while (0)
#define PG8_WAIT_V(n) asm volatile("s_waitcnt vmcnt(" #n ")" ::: "memory")
#define PG8_WAIT_L(n) asm volatile("s_waitcnt lgkmcnt(" #n ")" ::: "memory")
#define PG8_BAR __builtin_amdgcn_s_barrier()
#define PG8_SCHED __builtin_amdgcn_sched_barrier(0)
    Unit cur, nxt; int ui = 0;
    if (!S.next(0, cur)) return;
    f32x4 acc[2][2][4][2];
#pragma unroll
    for (int a = 0; a < 2; ++a)
#pragma unroll
        for (int b = 0; b < 2; ++b)
#pragma unroll
            for (int m = 0; m < 4; ++m)
#pragma unroll
                for (int n = 0; n < 2; ++n) acc[a][b][m][n] = (f32x4){0.f, 0.f, 0.f, 0.f};
    bf16x8 At[4][2], B0[2][2], B1[2][2];
    const char* cA = (const char*)g.A + (size_t)cur.pm * tstep; const char* cB = (const char*)g.Bt + (size_t)cur.pn * tstep;
    S.a_ready(cur);
    if constexpr (SP2) {
        PG8_STAGE(PG8_SB(0, 0), cB, voffB); PG8_STAGE(PG8_SB(0, 1), cB + hstep, voffB); PG8_STAGE(PG8_SA(0, 0), cA, voffA); PG8_STAGE(PG8_SA(0, 1), cA + hstep, voffA);
        if (wr == 1) PG8_BAR;
        PG8_WAIT_V(2); PG8_BAR;
        PG8_STAGE(PG8_SB(1, 0), cB + kstep, voffB); PG8_STAGE(PG8_SA(1, 0), cA + kstep, voffA); PG8_STAGE(PG8_SB(1, 1), cB + hstep + kstep, voffB);
        PG8_WAIT_V(6); PG8_BAR;
    } else {
        PG8_STAGE(PG8_SB(0, 0), cB, voffB); PG8_STAGE(PG8_SA(0, 0), cA, voffA); PG8_STAGE(PG8_SB(0, 1), cB + hstep, voffB); PG8_STAGE(PG8_SA(0, 1), cA + hstep, voffA);
        if (wr == 1) PG8_BAR;
        PG8_WAIT_V(4); PG8_BAR;
        PG8_STAGE(PG8_SB(1, 0), cB + kstep, voffB); PG8_STAGE(PG8_SA(1, 0), cA + kstep, voffA); PG8_STAGE(PG8_SB(1, 1), cB + hstep + kstep, voffB);
        PG8_WAIT_V(6); PG8_BAR;
    }
    for (;;) {
        const bool has_next = S.next(ui + 1, nxt);
        const char* nA = has_next ? (const char*)g.A + (size_t)nxt.pm * tstep : cA; const char* nB = has_next ? (const char*)g.Bt + (size_t)nxt.pn * tstep : cB;
        for (int t = 0; t < nt; t += 2) {
            const bool last = (t == nt - 2);
            const char* a1 = cA + (size_t)(t + 1) * kstep;
            const char* a2 = last ? nA : cA + (size_t)(t + 2) * kstep; const char* b2 = last ? nB : cB + (size_t)(t + 2) * kstep;
            const char* a3 = a2 + kstep; const char* b3 = b2 + kstep;
            if (last && has_next) S.a_ready(nxt);
            if constexpr (SP2) {
            PG8_LDB(B0, 0, 0); PG8_LDB(B1, 0, 1); PG8_SCHED; PG8_LDA(At, 0, 0); PG8_STAGE(PG8_SA(1, 1), a1 + hstep, voffA);
            PG8_WAIT_V(8); PG8_WAIT_L(0); PG8_BAR; PG8_MMA(0, 0, At, B0); PG8_MMA(0, 1, At, B1); PG8_BAR; PG8_SCHED;
            PG8_LDA(At, 0, 1); PG8_STAGE(PG8_SB(0, 0), b2, voffB); PG8_STAGE(PG8_SB(0, 1), b2 + hstep, voffB); PG8_STAGE(PG8_SA(0, 0), a2, voffA);
            PG8_WAIT_V(8); PG8_WAIT_L(0); PG8_BAR; PG8_MMA(1, 0, At, B0); PG8_MMA(1, 1, At, B1); PG8_BAR; PG8_SCHED;
            PG8_LDB(B0, 1, 0); PG8_LDB(B1, 1, 1); PG8_SCHED; PG8_LDA(At, 1, 0); PG8_STAGE(PG8_SA(0, 1), a2 + hstep, voffA);
            PG8_WAIT_V(8); PG8_WAIT_L(0); PG8_BAR; PG8_MMA(0, 0, At, B0); PG8_MMA(0, 1, At, B1); PG8_BAR; PG8_SCHED;
            PG8_LDA(At, 1, 1); PG8_STAGE(PG8_SB(1, 0), b3, voffB); PG8_STAGE(PG8_SB(1, 1), b3 + hstep, voffB); PG8_STAGE(PG8_SA(1, 0), a3, voffA);
            PG8_WAIT_V(8); PG8_WAIT_L(0); PG8_BAR; PG8_MMA(1, 0, At, B0); PG8_MMA(1, 1, At, B1); PG8_BAR; PG8_SCHED;
            } else {
            PG8_LDB(B0, 0, 0); PG8_SCHED; PG8_LDA(At, 0, 0); PG8_STAGE(PG8_SA(1, 1), a1 + hstep, voffA);
            PG8_WAIT_L(8); PG8_BAR; PG8_WAIT_L(0); PG8_MMA(0, 0, At, B0); PG8_BAR; PG8_SCHED;
            PG8_LDB(B1, 0, 1); PG8_STAGE(PG8_SB(0, 0), b2, voffB);
            PG8_BAR; PG8_WAIT_L(0); PG8_MMA(0, 1, At, B1); PG8_BAR;
            PG8_LDA(At, 0, 1); PG8_STAGE(PG8_SA(0, 0), a2, voffA);
            PG8_BAR; PG8_WAIT_L(0); PG8_MMA(1, 0, At, B0); PG8_BAR; PG8_SCHED;
            PG8_STAGE(PG8_SB(0, 1), b2 + hstep, voffB);
            PG8_WAIT_V(6); PG8_BAR; PG8_MMA(1, 1, At, B1); PG8_BAR;
            PG8_LDB(B0, 1, 0); PG8_SCHED; PG8_LDA(At, 1, 0); PG8_STAGE(PG8_SA(0, 1), a2 + hstep, voffA);
            PG8_WAIT_L(8); PG8_BAR; PG8_WAIT_L(0); PG8_MMA(0, 0, At, B0); PG8_BAR; PG8_SCHED;
            PG8_LDB(B1, 1, 1); PG8_STAGE(PG8_SB(1, 0), b3, voffB);
            PG8_BAR; PG8_WAIT_L(0); PG8_MMA(0, 1, At, B1); PG8_BAR;
            PG8_LDA(At, 1, 1); PG8_STAGE(PG8_SA(1, 0), a3, voffA);
            PG8_BAR; PG8_WAIT_L(0); PG8_MMA(1, 0, At, B0); PG8_BAR; PG8_SCHED;
            PG8_STAGE(PG8_SB(1, 1), b3 + hstep, voffB);
            PG8_WAIT_V(6); PG8_BAR; PG8_MMA(1, 1, At, B1); PG8_BAR;
            }
        }
        if constexpr (ALIGN_EPI) { if (wr == 0) PG8_BAR; }
        if constexpr (!Epi::AFTER_DRAIN) { E(acc, cur, wr, wc, fr, fq); S.done(cur); }
        if (!has_next) break;
#pragma unroll
        for (int a = 0; a < 2; ++a)
#pragma unroll
            for (int b = 0; b < 2; ++b)
#pragma unroll
                for (int m = 0; m < 4; ++m)
#pragma unroll
                    for (int n = 0; n < 2; ++n) acc[a][b][m][n] = (f32x4){0.f, 0.f, 0.f, 0.f};
        cur = nxt; cA = nA; cB = nB; ++ui;
        if constexpr (ALIGN_EPI) { if (wr == 1) PG8_BAR; }
    }
    PG8_WAIT_V(0);
    if constexpr (!ALIGN_EPI) { if (wr == 0) PG8_BAR; }
    PG8_BAR;
    if constexpr (Epi::AFTER_DRAIN) { E.fused(acc, cur, wr, wc, fr, fq, lds, wid, lane); S.done(cur); }
#undef PG8_SA
#undef PG8_SB
#undef PG8_STAGE
#undef PG8_LDA
#undef PG8_LDB
#undef PG8_MMA
#undef PG8_WAIT_V
#undef PG8_WAIT_L
#undef PG8_BAR
#undef PG8_SCHED
}
}

#define LAS __attribute__((address_space(3)))
typedef unsigned short bf16;
typedef pg8::f32x4 f32x4;
typedef pg8::u32x4 u32x4;
typedef unsigned u32x2 __attribute__((ext_vector_type(2)));
typedef float f32x2_t __attribute__((ext_vector_type(2))); typedef __bf16 bf16x2_t __attribute__((ext_vector_type(2)));
__device__ __forceinline__ unsigned cvt_pk_bf16(float lo, float hi) { f32x2_t v = {lo, hi}; bf16x2_t r = __builtin_convertvector(v, bf16x2_t); return __builtin_bit_cast(unsigned, r); }
constexpr int D = 1024, BATCH = 4, SEQ = 4096, M = BATCH * SEQ, FF = 4096, DEPTH = 4;
constexpr int NWAVES = 8, NTHREADS = 512;
constexpr float RMS_EPS = 1e-6f;
constexpr size_t MiB = 1u << 20;
constexpr size_t WS_SSQ = 0;
constexpr size_t WS_BAR = 1 * MiB;
constexpr size_t WS_HB = 2 * MiB;
constexpr size_t WS_WB0 = 34 * MiB, WS_WB1 = 66 * MiB;
constexpr size_t WS_R = 98 * MiB;
constexpr size_t WS_SC = 226 * MiB;
constexpr size_t WS_SSQO = 242 * MiB;
constexpr size_t WS_END = 246 * MiB;
constexpr size_t WB_IN = 0, WB_O = 12 * MiB, WB_UP = 16 * MiB, WB_DOWN = 24 * MiB;
constexpr size_t R_O = 96 * MiB;
constexpr size_t R_V = 64 * MiB;
constexpr int LDS_BYTES = 147456;

__device__ __forceinline__ float bflo(unsigned u) { return __uint_as_float(u << 16); }
__device__ __forceinline__ float bfhi(unsigned u) { return __uint_as_float(u & 0xffff0000u); }
__device__ __forceinline__ float wave_sum(float v) {
#pragma unroll
    for (int o = 1; o < 64; o <<= 1) v += __shfl_xor(v, o);
    return v;
}
__device__ __forceinline__ float row_rs(const float* ssq, int row) {
    const f32x4* p = (const f32x4*)(ssq + (size_t)row * 16);
    const f32x4 a = p[0], b = p[1], c = p[2], d = p[3];
    const float s = (((a[0] + a[1]) + (a[2] + a[3])) + ((b[0] + b[1]) + (b[2] + b[3]))) + (((c[0] + c[1]) + (c[2] + c[3])) + ((d[0] + d[1]) + (d[2] + d[3])));
    return rsqrtf(s * (1.f / 1024.f) + RMS_EPS);
}

template <int ACT> struct EpiRowScale {
    static constexpr bool PERM = true, AFTER_DRAIN = false;
    bf16* O; int ldc; const float* ssq; int split_cols; size_t split_stride;
    const LAS float* tab; int k0, k1, k2, k3;
    __device__ __forceinline__ void operator()(const f32x4 (&acc)[2][2][4][2], const pg8::Unit& u, int wr, int wc, int fr, int fq) const {
        const int row0 = u.pm * 256 + wr * 64 + fr; int colt = u.pn * 256; bf16* base = O;
        if (split_cols) { const int t = colt / split_cols; base += (size_t)t * split_stride; colt -= t * split_cols; }
        const int col0 = colt + wc * 32 + 8 * fq;
        const int slot = (u.pm == k0) ? 0 : (u.pm == k1) ? 1 : (u.pm == k2) ? 2 : (u.pm == k3) ? 3 : -1;
#pragma unroll
        for (int ai = 0; ai < 2; ++ai)
#pragma unroll
            for (int m = 0; m < 4; ++m) {
                const int row = row0 + ai * 128 + m * 16; const float rs = slot >= 0 ? tab[slot * 256 + wr * 64 + fr + ai * 128 + m * 16] : row_rs(ssq, row);
                bf16* rowp = base + (size_t)row * ldc + col0;
#pragma unroll
                for (int bj = 0; bj < 2; ++bj) {
                    f32x4 v0 = acc[ai][bj][m][0] * rs, v1 = acc[ai][bj][m][1] * rs;
                    if (ACT == 1) {
#pragma unroll
                        for (int e = 0; e < 4; ++e) { float a = fmaxf(v0[e], 0.f), b = fmaxf(v1[e], 0.f); v0[e] = a * a; v1[e] = b * b; }
                    }
                    u32x4 w; w.x = cvt_pk_bf16(v0[0], v0[1]); w.y = cvt_pk_bf16(v0[2], v0[3]); w.z = cvt_pk_bf16(v1[0], v1[1]); w.w = cvt_pk_bf16(v1[2], v1[3]);
                    *(u32x4*)(rowp + bj * 128) = w;
                }
            }
    }
};
template <bool BASE_F32> struct EpiRes {
    static constexpr bool PERM = true, AFTER_DRAIN = false;
    const float* xbase; bf16* hb; float* ssq;
    __device__ __forceinline__ void operator()(const f32x4 (&acc)[2][2][4][2], const pg8::Unit& u, int wr, int wc, int fr, int fq) const {
        const int col0 = u.pn * 256 + wc * 32 + 8 * fq;
#pragma unroll
        for (int ai = 0; ai < 2; ++ai)
#pragma unroll
            for (int m = 0; m < 4; ++m) {
                const int row = u.pm * 256 + ai * 128 + wr * 64 + m * 16 + fr; const size_t off = (size_t)row * D + col0; float s = 0.f;
#pragma unroll
                for (int bj = 0; bj < 2; ++bj) {
                    const size_t o = off + bj * 128;
                    f32x4 v0, v1;
                    if (BASE_F32) { v0 = *(const f32x4*)(xbase + o); v1 = *(const f32x4*)(xbase + o + 4); }
                    else { const u32x4 hv = *(const u32x4*)(hb + o); v0 = (f32x4){bflo(hv.x), bfhi(hv.x), bflo(hv.y), bfhi(hv.y)}; v1 = (f32x4){bflo(hv.z), bfhi(hv.z), bflo(hv.w), bfhi(hv.w)}; }
                    v0 = v0 + acc[ai][bj][m][0]; v1 = v1 + acc[ai][bj][m][1];
                    s += ((v0[0] * v0[0] + v0[1] * v0[1]) + (v0[2] * v0[2] + v0[3] * v0[3])) + ((v1[0] * v1[0] + v1[1] * v1[1]) + (v1[2] * v1[2] + v1[3] * v1[3]));
                    u32x4 w; w.x = cvt_pk_bf16(v0[0], v0[1]); w.y = cvt_pk_bf16(v0[2], v0[3]); w.z = cvt_pk_bf16(v1[0], v1[1]); w.w = cvt_pk_bf16(v1[2], v1[3]);
                    *(u32x4*)(hb + o) = w;
                }
                s += __shfl_xor(s, 16); s += __shfl_xor(s, 32);
                if (fq == 0) ssq[(size_t)row * 16 + u.pn * 4 + wc] = s;
            }
    }
};
struct EpiGate {
    static constexpr bool PERM = true, AFTER_DRAIN = false;
    bf16* Y; const bf16* Oin; const float* ssq; const float* rmso;
    __device__ __forceinline__ void operator()(const f32x4 (&acc)[2][2][4][2], const pg8::Unit& u, int wr, int wc, int fr, int fq) const {
        const int row0 = u.pm * 256 + wr * 64 + fr; const int col0 = u.pn * 256 + wc * 32 + 8 * fq;
#pragma unroll
        for (int ai = 0; ai < 2; ++ai)
#pragma unroll
            for (int m = 0; m < 4; ++m) {
                const int row = row0 + ai * 128 + m * 16; const float rs = row_rs(ssq, row);
                float ro; { const f32x4* p = (const f32x4*)(rmso + ((size_t)row * 4 + (u.pn >> 1)) * 16); const f32x4 a = p[0], b = p[1], c = p[2], d = p[3];
                    const float s = (((a[0] + a[1]) + (a[2] + a[3])) + ((b[0] + b[1]) + (b[2] + b[3]))) + (((c[0] + c[1]) + (c[2] + c[3])) + ((d[0] + d[1]) + (d[2] + d[3]))); ro = rsqrtf(s * (1.f / 512.f) + RMS_EPS); }
#pragma unroll
                for (int bj = 0; bj < 2; ++bj) {
                    const int c = col0 + bj * 128;
                    const u32x4 ov = *(const u32x4*)(Oin + (size_t)row * 2048 + c);
                    float o8[8] = {bflo(ov.x), bfhi(ov.x), bflo(ov.y), bfhi(ov.y), bflo(ov.z), bfhi(ov.z), bflo(ov.w), bfhi(ov.w)};
                    float y8[8];
#pragma unroll
                    for (int e = 0; e < 8; ++e) { const float g = (e < 4 ? acc[ai][bj][m][0][e & 3] : acc[ai][bj][m][1][e & 3]) * rs; const float sg = g / (1.f + __expf(-g)); y8[e] = sg * o8[e] * ro; }
                    u32x4 w; w.x = cvt_pk_bf16(y8[0], y8[1]); w.y = cvt_pk_bf16(y8[2], y8[3]); w.z = cvt_pk_bf16(y8[4], y8[5]); w.w = cvt_pk_bf16(y8[6], y8[7]);
                    *(u32x4*)(Y + (size_t)row * 2048 + c) = w;
                }
            }
    }
};

struct Args { const float* in[13]; float* out; unsigned char* ws; };

struct CvItem { const float* src; bf16* dst; const float* gain; float cs; int N, K; };
__device__ __forceinline__ void cv_load(const CvItem& d, float (&r)[32]) {
#pragma unroll
    for (int i = 0; i < 32; ++i) r[i] = __builtin_nontemporal_load(d.src + (size_t)(2 * i) * d.N);
}
__device__ __forceinline__ void cv_store(const CvItem& d, const float (&r)[32], LAS float* scr, int lane) {
#pragma unroll
    for (int i = 0; i < 32; ++i) scr[(2 * i + (lane >> 5)) * 33 + (lane & 31)] = r[i] * d.cs;
    asm volatile("s_waitcnt lgkmcnt(0)" ::: "memory");
    const int c = lane & 7;
    f32x4 g0 = (f32x4){1.f, 1.f, 1.f, 1.f}, g1 = g0;
    if (d.gain) { g0 = *(const f32x4*)(d.gain + 8 * c); g1 = *(const f32x4*)(d.gain + 8 * c + 4); }
#pragma unroll
    for (int j = 0; j < 4; ++j) { const int nn = (lane >> 3) + 8 * j; const LAS float* s = scr + (8 * c) * 33 + nn;
        u32x4 o; o.x = cvt_pk_bf16(s[0 * 33] * g0[0], s[1 * 33] * g0[1]); o.y = cvt_pk_bf16(s[2 * 33] * g0[2], s[3 * 33] * g0[3]);
        o.z = cvt_pk_bf16(s[4 * 33] * g1[0], s[5 * 33] * g1[1]); o.w = cvt_pk_bf16(s[6 * 33] * g1[2], s[7 * 33] * g1[3]);
        *(u32x4*)(d.dst + (size_t)nn * d.K + 8 * c) = o; }
    asm volatile("s_waitcnt lgkmcnt(0)" ::: "memory");
}
__device__ __forceinline__ void convert_layer(const Args& a, int i, LAS unsigned char* lds, int gw, int NGW, int wave, int lane) {
    const int kind = i % 3, j = i / 3;
    const float* w_in; int n_in; const float* w_o; int k_o; int sc_lo, sc_hi; float sc;
    if (kind == 0) { w_in = a.in[4] + (size_t)j * D * 1280; n_in = 1280; w_o = a.in[6] + (size_t)j * D * D; k_o = 1024; sc_lo = 0; sc_hi = 1024; sc = 0.125f; }
    else if (kind == 1) { w_in = a.in[7] + (size_t)j * D * 3072; n_in = 3072; w_o = a.in[8] + (size_t)j * D * D; k_o = 1024; sc_lo = 0; sc_hi = 1024; sc = 0.125f * 1.4426950408889634f; }
    else { w_in = a.in[9] + (size_t)j * D * 6144; n_in = 6144; w_o = a.in[10] + (size_t)j * 2048 * D; k_o = 2048; sc_lo = 1024; sc_hi = 2048; sc = 0.0625f; }
    const float* w_up = a.in[11] + (size_t)i * D * FF; const float* w_dn = a.in[12] + (size_t)i * FF * D;
    const float* g_attn = a.in[1] + (size_t)i * D; const float* g_mlp = a.in[2] + (size_t)i * D;
    unsigned char* wb = a.ws + ((i & 1) ? WS_WB1 : WS_WB0);
    LAS float* scr = (LAS float*)(lds + wave * 16384);
    const int I_in = (D / 64) * (n_in / 32), I_o = (k_o / 64) * (D / 32), I_up = (D / 64) * (FF / 32), I_dn = (FF / 64) * (D / 32);
    const int NITEMS = I_in + I_o + I_up + I_dn;
#define CV_DECODE(dsc, itv) do { int r_ = (itv); const float* W_; int K_, N_; bf16* WT_; const float* gn_; int lo_ = 0, hi_ = 0; \
        if (r_ < I_in) { W_ = w_in; K_ = D; N_ = n_in; WT_ = (bf16*)(wb + WB_IN); gn_ = g_attn; lo_ = sc_lo; hi_ = sc_hi; } \
        else if ((r_ -= I_in) < I_o) { W_ = w_o; K_ = k_o; N_ = D; WT_ = (bf16*)(wb + WB_O); gn_ = nullptr; } \
        else if ((r_ -= I_o) < I_up) { W_ = w_up; K_ = D; N_ = FF; WT_ = (bf16*)(wb + WB_UP); gn_ = g_mlp; } \
        else { r_ -= I_up; W_ = w_dn; K_ = FF; N_ = D; WT_ = (bf16*)(wb + WB_DOWN); gn_ = nullptr; } \
        const int nblk_ = N_ / 32, kb_ = r_ / nblk_, nb_ = r_ % nblk_, k0_ = 64 * kb_, n0_ = 32 * nb_, n_ = n0_ + (lane & 31); \
        (dsc).src = W_ + (size_t)(k0_ + (lane >> 5)) * N_ + n_; (dsc).dst = WT_ + (size_t)n0_ * K_ + k0_; (dsc).gain = gn_ ? gn_ + k0_ : nullptr; \
        (dsc).cs = (n_ >= lo_ && n_ < hi_) ? sc : 1.f; (dsc).N = N_; (dsc).K = K_; } while (0)
    for (int it = gw; it < NITEMS; it += 2 * NGW) {
        CvItem d0, d1; float r0[32], r1[32];
        CV_DECODE(d0, it); cv_load(d0, r0);
        const bool two = it + NGW < NITEMS;
        if (two) { CV_DECODE(d1, it + NGW); cv_load(d1, r1); }
        cv_store(d0, r0, scr, lane);
        if (two) cv_store(d1, r1, scr, lane);
    }
#undef CV_DECODE
}

#define UNPACK8(dst, vv_) do { (dst)[0] = bflo((vv_)[0]); (dst)[1] = bfhi((vv_)[0]); (dst)[2] = bflo((vv_)[1]); (dst)[3] = bfhi((vv_)[1]); (dst)[4] = bflo((vv_)[2]); (dst)[5] = bfhi((vv_)[2]); (dst)[6] = bflo((vv_)[3]); (dst)[7] = bfhi((vv_)[3]); } while (0)
__device__ __forceinline__ void swa_naive(const bf16* qkv, const float* sinks, bf16* o, int gtid, int gthreads) {
    for (int idx = gtid; idx < M * 16; idx += gthreads) {
        const int head = idx & 15, m = idx >> 4, t = m & (SEQ - 1), kv = head >> 3;
        float q[64], acc[64];
        { const u32x4* qp = (const u32x4*)(qkv + (size_t)m * 1280 + head * 64);
#pragma unroll
          for (int c = 0; c < 8; ++c) { const u32x4 w = qp[c]; UNPACK8(q + 8 * c, w); } }
#pragma unroll
        for (int d = 0; d < 64; ++d) acc[d] = 0.f;
        const float slope = exp2f(-0.5f * (float)(head + 1));
        float mr = sinks[head], l = 1.f;
        const int s0 = t - 127 < 0 ? 0 : t - 127;
        for (int s = s0; s <= t; ++s) {
            const bf16* kp = qkv + (size_t)(m - (t - s)) * 1280 + 1024 + kv * 64; const bf16* vp = kp + 128;
            float z = 0.f;
#pragma unroll
            for (int c = 0; c < 8; ++c) { const u32x4 w = ((const u32x4*)kp)[c]; float k8[8]; UNPACK8(k8, w);
#pragma unroll
                for (int e = 0; e < 8; ++e) z += q[8 * c + e] * k8[e]; }
            z -= slope * (float)(t - s);
            const float mn = fmaxf(mr, z), corr = __expf(mr - mn), p = __expf(z - mn);
            l = l * corr + p; mr = mn;
#pragma unroll
            for (int c = 0; c < 8; ++c) { const u32x4 w = ((const u32x4*)vp)[c]; float v8[8]; UNPACK8(v8, w);
#pragma unroll
                for (int e = 0; e < 8; ++e) acc[8 * c + e] = acc[8 * c + e] * corr + p * v8[e]; }
        }
        const float inv = 1.f / l;
        u32x4* op = (u32x4*)(o + (size_t)m * 1024 + head * 64);
#pragma unroll
        for (int c = 0; c < 8; ++c) { u32x4 w; w.x = cvt_pk_bf16(acc[8 * c] * inv, acc[8 * c + 1] * inv); w.y = cvt_pk_bf16(acc[8 * c + 2] * inv, acc[8 * c + 3] * inv);
            w.z = cvt_pk_bf16(acc[8 * c + 4] * inv, acc[8 * c + 5] * inv); w.w = cvt_pk_bf16(acc[8 * c + 6] * inv, acc[8 * c + 7] * inv); op[c] = w; }
    }
}
__device__ __forceinline__ void sb_naive(const bf16* qkv, bf16* o, int gtid, int gthreads) {
    int it = 0; const bool mir = (gthreads % (SEQ * 16)) == 0;
    for (int idx = gtid; idx < M * 16; idx += gthreads, ++it) {
        const int head = idx & 15; int m = idx >> 4; int t = m & (SEQ - 1);
        if (mir && (it & 1)) { t = SEQ - 1 - t; m = (m & ~(SEQ - 1)) + t; }
        float q[64], acc[64];
        { const u32x4* qp = (const u32x4*)(qkv + (size_t)m * 3072 + head * 64);
#pragma unroll
          for (int c = 0; c < 8; ++c) { const u32x4 w = qp[c]; UNPACK8(q + 8 * c, w); } }
#pragma unroll
        for (int d = 0; d < 64; ++d) acc[d] = 0.f;
        float carry = 0.f;
        for (int s = t - 1; s >= 0; --s) {
            const bf16* kp = qkv + (size_t)(m - (t - s)) * 3072 + 1024 + head * 64; const bf16* vp = kp + 1024;
            float z = 0.f;
#pragma unroll
            for (int c = 0; c < 8; ++c) { const u32x4 w = ((const u32x4*)kp)[c]; float k8[8]; UNPACK8(k8, w);
#pragma unroll
                for (int e = 0; e < 8; ++e) z += q[8 * c + e] * k8[e]; }
            const float sp = fmaxf(z, 0.f) + __logf(1.f + __expf(-fabsf(z)));
            const float p = __expf(z - sp + carry);
            carry -= sp;
#pragma unroll
            for (int c = 0; c < 8; ++c) { const u32x4 w = ((const u32x4*)vp)[c]; float v8[8]; UNPACK8(v8, w);
#pragma unroll
                for (int e = 0; e < 8; ++e) acc[8 * c + e] += p * v8[e]; }
        }
        u32x4* op = (u32x4*)(o + (size_t)m * 1024 + head * 64);
#pragma unroll
        for (int c = 0; c < 8; ++c) { u32x4 w; w.x = cvt_pk_bf16(acc[8 * c], acc[8 * c + 1]); w.y = cvt_pk_bf16(acc[8 * c + 2], acc[8 * c + 3]);
            w.z = cvt_pk_bf16(acc[8 * c + 4], acc[8 * c + 5]); w.w = cvt_pk_bf16(acc[8 * c + 6], acc[8 * c + 7]); op[c] = w; }
    }
}
__device__ __forceinline__ void ret_naive(const bf16* qk, bf16* vo, int gtid, int gthreads) {
    for (int idx = gtid; idx < 16 * 512 * 16; idx += gthreads) {
        const int dqi = idx & 15, e = (idx >> 4) & 511, bh = idx >> 13, b = bh >> 2, h = bh & 3;
        const float gamma = 1.f - exp2f(-5.f - (float)h);
        float S[16];
#pragma unroll
        for (int j = 0; j < 16; ++j) S[j] = 0.f;
        for (int t = 0; t < SEQ; ++t) {
            const size_t row = (size_t)b * SEQ + t;
            const u32x4* qp = (const u32x4*)(qk + row * 2048 + h * 256 + dqi * 16);
            const u32x4* kp = (const u32x4*)(qk + row * 2048 + 1024 + h * 256 + dqi * 16);
            bf16* vp = vo + row * 2048 + h * 512 + e;
            const float v = __uint_as_float((unsigned)(*vp) << 16);
            float q16[16], k16[16];
            { const u32x4 w0 = qp[0], w1 = qp[1]; UNPACK8(q16, w0); UNPACK8(q16 + 8, w1); }
            { const u32x4 w0 = kp[0], w1 = kp[1]; UNPACK8(k16, w0); UNPACK8(k16 + 8, w1); }
            float part = 0.f;
#pragma unroll
            for (int j = 0; j < 16; ++j) { S[j] = gamma * S[j] + k16[j] * v; part += q16[j] * S[j]; }
            part += __shfl_xor(part, 1); part += __shfl_xor(part, 2); part += __shfl_xor(part, 4); part += __shfl_xor(part, 8);
            if (dqi == 0) *vp = (bf16)(cvt_pk_bf16(part, 0.f) & 0xffffu);
        }
    }
}

typedef short bf16x8 __attribute__((ext_vector_type(8)));
typedef short s16x4 __attribute__((ext_vector_type(4)));
typedef float f32x16 __attribute__((ext_vector_type(16)));
#define MFMA32(a, b, c) __builtin_amdgcn_mfma_f32_32x32x16_bf16((a), (b), (c), 0, 0, 0)
__device__ __forceinline__ s16x4 tr16(const LAS unsigned char* p) { return __builtin_bit_cast(s16x4, __builtin_amdgcn_ds_read_tr16_b64_v4i16((LAS s16x4*)p)); }
__device__ __forceinline__ bf16x8 pack8(const float* a) {
    u32x4 w; w.x = cvt_pk_bf16(a[0], a[1]); w.y = cvt_pk_bf16(a[2], a[3]); w.z = cvt_pk_bf16(a[4], a[5]); w.w = cvt_pk_bf16(a[6], a[7]);
    return __builtin_bit_cast(bf16x8, w);
}
constexpr int SB_ROW = 144, SB_TILE = 64 * SB_ROW;
__device__ __forceinline__ void sb_phase(const bf16* qkv, bf16* o, LAS unsigned char* lds, int vcu, int G, int tid) {
    const int lane = tid & 63, wave = __builtin_amdgcn_readfirstlane(tid >> 6), r32 = lane & 31, hi = lane >> 5;
    const int srow = tid >> 3, sch = tid & 7;
    const int i16 = lane & 15, tq = i16 >> 2, tp = i16 & 3, blk = (lane >> 4) & 1;
    const int vtr_off = (4 * hi + tq) * SB_ROW + (16 * blk + 4 * tp) * 2;
    LAS unsigned* flg = (LAS unsigned*)(lds + 4 * SB_TILE);
    for (int P = vcu; P < 512; P += G) {
        const int bh = P >> 3, jj = P & 7, b = bh >> 4, h = bh & 15;
        for (int half = 0; half < 2; ++half) {
            const int jq = half ? 15 - jj : jj;
            const size_t mb = (size_t)b * SEQ;
            const bf16* kbase = qkv + mb * 3072 + 1024 + h * 64; const bf16* vbase = kbase + 1024;
            const int tq0 = 256 * jq + 32 * wave;
            bf16x8 qf[4];
            { const bf16* qp = qkv + (mb + tq0 + r32) * 3072 + h * 64 + 8 * hi;
#pragma unroll
              for (int d0 = 0; d0 < 4; ++d0) qf[d0] = *(const bf16x8*)(qp + 16 * d0); }
            f32x16 o0, o1;
#pragma unroll
            for (int r = 0; r < 16; ++r) { o0[r] = 0.f; o1[r] = 0.f; }
            float carry = 0.f; bool mydone = false;
            const int nst = 4 * jq + 4;
            { const size_t roff = (size_t)(64 * (nst - 1) + srow) * 3072 + sch * 8;
              const u32x4 kk = *(const u32x4*)(kbase + roff), vv = *(const u32x4*)(vbase + roff);
              *(LAS u32x4*)(lds + srow * SB_ROW + sch * 16) = kk; *(LAS u32x4*)(lds + 2 * SB_TILE + srow * SB_ROW + sch * 16) = vv; }
            __syncthreads();
            for (int st = nst - 1, it = 0; st >= 0; --st, ++it) {
                const int cb = it & 1;
                const LAS unsigned char* Kb = lds + cb * SB_TILE; const LAS unsigned char* Vb = lds + 2 * SB_TILE + cb * SB_TILE;
                u32x4 kk, vv;
                if (st > 0) { const size_t roff = (size_t)(64 * (st - 1) + srow) * 3072 + sch * 8; kk = *(const u32x4*)(kbase + roff); vv = *(const u32x4*)(vbase + roff); }
                if (64 * st < tq0 + 32 && !mydone) {
                    const bool diag = (64 * st + 63 >= tq0);
#pragma unroll
                    for (int sub = 1; sub >= 0; --sub) {
                        f32x16 p;
#pragma unroll
                        for (int r = 0; r < 16; ++r) p[r] = 0.f;
                        const LAS unsigned char* kp = Kb + (32 * sub + r32) * SB_ROW + 16 * hi;
#pragma unroll
                        for (int d0 = 0; d0 < 4; ++d0) p = MFMA32(*(const LAS bf16x8*)(kp + 32 * d0), qf[d0], p);
                        float l[16]; const int sg0 = 64 * st + 32 * sub + 4 * hi, tg = tq0 + r32;
#pragma unroll
                        for (int r = 0; r < 16; ++r) {
                            const float z = p[r]; const float e = __builtin_amdgcn_exp2f(z); float lg = __builtin_amdgcn_logf(1.f + e); lg = z > 32.f ? z : lg;
                            const bool valid = !diag || (sg0 + (r & 3) + 8 * (r >> 2) < tg);
                            l[r] = valid ? -lg : 0.f;
                        }
                        float gs[4], ot[4], ps[4];
#pragma unroll
                        for (int g = 0; g < 4; ++g) { gs[g] = (l[4 * g] + l[4 * g + 1]) + (l[4 * g + 2] + l[4 * g + 3]); ot[g] = __shfl_xor(gs[g], 32); ps[g] = gs[g] + ot[g]; }
                        float T[4]; T[3] = 0.f; T[2] = ps[3]; T[1] = ps[3] + ps[2]; T[0] = T[1] + ps[1];
                        const float total = T[0] + ps[0];
                        float A[16];
#pragma unroll
                        for (int g = 0; g < 4; ++g) {
                            const float base = carry + T[g] + (hi == 0 ? ot[g] : 0.f);
                            const float i3 = base + l[4 * g + 3], i2 = i3 + l[4 * g + 2], i1 = i2 + l[4 * g + 1], i0 = i1 + l[4 * g];
                            A[4 * g + 3] = __builtin_amdgcn_exp2f(p[4 * g + 3] + i3); A[4 * g + 2] = __builtin_amdgcn_exp2f(p[4 * g + 2] + i2);
                            A[4 * g + 1] = __builtin_amdgcn_exp2f(p[4 * g + 1] + i1); A[4 * g] = __builtin_amdgcn_exp2f(p[4 * g] + i0);
                        }
                        if (diag) {
#pragma unroll
                            for (int r = 0; r < 16; ++r) A[r] = (sg0 + (r & 3) + 8 * (r >> 2) < tg) ? A[r] : 0.f;
                        }
                        carry += total;
                        const bf16x8 pf0 = pack8(A), pf1 = pack8(A + 8);
#pragma unroll
                        for (int s = 0; s < 2; ++s) {
                            const LAS unsigned char* vp = Vb + (32 * sub + 16 * s) * SB_ROW + vtr_off;
                            const s16x4 a0 = tr16(vp), a1 = tr16(vp + 8 * SB_ROW), b0 = tr16(vp + 64), b1 = tr16(vp + 64 + 8 * SB_ROW);
                            const bf16x8 vf0 = __builtin_shufflevector(a0, a1, 0, 1, 2, 3, 4, 5, 6, 7), vf1 = __builtin_shufflevector(b0, b1, 0, 1, 2, 3, 4, 5, 6, 7);
                            o0 = MFMA32(vf0, s ? pf1 : pf0, o0); o1 = MFMA32(vf1, s ? pf1 : pf0, o1);
                        }
                    }
                }
                if (64 * st < tq0 + 32) mydone = __all(carry <= -150.f);
                if (lane == 0) flg[(it & 1) * 8 + wave] = mydone ? 1u : 0u;
                if (st > 0) { LAS unsigned char* Kn = lds + (cb ^ 1) * SB_TILE; *(LAS u32x4*)(Kn + srow * SB_ROW + sch * 16) = kk; *(LAS u32x4*)(Kn + 2 * SB_TILE + srow * SB_ROW + sch * 16) = vv; }
                __syncthreads();
                { const u32x4 f0 = *(const LAS u32x4*)(flg + (it & 1) * 8), f1 = *(const LAS u32x4*)(flg + (it & 1) * 8 + 4);
                  if ((f0.x & f0.y & f0.z & f0.w & f1.x & f1.y & f1.z & f1.w) != 0u) break; }
            }
            bf16* op = o + (mb + tq0 + r32) * 1024 + h * 64 + 4 * hi;
#pragma unroll
            for (int g = 0; g < 4; ++g) {
                u32x2 w0, w1; w0.x = cvt_pk_bf16(o0[4 * g], o0[4 * g + 1]); w0.y = cvt_pk_bf16(o0[4 * g + 2], o0[4 * g + 3]);
                w1.x = cvt_pk_bf16(o1[4 * g], o1[4 * g + 1]); w1.y = cvt_pk_bf16(o1[4 * g + 2], o1[4 * g + 3]);
                *(u32x2*)(op + 8 * g) = w0; *(u32x2*)(op + 32 + 8 * g) = w1;
            }
        }
    }
}

__device__ __forceinline__ void swa_phase(const bf16* qkv, const float* sinks, bf16* o, LAS unsigned char* lds, int vcu, int G, int tid) {
    const int lane = tid & 63, wave = __builtin_amdgcn_readfirstlane(tid >> 6), r32 = lane & 31, hi = lane >> 5;
    const int i16 = lane & 15, tq = i16 >> 2, tp = i16 & 3, blk = (lane >> 4) & 1;
    const int vtr_off = (4 * hi + tq) * SB_ROW + (16 * blk + 4 * tp) * 2;
    LAS unsigned char* Kb = lds; LAS unsigned char* Vb = lds + 256 * SB_ROW;
    for (int u = vcu; u < 256; u += G) {
        const int kv = u & 1, n = (u >> 1) & 31, b = u >> 6;
        const int head = kv * 8 + wave;
        const float slope = exp2f(-0.5f * (float)(head + 1)), sink = sinks[head];
        __syncthreads();
#pragma unroll
        for (int c4 = 0; c4 < 4; ++c4) {
            const int idx = tid + NTHREADS * c4, kr = idx >> 3, ch = idx & 7;
            u32x4 kk = (u32x4){0u, 0u, 0u, 0u}, vv = kk;
            if (n > 0 || kr >= 128) { const bf16* p = qkv + ((size_t)b * SEQ + 128 * (n - 1) + kr) * 1280 + 1024 + kv * 64 + ch * 8; kk = *(const u32x4*)p; vv = *(const u32x4*)(p + 128); }
            *(LAS u32x4*)(Kb + kr * SB_ROW + ch * 16) = kk; *(LAS u32x4*)(Vb + kr * SB_ROW + ch * 16) = vv;
        }
        __syncthreads();
        for (int sb = 0; sb < 4; ++sb) {
            const size_t qrow = (size_t)b * SEQ + 128 * n + 32 * sb + r32;
            bf16x8 qf[4];
            { const bf16* qp = qkv + qrow * 1280 + head * 64 + 8 * hi;
#pragma unroll
              for (int d0 = 0; d0 < 4; ++d0) qf[d0] = *(const bf16x8*)(qp + 16 * d0); }
            const int kl = 128 + 32 * sb + r32;
            float lg[5][16]; float mx = sink;
#pragma unroll
            for (int kt = 0; kt < 5; ++kt) {
                f32x16 p;
#pragma unroll
                for (int r = 0; r < 16; ++r) p[r] = 0.f;
                const LAS unsigned char* kp = Kb + (32 * (sb + kt) + r32) * SB_ROW + 16 * hi;
#pragma unroll
                for (int d0 = 0; d0 < 4; ++d0) p = MFMA32(*(const LAS bf16x8*)(kp + 32 * d0), qf[d0], p);
#pragma unroll
                for (int r = 0; r < 16; ++r) {
                    const int kvl = 32 * (sb + kt) + (r & 3) + 8 * (r >> 2) + 4 * hi, dist = kl - kvl;
                    const bool valid = dist >= 0 && dist < 128 && (n > 0 || kvl >= 128);
                    const float v = valid ? p[r] - slope * (float)dist : -1e30f;
                    lg[kt][r] = v; mx = fmaxf(mx, v);
                }
            }
            mx = fmaxf(mx, __shfl_xor(mx, 32));
            float l = 0.f;
            f32x16 o0, o1;
#pragma unroll
            for (int r = 0; r < 16; ++r) { o0[r] = 0.f; o1[r] = 0.f; }
#pragma unroll
            for (int kt = 0; kt < 5; ++kt) {
#pragma unroll
                for (int r = 0; r < 16; ++r) { const float e = __expf(lg[kt][r] - mx); lg[kt][r] = e; l += e; }
                const bf16x8 pf0 = pack8(&lg[kt][0]), pf1 = pack8(&lg[kt][8]);
#pragma unroll
                for (int s = 0; s < 2; ++s) {
                    const LAS unsigned char* vp = Vb + (32 * (sb + kt) + 16 * s) * SB_ROW + vtr_off;
                    const s16x4 a0 = tr16(vp), a1 = tr16(vp + 8 * SB_ROW), b0 = tr16(vp + 64), b1 = tr16(vp + 64 + 8 * SB_ROW);
                    const bf16x8 vf0 = __builtin_shufflevector(a0, a1, 0, 1, 2, 3, 4, 5, 6, 7), vf1 = __builtin_shufflevector(b0, b1, 0, 1, 2, 3, 4, 5, 6, 7);
                    o0 = MFMA32(vf0, s ? pf1 : pf0, o0); o1 = MFMA32(vf1, s ? pf1 : pf0, o1);
                }
            }
            l += __shfl_xor(l, 32);
            const float inv = 1.f / (l + __expf(sink - mx));
            bf16* op = o + qrow * 1024 + head * 64 + 4 * hi;
#pragma unroll
            for (int g = 0; g < 4; ++g) {
                u32x2 w0, w1; w0.x = cvt_pk_bf16(o0[4 * g] * inv, o0[4 * g + 1] * inv); w0.y = cvt_pk_bf16(o0[4 * g + 2] * inv, o0[4 * g + 3] * inv);
                w1.x = cvt_pk_bf16(o1[4 * g] * inv, o1[4 * g + 1] * inv); w1.y = cvt_pk_bf16(o1[4 * g + 2] * inv, o1[4 * g + 3] * inv);
                *(u32x2*)(op + 8 * g) = w0; *(u32x2*)(op + 32 + 8 * g) = w1;
            }
        }
    }
}

__device__ __forceinline__ void ret_scores(bf16* qk, bf16* sc, int vcu, int G, int tid) {
    const int lane = tid & 63, wave = __builtin_amdgcn_readfirstlane(tid >> 6), r32 = lane & 31, hi = lane >> 5;
    const int it = wave >> 1, jh = wave & 1;
    for (int u = vcu; u < 512; u += G) {
        const int bh = u >> 5, n = u & 31, b = bh >> 2, h = bh & 3;
        const float lg = log2f(1.f - exp2f(-5.f - (float)h));
        const size_t row0 = (size_t)b * SEQ + n * 128;
        const bf16* qp = qk + (row0 + 32 * it + r32) * 2048 + h * 256 + 8 * hi;
        bf16x8 qf[16];
#pragma unroll
        for (int ks = 0; ks < 16; ++ks) qf[ks] = *(const bf16x8*)(qp + 16 * ks);
#pragma unroll
        for (int jt2 = 0; jt2 < 2; ++jt2) {
            const int jt = 2 * jh + jt2;
            if (jt <= it) {
                const bf16* kp = qk + (row0 + 32 * jt + r32) * 2048 + 1024 + h * 256 + 8 * hi;
                f32x16 p;
#pragma unroll
                for (int r = 0; r < 16; ++r) p[r] = 0.f;
#pragma unroll
                for (int ks = 0; ks < 16; ++ks) p = MFMA32(*(const bf16x8*)(kp + 16 * ks), qf[ks], p);
                const int i = 32 * it + r32;
                bf16* sp = sc + (size_t)u * 16384 + (size_t)(it * 8 + 2 * jt) * 512 + r32 * 8 + 4 * hi;
#pragma unroll
                for (int g = 0; g < 4; ++g) {
                    float v[4];
#pragma unroll
                    for (int e = 0; e < 4; ++e) { const int j = 32 * jt + 8 * g + 4 * hi + e; v[e] = (i >= j) ? p[4 * g + e] * exp2f((float)(i - j) * lg) : 0.f; }
                    u32x2 w; w.x = cvt_pk_bf16(v[0], v[1]); w.y = cvt_pk_bf16(v[2], v[3]);
                    *(u32x2*)(sp + (g >> 1) * 512 + (g & 1) * 256) = w;
                }
            }
        }
        __syncthreads();
        if (jh == 0) {
            char* qc = (char*)(qk + row0 * 2048 + h * 256) + (size_t)(it * 32 + hi) * 4096 + r32 * 16;
#pragma unroll
            for (int ks = 0; ks < 16; ++ks) *(bf16x8*)(qc + ks * 8192) = qf[ks];
        }
    }
}
constexpr int RT_ST_ROW = 528, RT_V_ROW = 80, RT_K_ROW = 144;
constexpr int RT_OFF_ST = 0, RT_OFF_V = 32 * RT_ST_ROW, RT_OFF_VD = RT_OFF_V + 128 * RT_V_ROW, RT_OFF_K = RT_OFF_VD + 128 * RT_V_ROW, RT_SLAB = 64 * RT_K_ROW;
__device__ __forceinline__ void ret_scan(const bf16* qk, bf16* vo, const bf16* sc, float* ssqo, LAS unsigned char* lds, int vcu, int G, int tid) {
    const int lane = tid & 63, wave = __builtin_amdgcn_readfirstlane(tid >> 6), r32 = lane & 31, hi = lane >> 5;
    const int i16 = lane & 15, tq = i16 >> 2, tp = i16 & 3, blk = (lane >> 4) & 1;
    const int trv = (8 * hi + tq) * RT_V_ROW + (16 * blk + 4 * tp) * 2, trk = (8 * hi + tq) * RT_K_ROW + (16 * blk + 4 * tp) * 2;
    const int vj = tid >> 2, vch = tid & 3;
    const int krj = lane >> 3, kch = lane & 7, uw = wave & 3;
    const bool owave = wave < 4;
    LAS unsigned char* slab = lds + RT_OFF_K + uw * RT_SLAB;
    for (int u = vcu; u < 256; u += G) {
        const int bh = u >> 4, es = u & 15, b = bh >> 2, h = bh & 3, e0 = 32 * es;
        const float lg = log2f(1.f - exp2f(-5.f - (float)h)), cdec = exp2f(128.f * lg);
        const float kd = exp2f((float)(127 - vj) * lg);
        const size_t rowb = (size_t)b * SEQ;
        const int i = 32 * uw + r32;
        const float qd = exp2f((float)(i + 1) * lg);
        f32x16 st0, st1;
#pragma unroll
        for (int r = 0; r < 16; ++r) { st0[r] = 0.f; st1[r] = 0.f; }
        u32x4 kreg[16], vreg; bf16x8 qreg[16], sreg[8];
        unsigned offq = (unsigned)(hi * 4096 + r32 * 16), offs = (unsigned)(lane * 16), offk = (unsigned)(krj * 2048 + 8 * kch) * 2u, offv = (unsigned)(vj * 2048 + 8 * vch) * 2u;
        unsigned offo = (unsigned)(i * 2048 + 4 * hi) * 2u, offsq = (unsigned)(i * 64) * 4u;
        const char* const qbase = (const char*)(qk + rowb * 2048 + h * 256);
        const char* const kbase = (const char*)(qk + rowb * 2048 + 1024 + h * 256 + 64 * uw);
        const char* const sbase = (const char*)(sc + (size_t)(bh * 32) * 16384);
        char* const vbase = (char*)(vo + rowb * 2048 + h * 512 + e0);
        char* const sqbase = (char*)(ssqo + (rowb * 4 + h) * 16 + es);
#define RT_LOAD_K(nn, half) do { const char* kb_ = kbase + (size_t)(128 * (nn) + 64 * (half)) * 4096; _Pragma("unroll") for (int c8 = 0; c8 < 8; ++c8) \
            kreg[8 * (half) + c8] = *(const u32x4*)(kb_ + c8 * 32768 + offk); } while (0)
#define RT_LOAD_QS(nn) do { const char* qb_ = qbase + (size_t)(128 * (nn) + 32 * uw) * 4096; \
            _Pragma("unroll") for (int ks = 0; ks < 16; ++ks) qreg[ks] = *(const bf16x8*)(qb_ + 8192 * ks + offq); \
            const char* sb_ = sbase + (size_t)(nn) * 32768 + uw * 8192; \
            _Pragma("unroll") for (int ks = 0; ks < 8; ++ks) if (ks < 2 * uw + 2) sreg[ks] = *(const bf16x8*)(sb_ + 1024 * ks + offs); } while (0)
#define RT_LOAD_V(nn) do { vreg = *(const u32x4*)(vbase + (size_t)(128 * (nn)) * 4096 + offv); } while (0)
#define RT_WRITE_V() do { *(LAS u32x4*)(lds + RT_OFF_V + vj * RT_V_ROW + vch * 16) = vreg; float f8[8]; UNPACK8(f8, vreg); \
            u32x4 wd; wd.x = cvt_pk_bf16(f8[0] * kd, f8[1] * kd); wd.y = cvt_pk_bf16(f8[2] * kd, f8[3] * kd); wd.z = cvt_pk_bf16(f8[4] * kd, f8[5] * kd); wd.w = cvt_pk_bf16(f8[6] * kd, f8[7] * kd); \
            *(LAS u32x4*)(lds + RT_OFF_VD + vj * RT_V_ROW + vch * 16) = wd; } while (0)
        __syncthreads();
        for (int x = tid * 16; x < 32 * RT_ST_ROW; x += NTHREADS * 16) *(LAS u32x4*)(lds + RT_OFF_ST + x) = (u32x4){0u, 0u, 0u, 0u};
        RT_LOAD_V(0); RT_WRITE_V();
#define RT_BAR() do { asm volatile("s_waitcnt lgkmcnt(0)" ::: "memory"); __builtin_amdgcn_s_barrier(); asm volatile("" ::: "memory"); } while (0)
        if (owave) {
            RT_LOAD_QS(0);
            for (int n = 0; n < 32; ++n) {
                RT_BAR();
                asm volatile("" : "+v"(offq), "+v"(offs), "+v"(offv), "+v"(offo), "+v"(offsq));
                if (n < 31) RT_LOAD_V(n + 1);
                f32x16 oc, oi;
#pragma unroll
                for (int r = 0; r < 16; ++r) { oc[r] = 0.f; oi[r] = 0.f; }
                const LAS unsigned char* sp = lds + RT_OFF_ST + r32 * RT_ST_ROW + 16 * hi;
#pragma unroll
                for (int ks = 0; ks < 16; ++ks) oc = MFMA32(*(const LAS bf16x8*)(sp + 32 * ks), qreg[ks], oc);
#pragma unroll
                for (int ks = 0; ks < 8; ++ks) if (ks < 2 * uw + 2) {
                    const LAS unsigned char* vp = lds + RT_OFF_V + 16 * ks * RT_V_ROW + trv;
                    const s16x4 a0 = tr16(vp), a1 = tr16(vp + 4 * RT_V_ROW);
                    const bf16x8 vf = __builtin_shufflevector(a0, a1, 0, 1, 2, 3, 4, 5, 6, 7);
                    oi = MFMA32(vf, sreg[ks], oi);
                }
                if (n < 31) RT_LOAD_QS(n + 1);
                float s = 0.f;
                char* const op = vbase + (size_t)(128 * n) * 4096 + offo;
#pragma unroll
                for (int g = 0; g < 4; ++g) {
                    float v[4];
#pragma unroll
                    for (int e = 0; e < 4; ++e) { v[e] = oi[4 * g + e] + qd * oc[4 * g + e]; s += v[e] * v[e]; }
                    u32x2 w; w.x = cvt_pk_bf16(v[0], v[1]); w.y = cvt_pk_bf16(v[2], v[3]);
                    *(u32x2*)(op + 16 * g) = w;
                }
                s += __shfl_xor(s, 32);
                if (hi == 0) *(float*)(sqbase + (size_t)(128 * n) * 256 + offsq) = s;
                RT_BAR();
                if (n < 31) RT_WRITE_V();
            }
        } else {
            RT_LOAD_K(0, 0); RT_LOAD_K(0, 1);
            for (int n = 0; n < 32; ++n) {
                RT_BAR();
                asm volatile("" : "+v"(offk), "+v"(offv));
                if (n < 31) RT_LOAD_V(n + 1);
#pragma unroll
                for (int r = 0; r < 16; ++r) { st0[r] *= cdec; st1[r] *= cdec; }
#pragma unroll
                for (int half = 0; half < 2; ++half) {
#pragma unroll
                    for (int c8 = 0; c8 < 8; ++c8) *(LAS u32x4*)(slab + (krj + 8 * c8) * RT_K_ROW + kch * 16) = kreg[8 * half + c8];
                    if (n < 31) { if (half == 0) RT_LOAD_K(n + 1, 0); else RT_LOAD_K(n + 1, 1); }
#pragma unroll
                    for (int ks = 0; ks < 4; ++ks) {
                        const LAS unsigned char* kp = slab + 16 * ks * RT_K_ROW + trk;
                        const LAS unsigned char* vp = lds + RT_OFF_VD + (64 * half + 16 * ks) * RT_V_ROW + trv;
                        const s16x4 v0 = tr16(vp), v1 = tr16(vp + 4 * RT_V_ROW);
                        const s16x4 k0 = tr16(kp), k1 = tr16(kp + 4 * RT_K_ROW), k2 = tr16(kp + 64), k3 = tr16(kp + 64 + 4 * RT_K_ROW);
                        const bf16x8 vf = __builtin_shufflevector(v0, v1, 0, 1, 2, 3, 4, 5, 6, 7);
                        const bf16x8 kf0 = __builtin_shufflevector(k0, k1, 0, 1, 2, 3, 4, 5, 6, 7), kf1 = __builtin_shufflevector(k2, k3, 0, 1, 2, 3, 4, 5, 6, 7);
                        st0 = MFMA32(kf0, vf, st0); st1 = MFMA32(kf1, vf, st1);
                    }
                }
                RT_BAR();
                { LAS unsigned char* wp = lds + RT_OFF_ST + r32 * RT_ST_ROW + (64 * uw + 4 * hi) * 2;
#pragma unroll
                  for (int g = 0; g < 4; ++g) {
                    u32x2 w0, w1; w0.x = cvt_pk_bf16(st0[4 * g], st0[4 * g + 1]); w0.y = cvt_pk_bf16(st0[4 * g + 2], st0[4 * g + 3]);
                    w1.x = cvt_pk_bf16(st1[4 * g], st1[4 * g + 1]); w1.y = cvt_pk_bf16(st1[4 * g + 2], st1[4 * g + 3]);
                    *(LAS u32x2*)(wp + 16 * g) = w0; *(LAS u32x2*)(wp + 64 + 16 * g) = w1;
                  } }
                if (n < 31) RT_WRITE_V();
            }
        }
#undef RT_BAR
#undef RT_LOAD_K
#undef RT_LOAD_QS
#undef RT_LOAD_V
#undef RT_WRITE_V
    }
}

#define XB_TMO      128
#define XB_XCNT(j)  (256  + 64 * (j))
#define XB_XSUB(j)  (1280 + 64 * (j))
#define XB_XGEN(j)  (2304 + 64 * (j))
#define XB_TOP      3328
#define XB_TOPGEN   3392
#define XCD_BAR_WORDS 3456
#define XB_SPIN_CAP (1u << 18)

__device__ __forceinline__ unsigned xb_ld(unsigned* p)              { return __hip_atomic_load(p, __ATOMIC_RELAXED, __HIP_MEMORY_SCOPE_AGENT); }
__device__ __forceinline__ unsigned xb_add(unsigned* p, unsigned v) { return __hip_atomic_fetch_add(p, v, __ATOMIC_RELAXED, __HIP_MEMORY_SCOPE_AGENT); }
__device__ __forceinline__ unsigned xb_xcc_id() { return (unsigned)__builtin_amdgcn_s_getreg((3 << 11) | 20) & 0xFu; }
#define XB_SPIN(cond, bar) do { unsigned _sp = 0; while (cond) { __builtin_amdgcn_s_sleep(1); \
    if ((++_sp & 255u) == 0u) { if (xb_ld(&(bar)[XB_TMO])) break; if (_sp > XB_SPIN_CAP) { atomicAdd(&(bar)[XB_TMO], 1u); break; } } } } while (0)

struct XcdBarrier {
    unsigned* bar; unsigned x;
    volatile LAS unsigned* st;
};

__device__ __forceinline__ XcdBarrier xcd_barrier_post(unsigned* bar, volatile LAS unsigned* st) {
    XcdBarrier b; b.bar = bar; b.x = xb_xcc_id(); b.st = st;
    if (threadIdx.x == 0) (void)xb_add(&bar[XB_XCNT(b.x)], 1u);
    return b;
}
__device__ __forceinline__ void xcd_barrier_complete(unsigned* bar, unsigned x, unsigned& nloc, unsigned& nx) {
    const unsigned G = gridDim.x * gridDim.y * gridDim.z;
    unsigned sum, cnt, mine, sp = 0u;
    for (;;) {
        sum = 0u; cnt = 0u; mine = 0u;
#pragma unroll
        for (unsigned j = 0; j < 16; ++j) { const unsigned c = xb_ld(&bar[XB_XCNT(j)]); sum += c; cnt += (c > 0u) ? 1u : 0u; mine = (j == x) ? c : mine; }
        if (sum == G) break;
        __builtin_amdgcn_s_sleep(1);
        if ((++sp & 255u) == 0u) { if (xb_ld(&bar[XB_TMO])) break; if (sp > XB_SPIN_CAP) { atomicAdd(&bar[XB_TMO], 1u); break; } }
    }
    nloc = mine > 0u ? mine : 1u; nx = cnt > 0u ? cnt : 1u;
}

__device__ __forceinline__ void xcd_barrier(const XcdBarrier& b) {
    asm volatile("s_waitcnt vmcnt(0)" ::: "memory");
    __syncthreads();
    if (threadIdx.x == 0) {
        unsigned* bar = b.bar;
        __builtin_amdgcn_s_waitcnt(0);
        unsigned nloc = b.st[0], nx = b.st[1];
        if (nloc == 0u) { xcd_barrier_complete(bar, b.x, nloc, nx); b.st[0] = nloc; b.st[1] = nx; }
        const unsigned old = xb_add(&bar[XB_XSUB(b.x)], 1u);
        const unsigned gen = old / nloc;
        if (old + 1u == (gen + 1u) * nloc) {
            __builtin_amdgcn_fence(__ATOMIC_RELEASE, "agent");
            asm volatile("s_waitcnt vmcnt(0)" ::: "memory");
            const unsigned og = xb_add(&bar[XB_TOP], 1u);
            const unsigned tg = og / nx;
            if (og + 1u == (tg + 1u) * nx) xb_add(&bar[XB_TOPGEN], 1u);
            else XB_SPIN(xb_ld(&bar[XB_TOPGEN]) == tg, bar);
            __builtin_amdgcn_fence(__ATOMIC_ACQUIRE, "agent");
            xb_add(&bar[XB_XGEN(b.x)], 1u);
            asm volatile("s_waitcnt vmcnt(0)" ::: "memory");
        } else {
            XB_SPIN(xb_ld(&bar[XB_XGEN(b.x)]) == gen, bar);
            __builtin_amdgcn_fence(__ATOMIC_ACQUIRE, "agent");
            asm volatile("s_waitcnt vmcnt(0)" ::: "memory");
        }
    }
    __syncthreads();
}

#define FILL_RS_TABLE(S_, kk_) do { _Pragma("unroll") for (int ui_ = 0; ui_ < 4; ++ui_) { pg8::Unit u_; kk_[ui_] = -1; \
        if (S_.next(ui_, u_)) { kk_[ui_] = u_.pm; if (tl_ < 256) rstab[ui_ * 256 + tl_] = row_rs(ssq, u_.pm * 256 + tl_); } } __syncthreads(); } while (0)
__global__ void __launch_bounds__(NTHREADS, 2) mega(Args a) {
    extern __shared__ __attribute__((aligned(16))) unsigned char lds_raw[];
    LAS unsigned char* lds = (LAS unsigned char*)lds_raw;
    cg::grid_group grid = cg::this_grid();
    const int tid = threadIdx.x, lane0 = tid & 63, wave = __builtin_amdgcn_readfirstlane(tid >> 6);
    const int G = gridDim.x, bx = blockIdx.x;
    const int gw = bx * NWAVES + wave, NGW = G * NWAVES, gthreads = G * NTHREADS;
    const int vcu = (G % 8 == 0) ? (bx % 8) * (G / 8) + bx / 8 : bx;
    unsigned char* ws = a.ws;
    float* ssq = (float*)(ws + WS_SSQ); bf16* hb = (bf16*)(ws + WS_HB);
    unsigned char* R = ws + WS_R;

    volatile LAS unsigned* xb_st = (volatile LAS unsigned*)(lds + 131072 + 64);
    LAS float* rstab = (LAS float*)(lds + 131072 + 256);
    if (tid < 2) xb_st[tid] = 0u;
    unsigned* barw = (unsigned*)(ws + WS_BAR);
    __syncthreads();
    const XcdBarrier xbar = xcd_barrier_post(barw, xb_st);
    convert_layer(a, 0, lds, gw, NGW, wave, lane0);
    for (int m = gw; m < M; m += 2 * NGW) {
        const int lane = lane0; const int m1 = m + NGW; const bool two = m1 < M;
        const f32x4* xr0 = (const f32x4*)(a.in[0] + (size_t)m * D) + lane; const f32x4* xr1 = (const f32x4*)(a.in[0] + (size_t)(two ? m1 : m) * D) + lane;
        f32x4 v0[4], v1[4];
#pragma unroll
        for (int j = 0; j < 4; ++j) { v0[j] = __builtin_nontemporal_load(xr0 + 64 * j); v1[j] = __builtin_nontemporal_load(xr1 + 64 * j); }
        float s0 = 0.f, s1 = 0.f;
        unsigned long long* o0 = (unsigned long long*)(hb + (size_t)m * D) + lane; unsigned long long* o1 = (unsigned long long*)(hb + (size_t)m1 * D) + lane;
#pragma unroll
        for (int j = 0; j < 4; ++j) {
            s0 += (v0[j][0] * v0[j][0] + v0[j][1] * v0[j][1]) + (v0[j][2] * v0[j][2] + v0[j][3] * v0[j][3]);
            s1 += (v1[j][0] * v1[j][0] + v1[j][1] * v1[j][1]) + (v1[j][2] * v1[j][2] + v1[j][3] * v1[j][3]);
            o0[64 * j] = (unsigned long long)cvt_pk_bf16(v0[j][0], v0[j][1]) | ((unsigned long long)cvt_pk_bf16(v0[j][2], v0[j][3]) << 32);
            if (two) o1[64 * j] = (unsigned long long)cvt_pk_bf16(v1[j][0], v1[j][1]) | ((unsigned long long)cvt_pk_bf16(v1[j][2], v1[j][3]) << 32);
        }
        s0 = wave_sum(s0); s1 = wave_sum(s1);
        if (lane < 16) { ssq[(size_t)m * 16 + lane] = (lane == 0) ? s0 : 0.f; if (two) ssq[(size_t)m1 * 16 + lane] = (lane == 0) ? s1 : 0.f; }
    }
    if (a.ws == nullptr) grid.sync();
    xcd_barrier(xbar);

    bool conv_done = false;
    for (int i = 0; i < DEPTH; ++i) {
        const int kind = i % 3, j = i / 3;
        unsigned char* wb = ws + ((i & 1) ? WS_WB1 : WS_WB0);
        int tl_ = threadIdx.x; asm volatile("" : "+v"(tl_));
        const int lane = tl_ & 63, gtid = bx * NTHREADS + tl_;
        {
            const int n_in = kind == 0 ? 1280 : (kind == 1 ? 3072 : 4096);
            pg8::Gemm g{hb, (const bf16*)(wb + WB_IN), M, n_in, D}; pg8::StaticOrder S; S.init(M, n_in, G, bx);
            int kk[4]; FILL_RS_TABLE(S, kk);
            EpiRowScale<0> E{(bf16*)R, kind == 2 ? 2048 : n_in, ssq, kind == 2 ? 2048 : 0, (size_t)(R_V / 2), rstab, kk[0], kk[1], kk[2], kk[3]};
            pg8::gemm_phase<EpiRowScale<0>, pg8::StaticOrder, true, true>(lds, g, S, E);
            conv_done = false;
            if (kind == 0 && i + 1 < DEPTH && S.nwg > G && S.nwg < 2 * G) {
                const int first = S.nwg - G;
                if (bx >= first) convert_layer(a, i + 1, lds, (bx - first) * NWAVES + wave, (G - first) * NWAVES, wave, lane);
                conv_done = true;
            }
        }
        xcd_barrier(xbar);
        if (i + 1 < DEPTH && !conv_done) { convert_layer(a, i + 1, lds, gw, NGW, wave, lane); __syncthreads(); }
        if (kind == 0) swa_phase((const bf16*)R, a.in[5] + j * 16, (bf16*)(R + R_O), lds, vcu, G, tl_);
        else if (kind == 1) sb_phase((const bf16*)R, (bf16*)(R + R_O), lds, vcu, G, tl_);
        else {
            ret_scores((bf16*)R, (bf16*)(ws + WS_SC), vcu, G, tl_);
            xcd_barrier(xbar);
            ret_scan((const bf16*)R, (bf16*)(R + R_V), (const bf16*)(ws + WS_SC), (float*)(ws + WS_SSQO), lds, vcu, G, tl_);
            xcd_barrier(xbar);
            pg8::Gemm g{hb, (const bf16*)(wb + WB_IN) + (size_t)4096 * D, M, 2048, D}; pg8::StaticOrder S; S.init(M, 2048, G, bx);
            EpiGate E{(bf16*)R, (const bf16*)(R + R_V), ssq, (const float*)(ws + WS_SSQO)};
            pg8::gemm_phase<EpiGate, pg8::StaticOrder, true, true>(lds, g, S, E);
        }
        xcd_barrier(xbar);
        {
            const int k_o = kind == 2 ? 2048 : 1024;
            pg8::Gemm g{kind == 2 ? (const bf16*)R : (const bf16*)(R + R_O), (const bf16*)(wb + WB_O), M, D, k_o}; pg8::StaticOrder S; S.init(M, D, G, bx);
            EpiRes<false> E{nullptr, hb, ssq}; pg8::gemm_phase<EpiRes<false>, pg8::StaticOrder, true, true>(lds, g, S, E);
        }
        xcd_barrier(xbar);
        {
            pg8::Gemm g{hb, (const bf16*)(wb + WB_UP), M, FF, D}; pg8::StaticOrder S; S.init(M, FF, G, bx);
            int kk[4]; FILL_RS_TABLE(S, kk);
            EpiRowScale<1> E{(bf16*)R, FF, ssq, 0, 0, rstab, kk[0], kk[1], kk[2], kk[3]};
            pg8::gemm_phase<EpiRowScale<1>, pg8::StaticOrder, true, true>(lds, g, S, E);
        }
        xcd_barrier(xbar);
        {
            pg8::Gemm g{(const bf16*)R, (const bf16*)(wb + WB_DOWN), M, D, FF}; pg8::StaticOrder S; S.init(M, D, G, bx);
            EpiRes<false> E{nullptr, hb, ssq};
            pg8::gemm_phase<EpiRes<false>, pg8::StaticOrder, true, true>(lds, g, S, E);
        }
        xcd_barrier(xbar);
    }
    for (int m = gw; m < M; m += NGW) {
        const float rs = row_rs(ssq, m); const int lane = lane0;
        const u32x4* hr = (const u32x4*)(hb + (size_t)m * D) + lane; const f32x4* gr = (const f32x4*)a.in[3] + 2 * lane; f32x4* orow = (f32x4*)(a.out + (size_t)m * D) + 2 * lane;
#pragma unroll
        for (int jj = 0; jj < 2; ++jj) { const u32x4 hv = hr[64 * jj]; const f32x4 g0 = gr[128 * jj], g1 = gr[128 * jj + 1];
            const f32x4 v0 = (f32x4){bflo(hv.x), bfhi(hv.x), bflo(hv.y), bfhi(hv.y)}, v1 = (f32x4){bflo(hv.z), bfhi(hv.z), bflo(hv.w), bfhi(hv.w)};
            __builtin_nontemporal_store(v0 * rs * g0, orow + 128 * jj); __builtin_nontemporal_store(v1 * rs * g1, orow + 128 * jj + 1); }
    }
}

extern "C" void kernel_launch(void* const* d_in, const int* in_sizes, int n_in, void* d_out, int out_size, void* d_ws, size_t ws_size, hipStream_t stream) {
    static int grid = 0;
    if (grid == 0) {
        if (n_in != 13 || out_size != M * D || ws_size < WS_END) { fprintf(stderr, "kernel_launch: unexpected shapes (n_in %d out %d ws %zu)\n", n_in, out_size, ws_size); grid = -1; return; }
        int dev = 0, cus = 0, per_cu = 0;
        hipGetDevice(&dev); hipDeviceGetAttribute(&cus, hipDeviceAttributeMultiprocessorCount, dev);
        hipFuncSetAttribute((const void*)mega, hipFuncAttributeMaxDynamicSharedMemorySize, LDS_BYTES);
        if (hipOccupancyMaxActiveBlocksPerMultiprocessor(&per_cu, (const void*)mega, NTHREADS, LDS_BYTES) != hipSuccess || per_cu < 1) { fprintf(stderr, "kernel_launch: occupancy query gave %d\n", per_cu); per_cu = 1; }
        (void)hipGetLastError();
        grid = cus * per_cu;
        fprintf(stderr, "kernel_launch: grid %d (cus %d x %d)\n", grid, cus, per_cu);
    }
    if (grid < 0) return;
    Args a{};
    for (int i = 0; i < 13; ++i) a.in[i] = (const float*)d_in[i];
    a.out = (float*)d_out; a.ws = (unsigned char*)d_ws;
    if (hipMemsetAsync((char*)d_ws + WS_BAR, 0, XCD_BAR_WORDS * 4, stream) != hipSuccess) { fprintf(stderr, "kernel_launch: memset of the barrier words failed\n"); return; }
    void* args[] = {&a};
    hipError_t e = hipLaunchCooperativeKernel((const void*)mega, dim3(grid), dim3(NTHREADS), args, LDS_BYTES, stream);
    if (e != hipSuccess) fprintf(stderr, "cooperative launch failed: %s (grid %d)\n", hipGetErrorString(e), grid);
}
```

```cpp
#include <hip/hip_runtime.h>
#include <hip/hip_cooperative_groups.h>
#include <cstdio>
#include <cstdint>
namespace cg = cooperative_groups;
namespace pg8 {
#define PG8_LAS __attribute__((address_space(3)))
typedef unsigned short bf16_t;
typedef short bf16x8 __attribute__((ext_vector_type(8)));
typedef float f32x4 __attribute__((ext_vector_type(4)));
typedef unsigned u32x4 __attribute__((ext_vector_type(4)));
constexpr int BM = 256, BK = 64, HALF = 128, HTB = HALF * BK * 2  , STAGE_BYTES = 8 * HTB, NXCD = 8, WGM = 8;

__host__ __device__ __forceinline__ int lds_byte(int r, int c) { const int st = (r >> 4) * 2 + (c >> 5), rr = r & 15, cc = c & 31, ob = rr * 64 + cc * 2; return st * 1024 + (ob ^ (((ob >> 9) & 1) << 5)); }
__host__ __device__ __forceinline__ void stage_rc(int b, int& R, int& C) { const int st = b / 1024, sb = b % 1024, swz = sb ^ (((sb >> 9) & 1) << 5); R = (st >> 1) * 16 + swz / 64; C = (st & 1) * 32 + (swz % 64) / 2; }
__host__ __device__ __forceinline__ int perm32(int rho) { const int n = rho >> 4, i = rho & 15; return 8 * (i >> 2) + 4 * n + (i & 3); }

struct Unit { int pm, pn; };
struct Gemm { const bf16_t* A; const bf16_t* Bt; int M, N, K; };

struct StaticOrder {
    int nM, nN, nwg, G, c;
    __host__ __device__ void init(int M, int N, int G_, int c_) { nM = M / BM; nN = N / BM; nwg = nM * nN; G = G_; c = c_; }
    __host__ __device__ bool next(int i, Unit& u) const {
        const long L = (long)i * G + c; if (L >= nwg) return false;
        int wgid = (int)L; { const int q = nwg / NXCD, r = nwg % NXCD, xcd = wgid % NXCD, off = wgid / NXCD; wgid = (xcd < r ? xcd * (q + 1) : r * (q + 1) + (xcd - r) * q) + off; }
        const int nig = WGM * nN, gid = wgid / nig, fm = gid * WGM, gsz = (nM - fm) < WGM ? (nM - fm) : WGM;
        u.pm = fm + ((wgid % nig) % gsz); u.pn = (wgid % nig) / gsz; return true;
    }
    __device__ __forceinline__ void a_ready(const Unit&) const {}
    __device__ __forceinline__ void done(const Unit&) const {}
};

__device__ __forceinline__ unsigned cvt_pk_bf16(float lo, float hi) { unsigned r; asm volatile("v_cvt_pk_bf16_f32 %0, %1, %2" : "=v"(r) : "v"(lo), "v"(hi)); return r; }
typedef float f32x2 __attribute__((ext_vector_type(2)));
__device__ __forceinline__ f32x2 gelu_pk(f32x2 v) {
    const f32x2 av = __builtin_elementwise_abs(v), d = av * 0.2316418882f + 1.0f;
    f32x2 t; t.x = __builtin_amdgcn_rcpf(d.x); t.y = __builtin_amdgcn_rcpf(d.y);
    f32x2 q = t * 0.5307027145f + (-0.7265760135f); q = q * t + 0.7107068705f; q = q * t + (-0.142248368f); q = q * t + 0.127414796f; q = q * t;
    const f32x2 s = (v * v) * (-0.72134752044f);
    f32x2 e; e.x = __builtin_amdgcn_exp2f(s.x); e.y = __builtin_amdgcn_exp2f(s.y);
    const f32x2 m = v * (q * e), r = v - m;
    f32x2 o; o.x = v.x < 0.f ? m.x : r.x; o.y = v.y < 0.f ? m.y : r.y; return o;
}

template <int ACT  > struct EpiBf16 {
    static constexpr bool PERM = true, AFTER_DRAIN = false; static_assert(ACT == 0 || ACT == 1, "EpiBf16: ACT is 0 (none) or 1 (gelu_pk)");
    bf16_t* O; int ldc; const float* bias; int split_cols; size_t split_stride; float scale0;
    __device__ __forceinline__ void operator()(const f32x4 (&acc)[2][2][4][2], const Unit& u, int wr, int wc, int fr, int fq) const {
        const int row0 = u.pm * BM + wr * 64 + fr; int colt = u.pn * BM; bf16_t* base = O;
        float sc = 1.f; if (split_cols) { const int t = colt / split_cols; base += (size_t)t * split_stride; colt -= t * split_cols; if (t == 0) sc = scale0; }
        const int col0 = colt + wc * 32 + 8 * fq, bcol0 = u.pn * BM + wc * 32 + 8 * fq;
        f32x4 bv[2][2];
#pragma unroll
        for (int bj = 0; bj < 2; ++bj)
#pragma unroll
            for (int n = 0; n < 2; ++n) bv[bj][n] = bias ? *(const f32x4*)(bias + bcol0 + bj * HALF + 4 * n) : (f32x4){0.f, 0.f, 0.f, 0.f};
#pragma unroll
        for (int ai = 0; ai < 2; ++ai)
#pragma unroll
            for (int m = 0; m < 4; ++m) { bf16_t* rowp = base + (size_t)(row0 + ai * HALF + m * 16) * ldc + col0;
#pragma unroll
                for (int bj = 0; bj < 2; ++bj) { f32x4 v0 = acc[ai][bj][m][0] + bv[bj][0], v1 = acc[ai][bj][m][1] + bv[bj][1];
                    if (ACT == 1) { f32x2 a = gelu_pk((f32x2){v0[0], v0[1]}), b = gelu_pk((f32x2){v0[2], v0[3]}), c = gelu_pk((f32x2){v1[0], v1[1]}), d = gelu_pk((f32x2){v1[2], v1[3]});
                        v0 = (f32x4){a.x, a.y, b.x, b.y}; v1 = (f32x4){c.x, c.y, d.x, d.y}; }
                    v0 = v0 * sc; v1 = v1 * sc; u32x4 w; w.x = cvt_pk_bf16(v0[0], v0[1]); w.y = cvt_pk_bf16(v0[2], v0[3]); w.z = cvt_pk_bf16(v1[0], v1[1]); w.w = cvt_pk_bf16(v1[2], v1[3]);
                    *(u32x4*)(rowp + bj * HALF) = w; } }
    }
};

template <class Epi, class Sched, bool ALIGN_EPI = false, bool SP2 = false>
__device__ __forceinline__ void gemm_phase(PG8_LAS unsigned char* lds, const Gemm g, const Sched& S, const Epi& E) {
    int tid_ = threadIdx.x; asm volatile("" : "+v"(tid_));
    const int tid = tid_, wid = __builtin_amdgcn_readfirstlane(tid >> 6), lane = tid & 63, wr = wid >> 2, wc = wid & 3, fr = lane & 15, fq = lane >> 4;
    const int K = g.K, nt = K / BK;
    unsigned voffA[2], voffB[2];
#pragma unroll
    for (int i = 0; i < 2; ++i) { int R, C; stage_rc(tid * 16 + i * 8192, R, C); const int Rb = Epi::PERM ? ((R & ~31) + perm32(R & 31)) : R;
        voffA[i] = (unsigned)(R * K + C) * 2u; voffB[i] = (unsigned)(Rb * K + C) * 2u; }
    const size_t kstep = (size_t)(BK * 2);
    const size_t hstep = (size_t)HALF * K * 2;
    const size_t tstep = 2 * hstep;
    const unsigned ldsw = (unsigned)wid * 1024u;
    const int aoff = lds_byte(wr * 64 + fr, fq * 8), boff = lds_byte(wc * 32 + fr, fq * 8);
#define PG8_SA(b, h) (((b) * 2 + (h)) * HTB)
#define PG8_SB(b, h) ((4 + (b) * 2 + (h)) * HTB)
#define PG8_STAGE(bufoff, gbase, voff) do { _Pragma("unroll") for (int _i = 0; _i < 2; ++_i) \
        __builtin_amdgcn_global_load_lds((const unsigned*)((const char*)(gbase) + (voff)[_i]), (PG8_LAS unsigned*)(lds + (bufoff) + ldsw + _i * 8192), 16, 0, 0); } while (0)
#define PG8_LDA(dst, b, h) do { _Pragma("unroll") for (int m = 0; m < 4; ++m) _Pragma("unroll") for (int k = 0; k < 2; ++k) dst[m][k] = *(const PG8_LAS bf16x8*)(lds + PG8_SA(b, h) + aoff + m * 2048 + k * 1024); } while (0)
#define PG8_LDB(dst, b, h) do { _Pragma("unroll") for (int n = 0; n < 2; ++n) _Pragma("unroll") for (int k = 0; k < 2; ++k) dst[n][k] = *(const PG8_LAS bf16x8*)(lds + PG8_SB(b, h) + boff + n * 2048 + k * 1024); } while (0)
#define PG8_MMA(ai, bj, At, Bt) do { __builtin_amdgcn_s_setprio(1); _Pragma("unroll") for (int m = 0; m < 4; ++m) _Pragma("unroll") for (int n = 0; n < 2; ++n) _Pragma("unroll") for (int k = 0; k < 2; ++k) \
        acc[ai][bj][m][n] = __builtin_amdgcn_mfma_f32_16x16x32_bf16(Bt[n][k], At[m][k], acc[ai][bj][m][n], 0, 0, 0); __builtin_amdgcn_s_setprio(0); } while (0)
#define PG8_WAIT_V(n) asm volatile("s_waitcnt vmcnt(" #n ")" ::: "memory")
#define PG8_WAIT_L(n) asm volatile("s_waitcnt lgkmcnt(" #n ")" ::: "memory")
#define PG8_BAR __builtin_amdgcn_s_barrier()
#define PG8_SCHED __builtin_amdgcn_sched_barrier(0)
    Unit cur, nxt; int ui = 0;
    if (!S.next(0, cur)) return;
    f32x4 acc[2][2][4][2];
#pragma unroll
    for (int a = 0; a < 2; ++a)
#pragma unroll
        for (int b = 0; b < 2; ++b)
#pragma unroll
            for (int m = 0; m < 4; ++m)
#pragma unroll
                for (int n = 0; n < 2; ++n) acc[a][b][m][n] = (f32x4){0.f, 0.f, 0.f, 0.f};
    bf16x8 At[4][2], B0[2][2], B1[2][2];
    const char* cA = (const char*)g.A + (size_t)cur.pm * tstep; const char* cB = (const char*)g.Bt + (size_t)cur.pn * tstep;
    S.a_ready(cur);
    if constexpr (SP2) {
        PG8_STAGE(PG8_SB(0, 0), cB, voffB); PG8_STAGE(PG8_SB(0, 1), cB + hstep, voffB); PG8_STAGE(PG8_SA(0, 0), cA, voffA); PG8_STAGE(PG8_SA(0, 1), cA + hstep, voffA);
        if (wr == 1) PG8_BAR;
        PG8_WAIT_V(2); PG8_BAR;
        PG8_STAGE(PG8_SB(1, 0), cB + kstep, voffB); PG8_STAGE(PG8_SA(1, 0), cA + kstep, voffA); PG8_STAGE(PG8_SB(1, 1), cB + hstep + kstep, voffB);
        PG8_WAIT_V(6); PG8_BAR;
    } else {
        PG8_STAGE(PG8_SB(0, 0), cB, voffB); PG8_STAGE(PG8_SA(0, 0), cA, voffA); PG8_STAGE(PG8_SB(0, 1), cB + hstep, voffB); PG8_STAGE(PG8_SA(0, 1), cA + hstep, voffA);
        if (wr == 1) PG8_BAR;
        PG8_WAIT_V(4); PG8_BAR;
        PG8_STAGE(PG8_SB(1, 0), cB + kstep, voffB); PG8_STAGE(PG8_SA(1, 0), cA + kstep, voffA); PG8_STAGE(PG8_SB(1, 1), cB + hstep + kstep, voffB);
        PG8_WAIT_V(6); PG8_BAR;
    }
    for (;;) {
        const bool has_next = S.next(ui + 1, nxt);
        const char* nA = has_next ? (const char*)g.A + (size_t)nxt.pm * tstep : cA; const char* nB = has_next ? (const char*)g.Bt + (size_t)nxt.pn * tstep : cB;
        for (int t = 0; t < nt; t += 2) {
            const bool last = (t == nt - 2);
            const char* a1 = cA + (size_t)(t + 1) * kstep;
            const char* a2 = last ? nA : cA + (size_t)(t + 2) * kstep; const char* b2 = last ? nB : cB + (size_t)(t + 2) * kstep;
            const char* a3 = a2 + kstep; const char* b3 = b2 + kstep;
            if (last && has_next) S.a_ready(nxt);
            if constexpr (SP2) {
            PG8_LDB(B0, 0, 0); PG8_LDB(B1, 0, 1); PG8_SCHED; PG8_LDA(At, 0, 0); PG8_STAGE(PG8_SA(1, 1), a1 + hstep, voffA);
            PG8_WAIT_V(8); PG8_WAIT_L(0); PG8_BAR; PG8_MMA(0, 0, At, B0); PG8_MMA(0, 1, At, B1); PG8_BAR; PG8_SCHED;
            PG8_LDA(At, 0, 1); PG8_STAGE(PG8_SB(0, 0), b2, voffB); PG8_STAGE(PG8_SB(0, 1), b2 + hstep, voffB); PG8_STAGE(PG8_SA(0, 0), a2, voffA);
            PG8_WAIT_V(8); PG8_WAIT_L(0); PG8_BAR; PG8_MMA(1, 0, At, B0); PG8_MMA(1, 1, At, B1); PG8_BAR; PG8_SCHED;
            PG8_LDB(B0, 1, 0); PG8_LDB(B1, 1, 1); PG8_SCHED; PG8_LDA(At, 1, 0); PG8_STAGE(PG8_SA(0, 1), a2 + hstep, voffA);
            PG8_WAIT_V(8); PG8_WAIT_L(0); PG8_BAR; PG8_MMA(0, 0, At, B0); PG8_MMA(0, 1, At, B1); PG8_BAR; PG8_SCHED;
            PG8_LDA(At, 1, 1); PG8_STAGE(PG8_SB(1, 0), b3, voffB); PG8_STAGE(PG8_SB(1, 1), b3 + hstep, voffB); PG8_STAGE(PG8_SA(1, 0), a3, voffA);
            PG8_WAIT_V(8); PG8_WAIT_L(0); PG8_BAR; PG8_MMA(1, 0, At, B0); PG8_MMA(1, 1, At, B1); PG8_BAR; PG8_SCHED;
            } else {
            PG8_LDB(B0, 0, 0); PG8_SCHED; PG8_LDA(At, 0, 0); PG8_STAGE(PG8_SA(1, 1), a1 + hstep, voffA);
            PG8_WAIT_L(8); PG8_BAR; PG8_WAIT_L(0); PG8_MMA(0, 0, At, B0); PG8_BAR; PG8_SCHED;
            PG8_LDB(B1, 0, 1); PG8_STAGE(PG8_SB(0, 0), b2, voffB);
            PG8_BAR; PG8_WAIT_L(0); PG8_MMA(0, 1, At, B1); PG8_BAR;
            PG8_LDA(At, 0, 1); PG8_STAGE(PG8_SA(0, 0), a2, voffA);
            PG8_BAR; PG8_WAIT_L(0); PG8_MMA(1, 0, At, B0); PG8_BAR; PG8_SCHED;
            PG8_STAGE(PG8_SB(0, 1), b2 + hstep, voffB);
            PG8_WAIT_V(6); PG8_BAR; PG8_MMA(1, 1, At, B1); PG8_BAR;
            PG8_LDB(B0, 1, 0); PG8_SCHED; PG8_LDA(At, 1, 0); PG8_STAGE(PG8_SA(0, 1), a2 + hstep, voffA);
            PG8_WAIT_L(8); PG8_BAR; PG8_WAIT_L(0); PG8_MMA(0, 0, At, B0); PG8_BAR; PG8_SCHED;
            PG8_LDB(B1, 1, 1); PG8_STAGE(PG8_SB(1, 0), b3, voffB);
            PG8_BAR; PG8_WAIT_L(0); PG8_MMA(0, 1, At, B1); PG8_BAR;
            PG8_LDA(At, 1, 1); PG8_STAGE(PG8_SA(1, 0), a3, voffA);
            PG8_BAR; PG8_WAIT_L(0); PG8_MMA(1, 0, At, B0); PG8_BAR; PG8_SCHED;
            PG8_STAGE(PG8_SB(1, 1), b3 + hstep, voffB);
            PG8_WAIT_V(6); PG8_BAR; PG8_MMA(1, 1, At, B1); PG8_BAR;
            }
        }
        if constexpr (ALIGN_EPI) { if (wr == 0) PG8_BAR; }
        if constexpr (!Epi::AFTER_DRAIN) { E(acc, cur, wr, wc, fr, fq); S.done(cur); }
        if (!has_next) break;
#pragma unroll
        for (int a = 0; a < 2; ++a)
#pragma unroll
            for (int b = 0; b < 2; ++b)
#pragma unroll
                for (int m = 0; m < 4; ++m)
#pragma unroll
                    for (int n = 0; n < 2; ++n) acc[a][b][m][n] = (f32x4){0.f, 0.f, 0.f, 0.f};
        cur = nxt; cA = nA; cB = nB; ++ui;
        if constexpr (ALIGN_EPI) { if (wr == 1) PG8_BAR; }
    }
    PG8_WAIT_V(0);
    if constexpr (!ALIGN_EPI) { if (wr == 0) PG8_BAR; }
    PG8_BAR;
    if constexpr (Epi::AFTER_DRAIN) { E.fused(acc, cur, wr, wc, fr, fq, lds, wid, lane); S.done(cur); }
#undef PG8_SA
#undef PG8_SB
#undef PG8_STAGE
#undef PG8_LDA
#undef PG8_LDB
#undef PG8_MMA
#undef PG8_WAIT_V
#undef PG8_WAIT_L
#undef PG8_BAR
#undef PG8_SCHED
}
}

#define LAS __attribute__((address_space(3)))
typedef unsigned short bf16;
typedef pg8::f32x4 f32x4;
typedef pg8::u32x4 u32x4;
typedef unsigned u32x2 __attribute__((ext_vector_type(2)));
typedef float f32x2_t __attribute__((ext_vector_type(2))); typedef __bf16 bf16x2_t __attribute__((ext_vector_type(2)));
__device__ __forceinline__ unsigned cvt_pk_bf16(float lo, float hi) { f32x2_t v = {lo, hi}; bf16x2_t r = __builtin_convertvector(v, bf16x2_t); return __builtin_bit_cast(unsigned, r); }
constexpr int D = 1024, BATCH = 4, SEQ = 4096, M = BATCH * SEQ, FF = 4096, DEPTH = 4;
constexpr int NWAVES = 8, NTHREADS = 512;
constexpr float RMS_EPS = 1e-6f;
constexpr size_t MiB = 1u << 20;
constexpr size_t WS_SSQ = 0;
constexpr size_t WS_BAR = 1 * MiB;
constexpr size_t WS_HB = 2 * MiB;
constexpr size_t WS_WB0 = 34 * MiB, WS_WB1 = 66 * MiB;
constexpr size_t WS_R = 98 * MiB;
constexpr size_t WS_SC = 226 * MiB;
constexpr size_t WS_SSQO = 242 * MiB;
constexpr size_t WS_END = 246 * MiB;
constexpr size_t WB_IN = 0, WB_O = 12 * MiB, WB_UP = 16 * MiB, WB_DOWN = 24 * MiB;
constexpr size_t R_O = 96 * MiB;
constexpr size_t R_V = 64 * MiB;
constexpr int LDS_BYTES = 147456;

__device__ __forceinline__ float bflo(unsigned u) { return __uint_as_float(u << 16); }
__device__ __forceinline__ float bfhi(unsigned u) { return __uint_as_float(u & 0xffff0000u); }
__device__ __forceinline__ float wave_sum(float v) {
#pragma unroll
    for (int o = 1; o < 64; o <<= 1) v += __shfl_xor(v, o);
    return v;
}
__device__ __forceinline__ float row_rs(const float* ssq, int row) {
    const f32x4* p = (const f32x4*)(ssq + (size_t)row * 16);
    const f32x4 a = p[0], b = p[1], c = p[2], d = p[3];
    const float s = (((a[0] + a[1]) + (a[2] + a[3])) + ((b[0] + b[1]) + (b[2] + b[3]))) + (((c[0] + c[1]) + (c[2] + c[3])) + ((d[0] + d[1]) + (d[2] + d[3])));
    return rsqrtf(s * (1.f / 1024.f) + RMS_EPS);
}

template <int ACT> struct EpiRowScale {
    static constexpr bool PERM = true, AFTER_DRAIN = false;
    bf16* O; int ldc; const float* ssq; int split_cols; size_t split_stride;
    const LAS float* tab; int k0, k1, k2, k3;
    __device__ __forceinline__ void operator()(const f32x4 (&acc)[2][2][4][2], const pg8::Unit& u, int wr, int wc, int fr, int fq) const {
        const int row0 = u.pm * 256 + wr * 64 + fr; int colt = u.pn * 256; bf16* base = O;
        if (split_cols) { const int t = colt / split_cols; base += (size_t)t * split_stride; colt -= t * split_cols; }
        const int col0 = colt + wc * 32 + 8 * fq;
        const int slot = (u.pm == k0) ? 0 : (u.pm == k1) ? 1 : (u.pm == k2) ? 2 : (u.pm == k3) ? 3 : -1;
#pragma unroll
        for (int ai = 0; ai < 2; ++ai)
#pragma unroll
            for (int m = 0; m < 4; ++m) {
                const int row = row0 + ai * 128 + m * 16; const float rs = slot >= 0 ? tab[slot * 256 + wr * 64 + fr + ai * 128 + m * 16] : row_rs(ssq, row);
                bf16* rowp = base + (size_t)row * ldc + col0;
#pragma unroll
                for (int bj = 0; bj < 2; ++bj) {
                    f32x4 v0 = acc[ai][bj][m][0] * rs, v1 = acc[ai][bj][m][1] * rs;
                    if (ACT == 1) {
#pragma unroll
                        for (int e = 0; e < 4; ++e) { float a = fmaxf(v0[e], 0.f), b = fmaxf(v1[e], 0.f); v0[e] = a * a; v1[e] = b * b; }
                    }
                    u32x4 w; w.x = cvt_pk_bf16(v0[0], v0[1]); w.y = cvt_pk_bf16(v0[2], v0[3]); w.z = cvt_pk_bf16(v1[0], v1[1]); w.w = cvt_pk_bf16(v1[2], v1[3]);
                    *(u32x4*)(rowp + bj * 128) = w;
                }
            }
    }
};
template <bool BASE_F32> struct EpiRes {
    static constexpr bool PERM = true, AFTER_DRAIN = false;
    const float* xbase; bf16* hb; float* ssq;
    __device__ __forceinline__ void operator()(const f32x4 (&acc)[2][2][4][2], const pg8::Unit& u, int wr, int wc, int fr, int fq) const {
        const int col0 = u.pn * 256 + wc * 32 + 8 * fq;
#pragma unroll
        for (int ai = 0; ai < 2; ++ai)
#pragma unroll
            for (int m = 0; m < 4; ++m) {
                const int row = u.pm * 256 + ai * 128 + wr * 64 + m * 16 + fr; const size_t off = (size_t)row * D + col0; float s = 0.f;
#pragma unroll
                for (int bj = 0; bj < 2; ++bj) {
                    const size_t o = off + bj * 128;
                    f32x4 v0, v1;
                    if (BASE_F32) { v0 = *(const f32x4*)(xbase + o); v1 = *(const f32x4*)(xbase + o + 4); }
                    else { const u32x4 hv = *(const u32x4*)(hb + o); v0 = (f32x4){bflo(hv.x), bfhi(hv.x), bflo(hv.y), bfhi(hv.y)}; v1 = (f32x4){bflo(hv.z), bfhi(hv.z), bflo(hv.w), bfhi(hv.w)}; }
                    v0 = v0 + acc[ai][bj][m][0]; v1 = v1 + acc[ai][bj][m][1];
                    s += ((v0[0] * v0[0] + v0[1] * v0[1]) + (v0[2] * v0[2] + v0[3] * v0[3])) + ((v1[0] * v1[0] + v1[1] * v1[1]) + (v1[2] * v1[2] + v1[3] * v1[3]));
                    u32x4 w; w.x = cvt_pk_bf16(v0[0], v0[1]); w.y = cvt_pk_bf16(v0[2], v0[3]); w.z = cvt_pk_bf16(v1[0], v1[1]); w.w = cvt_pk_bf16(v1[2], v1[3]);
                    *(u32x4*)(hb + o) = w;
                }
                s += __shfl_xor(s, 16); s += __shfl_xor(s, 32);
                if (fq == 0) ssq[(size_t)row * 16 + u.pn * 4 + wc] = s;
            }
    }
};
struct EpiGate {
    static constexpr bool PERM = true, AFTER_DRAIN = false;
    bf16* Y; const bf16* Oin; const float* ssq; const float* rmso;
    __device__ __forceinline__ void operator()(const f32x4 (&acc)[2][2][4][2], const pg8::Unit& u, int wr, int wc, int fr, int fq) const {
        const int row0 = u.pm * 256 + wr * 64 + fr; const int col0 = u.pn * 256 + wc * 32 + 8 * fq;
#pragma unroll
        for (int ai = 0; ai < 2; ++ai)
#pragma unroll
            for (int m = 0; m < 4; ++m) {
                const int row = row0 + ai * 128 + m * 16; const float rs = row_rs(ssq, row);
                float ro; { const f32x4* p = (const f32x4*)(rmso + ((size_t)row * 4 + (u.pn >> 1)) * 16); const f32x4 a = p[0], b = p[1], c = p[2], d = p[3];
                    const float s = (((a[0] + a[1]) + (a[2] + a[3])) + ((b[0] + b[1]) + (b[2] + b[3]))) + (((c[0] + c[1]) + (c[2] + c[3])) + ((d[0] + d[1]) + (d[2] + d[3]))); ro = rsqrtf(s * (1.f / 512.f) + RMS_EPS); }
#pragma unroll
                for (int bj = 0; bj < 2; ++bj) {
                    const int c = col0 + bj * 128;
                    const u32x4 ov = *(const u32x4*)(Oin + (size_t)row * 2048 + c);
                    float o8[8] = {bflo(ov.x), bfhi(ov.x), bflo(ov.y), bfhi(ov.y), bflo(ov.z), bfhi(ov.z), bflo(ov.w), bfhi(ov.w)};
                    float y8[8];
#pragma unroll
                    for (int e = 0; e < 8; ++e) { const float g = (e < 4 ? acc[ai][bj][m][0][e & 3] : acc[ai][bj][m][1][e & 3]) * rs; const float sg = g / (1.f + __expf(-g)); y8[e] = sg * o8[e] * ro; }
                    u32x4 w; w.x = cvt_pk_bf16(y8[0], y8[1]); w.y = cvt_pk_bf16(y8[2], y8[3]); w.z = cvt_pk_bf16(y8[4], y8[5]); w.w = cvt_pk_bf16(y8[6], y8[7]);
                    *(u32x4*)(Y + (size_t)row * 2048 + c) = w;
                }
            }
    }
};

struct Args { const float* in[13]; float* out; unsigned char* ws; };

struct CvItem { const float* src; bf16* dst; const float* gain; float cs; int N, K; };
__device__ __forceinline__ void cv_load(const CvItem& d, float (&r)[32]) {
#pragma unroll
    for (int i = 0; i < 32; ++i) r[i] = __builtin_nontemporal_load(d.src + (size_t)(2 * i) * d.N);
}
__device__ __forceinline__ void cv_store(const CvItem& d, const float (&r)[32], LAS float* scr, int lane) {
#pragma unroll
    for (int i = 0; i < 32; ++i) scr[(2 * i + (lane >> 5)) * 33 + (lane & 31)] = r[i] * d.cs;
    asm volatile("s_waitcnt lgkmcnt(0)" ::: "memory");
    const int c = lane & 7;
    f32x4 g0 = (f32x4){1.f, 1.f, 1.f, 1.f}, g1 = g0;
    if (d.gain) { g0 = *(const f32x4*)(d.gain + 8 * c); g1 = *(const f32x4*)(d.gain + 8 * c + 4); }
#pragma unroll
    for (int j = 0; j < 4; ++j) { const int nn = (lane >> 3) + 8 * j; const LAS float* s = scr + (8 * c) * 33 + nn;
        u32x4 o; o.x = cvt_pk_bf16(s[0 * 33] * g0[0], s[1 * 33] * g0[1]); o.y = cvt_pk_bf16(s[2 * 33] * g0[2], s[3 * 33] * g0[3]);
        o.z = cvt_pk_bf16(s[4 * 33] * g1[0], s[5 * 33] * g1[1]); o.w = cvt_pk_bf16(s[6 * 33] * g1[2], s[7 * 33] * g1[3]);
        *(u32x4*)(d.dst + (size_t)nn * d.K + 8 * c) = o; }
    asm volatile("s_waitcnt lgkmcnt(0)" ::: "memory");
}
__device__ __forceinline__ void convert_layer(const Args& a, int i, int mask, LAS unsigned char* lds, int gw, int NGW, int wave, int lane) {
    const int kind = i % 3, j = i / 3;
    const float* w_in; int n_in; const float* w_o; int k_o; int sc_lo, sc_hi; float sc;
    if (kind == 0) { w_in = a.in[4] + (size_t)j * D * 1280; n_in = 1280; w_o = a.in[6] + (size_t)j * D * D; k_o = 1024; sc_lo = 0; sc_hi = 1024; sc = 0.125f; }
    else if (kind == 1) { w_in = a.in[7] + (size_t)j * D * 3072; n_in = 3072; w_o = a.in[8] + (size_t)j * D * D; k_o = 1024; sc_lo = 0; sc_hi = 1024; sc = 0.125f * 1.4426950408889634f; }
    else { w_in = a.in[9] + (size_t)j * D * 6144; n_in = 6144; w_o = a.in[10] + (size_t)j * 2048 * D; k_o = 2048; sc_lo = 1024; sc_hi = 2048; sc = 0.0625f; }
    const float* w_up = a.in[11] + (size_t)i * D * FF; const float* w_dn = a.in[12] + (size_t)i * FF * D;
    const float* g_attn = a.in[1] + (size_t)i * D; const float* g_mlp = a.in[2] + (size_t)i * D;
    unsigned char* wb = a.ws + ((i & 1) ? WS_WB1 : WS_WB0);
    LAS float* scr = (LAS float*)(lds + wave * 16384);
    const int I_in = (mask & 1) ? (D / 64) * (n_in / 32) : 0, I_o = (mask & 2) ? (k_o / 64) * (D / 32) : 0, I_up = (mask & 4) ? (D / 64) * (FF / 32) : 0, I_dn = (mask & 8) ? (FF / 64) * (D / 32) : 0;
    const int NITEMS = I_in + I_o + I_up + I_dn;
#define CV_DECODE(dsc, itv) do { int r_ = (itv); const float* W_; int K_, N_; bf16* WT_; const float* gn_; int lo_ = 0, hi_ = 0; \
        if (r_ < I_in) { W_ = w_in; K_ = D; N_ = n_in; WT_ = (bf16*)(wb + WB_IN); gn_ = g_attn; lo_ = sc_lo; hi_ = sc_hi; } \
        else if ((r_ -= I_in) < I_o) { W_ = w_o; K_ = k_o; N_ = D; WT_ = (bf16*)(wb + WB_O); gn_ = nullptr; } \
        else if ((r_ -= I_o) < I_up) { W_ = w_up; K_ = D; N_ = FF; WT_ = (bf16*)(wb + WB_UP); gn_ = g_mlp; } \
        else { r_ -= I_up; W_ = w_dn; K_ = FF; N_ = D; WT_ = (bf16*)(wb + WB_DOWN); gn_ = nullptr; } \
        const int nblk_ = N_ / 32, kb_ = r_ / nblk_, nb_ = r_ % nblk_, k0_ = 64 * kb_, n0_ = 32 * nb_, n_ = n0_ + (lane & 31); \
        (dsc).src = W_ + (size_t)(k0_ + (lane >> 5)) * N_ + n_; (dsc).dst = WT_ + (size_t)n0_ * K_ + k0_; (dsc).gain = gn_ ? gn_ + k0_ : nullptr; \
        (dsc).cs = (n_ >= lo_ && n_ < hi_) ? sc : 1.f; (dsc).N = N_; (dsc).K = K_; } while (0)
    for (int it = gw; it < NITEMS; it += 2 * NGW) {
        CvItem d0, d1; float r0[32], r1[32];
        CV_DECODE(d0, it); cv_load(d0, r0);
        const bool two = it + NGW < NITEMS;
        if (two) { CV_DECODE(d1, it + NGW); cv_load(d1, r1); }
        cv_store(d0, r0, scr, lane);
        if (two) cv_store(d1, r1, scr, lane);
    }
#undef CV_DECODE
}

#define UNPACK8(dst, vv_) do { (dst)[0] = bflo((vv_)[0]); (dst)[1] = bfhi((vv_)[0]); (dst)[2] = bflo((vv_)[1]); (dst)[3] = bfhi((vv_)[1]); (dst)[4] = bflo((vv_)[2]); (dst)[5] = bfhi((vv_)[2]); (dst)[6] = bflo((vv_)[3]); (dst)[7] = bfhi((vv_)[3]); } while (0)
__device__ __forceinline__ void swa_naive(const bf16* qkv, const float* sinks, bf16* o, int gtid, int gthreads) {
    for (int idx = gtid; idx < M * 16; idx += gthreads) {
        const int head = idx & 15, m = idx >> 4, t = m & (SEQ - 1), kv = head >> 3;
        float q[64], acc[64];
        { const u32x4* qp = (const u32x4*)(qkv + (size_t)m * 1280 + head * 64);
#pragma unroll
          for (int c = 0; c < 8; ++c) { const u32x4 w = qp[c]; UNPACK8(q + 8 * c, w); } }
#pragma unroll
        for (int d = 0; d < 64; ++d) acc[d] = 0.f;
        const float slope = exp2f(-0.5f * (float)(head + 1));
        float mr = sinks[head], l = 1.f;
        const int s0 = t - 127 < 0 ? 0 : t - 127;
        for (int s = s0; s <= t; ++s) {
            const bf16* kp = qkv + (size_t)(m - (t - s)) * 1280 + 1024 + kv * 64; const bf16* vp = kp + 128;
            float z = 0.f;
#pragma unroll
            for (int c = 0; c < 8; ++c) { const u32x4 w = ((const u32x4*)kp)[c]; float k8[8]; UNPACK8(k8, w);
#pragma unroll
                for (int e = 0; e < 8; ++e) z += q[8 * c + e] * k8[e]; }
            z -= slope * (float)(t - s);
            const float mn = fmaxf(mr, z), corr = __expf(mr - mn), p = __expf(z - mn);
            l = l * corr + p; mr = mn;
#pragma unroll
            for (int c = 0; c < 8; ++c) { const u32x4 w = ((const u32x4*)vp)[c]; float v8[8]; UNPACK8(v8, w);
#pragma unroll
                for (int e = 0; e < 8; ++e) acc[8 * c + e] = acc[8 * c + e] * corr + p * v8[e]; }
        }
        const float inv = 1.f / l;
        u32x4* op = (u32x4*)(o + (size_t)m * 1024 + head * 64);
#pragma unroll
        for (int c = 0; c < 8; ++c) { u32x4 w; w.x = cvt_pk_bf16(acc[8 * c] * inv, acc[8 * c + 1] * inv); w.y = cvt_pk_bf16(acc[8 * c + 2] * inv, acc[8 * c + 3] * inv);
            w.z = cvt_pk_bf16(acc[8 * c + 4] * inv, acc[8 * c + 5] * inv); w.w = cvt_pk_bf16(acc[8 * c + 6] * inv, acc[8 * c + 7] * inv); op[c] = w; }
    }
}
__device__ __forceinline__ void sb_naive(const bf16* qkv, bf16* o, int gtid, int gthreads) {
    int it = 0; const bool mir = (gthreads % (SEQ * 16)) == 0;
    for (int idx = gtid; idx < M * 16; idx += gthreads, ++it) {
        const int head = idx & 15; int m = idx >> 4; int t = m & (SEQ - 1);
        if (mir && (it & 1)) { t = SEQ - 1 - t; m = (m & ~(SEQ - 1)) + t; }
        float q[64], acc[64];
        { const u32x4* qp = (const u32x4*)(qkv + (size_t)m * 3072 + head * 64);
#pragma unroll
          for (int c = 0; c < 8; ++c) { const u32x4 w = qp[c]; UNPACK8(q + 8 * c, w); } }
#pragma unroll
        for (int d = 0; d < 64; ++d) acc[d] = 0.f;
        float carry = 0.f;
        for (int s = t - 1; s >= 0; --s) {
            const bf16* kp = qkv + (size_t)(m - (t - s)) * 3072 + 1024 + head * 64; const bf16* vp = kp + 1024;
            float z = 0.f;
#pragma unroll
            for (int c = 0; c < 8; ++c) { const u32x4 w = ((const u32x4*)kp)[c]; float k8[8]; UNPACK8(k8, w);
#pragma unroll
                for (int e = 0; e < 8; ++e) z += q[8 * c + e] * k8[e]; }
            const float sp = fmaxf(z, 0.f) + __logf(1.f + __expf(-fabsf(z)));
            const float p = __expf(z - sp + carry);
            carry -= sp;
#pragma unroll
            for (int c = 0; c < 8; ++c) { const u32x4 w = ((const u32x4*)vp)[c]; float v8[8]; UNPACK8(v8, w);
#pragma unroll
                for (int e = 0; e < 8; ++e) acc[8 * c + e] += p * v8[e]; }
        }
        u32x4* op = (u32x4*)(o + (size_t)m * 1024 + head * 64);
#pragma unroll
        for (int c = 0; c < 8; ++c) { u32x4 w; w.x = cvt_pk_bf16(acc[8 * c], acc[8 * c + 1]); w.y = cvt_pk_bf16(acc[8 * c + 2], acc[8 * c + 3]);
            w.z = cvt_pk_bf16(acc[8 * c + 4], acc[8 * c + 5]); w.w = cvt_pk_bf16(acc[8 * c + 6], acc[8 * c + 7]); op[c] = w; }
    }
}
__device__ __forceinline__ void ret_naive(const bf16* qk, bf16* vo, int gtid, int gthreads) {
    for (int idx = gtid; idx < 16 * 512 * 16; idx += gthreads) {
        const int dqi = idx & 15, e = (idx >> 4) & 511, bh = idx >> 13, b = bh >> 2, h = bh & 3;
        const float gamma = 1.f - exp2f(-5.f - (float)h);
        float S[16];
#pragma unroll
        for (int j = 0; j < 16; ++j) S[j] = 0.f;
        for (int t = 0; t < SEQ; ++t) {
            const size_t row = (size_t)b * SEQ + t;
            const u32x4* qp = (const u32x4*)(qk + row * 2048 + h * 256 + dqi * 16);
            const u32x4* kp = (const u32x4*)(qk + row * 2048 + 1024 + h * 256 + dqi * 16);
            bf16* vp = vo + row * 2048 + h * 512 + e;
            const float v = __uint_as_float((unsigned)(*vp) << 16);
            float q16[16], k16[16];
            { const u32x4 w0 = qp[0], w1 = qp[1]; UNPACK8(q16, w0); UNPACK8(q16 + 8, w1); }
            { const u32x4 w0 = kp[0], w1 = kp[1]; UNPACK8(k16, w0); UNPACK8(k16 + 8, w1); }
            float part = 0.f;
#pragma unroll
            for (int j = 0; j < 16; ++j) { S[j] = gamma * S[j] + k16[j] * v; part += q16[j] * S[j]; }
            part += __shfl_xor(part, 1); part += __shfl_xor(part, 2); part += __shfl_xor(part, 4); part += __shfl_xor(part, 8);
            if (dqi == 0) *vp = (bf16)(cvt_pk_bf16(part, 0.f) & 0xffffu);
        }
    }
}

typedef short bf16x8 __attribute__((ext_vector_type(8)));
typedef short s16x4 __attribute__((ext_vector_type(4)));
typedef float f32x16 __attribute__((ext_vector_type(16)));
#define MFMA32(a, b, c) __builtin_amdgcn_mfma_f32_32x32x16_bf16((a), (b), (c), 0, 0, 0)
__device__ __forceinline__ s16x4 tr16(const LAS unsigned char* p) { return __builtin_bit_cast(s16x4, __builtin_amdgcn_ds_read_tr16_b64_v4i16((LAS s16x4*)p)); }
__device__ __forceinline__ bf16x8 pack8(const float* a) {
    u32x4 w; w.x = cvt_pk_bf16(a[0], a[1]); w.y = cvt_pk_bf16(a[2], a[3]); w.z = cvt_pk_bf16(a[4], a[5]); w.w = cvt_pk_bf16(a[6], a[7]);
    return __builtin_bit_cast(bf16x8, w);
}
constexpr int SB_ROW = 144, SB_TILE = 64 * SB_ROW;
__device__ __forceinline__ void sb_phase(const bf16* qkv, bf16* o, LAS unsigned char* lds, int vcu, int G, int tid) {
    const int lane = tid & 63, wave = __builtin_amdgcn_readfirstlane(tid >> 6), r32 = lane & 31, hi = lane >> 5;
    const int srow = tid >> 3, sch = tid & 7;
    const int i16 = lane & 15, tq = i16 >> 2, tp = i16 & 3, blk = (lane >> 4) & 1;
    const int vtr_off = (4 * hi + tq) * SB_ROW + (16 * blk + 4 * tp) * 2;
    LAS unsigned* flg = (LAS unsigned*)(lds + 4 * SB_TILE);
    for (int P = vcu; P < 512; P += G) {
        const int bh = P >> 3, jj = P & 7, b = bh >> 4, h = bh & 15;
        for (int half = 0; half < 2; ++half) {
            const int jq = half ? 15 - jj : jj;
            const size_t mb = (size_t)b * SEQ;
            const bf16* kbase = qkv + mb * 3072 + 1024 + h * 64; const bf16* vbase = kbase + 1024;
            const int tq0 = 256 * jq + 32 * wave;
            bf16x8 qf[4];
            { const bf16* qp = qkv + (mb + tq0 + r32) * 3072 + h * 64 + 8 * hi;
#pragma unroll
              for (int d0 = 0; d0 < 4; ++d0) qf[d0] = *(const bf16x8*)(qp + 16 * d0); }
            f32x16 o0, o1;
#pragma unroll
            for (int r = 0; r < 16; ++r) { o0[r] = 0.f; o1[r] = 0.f; }
            float carry = 0.f; bool mydone = false;
            const int nst = 4 * jq + 4;
            { const size_t roff = (size_t)(64 * (nst - 1) + srow) * 3072 + sch * 8;
              const u32x4 kk = *(const u32x4*)(kbase + roff), vv = *(const u32x4*)(vbase + roff);
              *(LAS u32x4*)(lds + srow * SB_ROW + sch * 16) = kk; *(LAS u32x4*)(lds + 2 * SB_TILE + srow * SB_ROW + sch * 16) = vv; }
            __syncthreads();
            for (int st = nst - 1, it = 0; st >= 0; --st, ++it) {
                const int cb = it & 1;
                const LAS unsigned char* Kb = lds + cb * SB_TILE; const LAS unsigned char* Vb = lds + 2 * SB_TILE + cb * SB_TILE;
                u32x4 kk, vv;
                if (st > 0) { const size_t roff = (size_t)(64 * (st - 1) + srow) * 3072 + sch * 8; kk = *(const u32x4*)(kbase + roff); vv = *(const u32x4*)(vbase + roff); }
                if (64 * st < tq0 + 32 && !mydone) {
                    const bool diag = (64 * st + 63 >= tq0);
#pragma unroll
                    for (int sub = 1; sub >= 0; --sub) {
                        f32x16 p;
#pragma unroll
                        for (int r = 0; r < 16; ++r) p[r] = 0.f;
                        const LAS unsigned char* kp = Kb + (32 * sub + r32) * SB_ROW + 16 * hi;
#pragma unroll
                        for (int d0 = 0; d0 < 4; ++d0) p = MFMA32(*(const LAS bf16x8*)(kp + 32 * d0), qf[d0], p);
                        float l[16]; const int sg0 = 64 * st + 32 * sub + 4 * hi, tg = tq0 + r32;
#pragma unroll
                        for (int r = 0; r < 16; ++r) {
                            const float z = p[r]; const float e = __builtin_amdgcn_exp2f(z); float lg = __builtin_amdgcn_logf(1.f + e); lg = z > 32.f ? z : lg;
                            const bool valid = !diag || (sg0 + (r & 3) + 8 * (r >> 2) < tg);
                            l[r] = valid ? -lg : 0.f;
                        }
                        float gs[4], ot[4], ps[4];
#pragma unroll
                        for (int g = 0; g < 4; ++g) { gs[g] = (l[4 * g] + l[4 * g + 1]) + (l[4 * g + 2] + l[4 * g + 3]); ot[g] = __shfl_xor(gs[g], 32); ps[g] = gs[g] + ot[g]; }
                        float T[4]; T[3] = 0.f; T[2] = ps[3]; T[1] = ps[3] + ps[2]; T[0] = T[1] + ps[1];
                        const float total = T[0] + ps[0];
                        float A[16];
#pragma unroll
                        for (int g = 0; g < 4; ++g) {
                            const float base = carry + T[g] + (hi == 0 ? ot[g] : 0.f);
                            const float i3 = base + l[4 * g + 3], i2 = i3 + l[4 * g + 2], i1 = i2 + l[4 * g + 1], i0 = i1 + l[4 * g];
                            A[4 * g + 3] = __builtin_amdgcn_exp2f(p[4 * g + 3] + i3); A[4 * g + 2] = __builtin_amdgcn_exp2f(p[4 * g + 2] + i2);
                            A[4 * g + 1] = __builtin_amdgcn_exp2f(p[4 * g + 1] + i1); A[4 * g] = __builtin_amdgcn_exp2f(p[4 * g] + i0);
                        }
                        if (diag) {
#pragma unroll
                            for (int r = 0; r < 16; ++r) A[r] = (sg0 + (r & 3) + 8 * (r >> 2) < tg) ? A[r] : 0.f;
                        }
                        carry += total;
                        const bf16x8 pf0 = pack8(A), pf1 = pack8(A + 8);
#pragma unroll
                        for (int s = 0; s < 2; ++s) {
                            const LAS unsigned char* vp = Vb + (32 * sub + 16 * s) * SB_ROW + vtr_off;
                            const s16x4 a0 = tr16(vp), a1 = tr16(vp + 8 * SB_ROW), b0 = tr16(vp + 64), b1 = tr16(vp + 64 + 8 * SB_ROW);
                            const bf16x8 vf0 = __builtin_shufflevector(a0, a1, 0, 1, 2, 3, 4, 5, 6, 7), vf1 = __builtin_shufflevector(b0, b1, 0, 1, 2, 3, 4, 5, 6, 7);
                            o0 = MFMA32(vf0, s ? pf1 : pf0, o0); o1 = MFMA32(vf1, s ? pf1 : pf0, o1);
                        }
                    }
                }
                if (64 * st < tq0 + 32) mydone = __all(carry <= -150.f);
                if (lane == 0) flg[(it & 1) * 8 + wave] = mydone ? 1u : 0u;
                if (st > 0) { LAS unsigned char* Kn = lds + (cb ^ 1) * SB_TILE; *(LAS u32x4*)(Kn + srow * SB_ROW + sch * 16) = kk; *(LAS u32x4*)(Kn + 2 * SB_TILE + srow * SB_ROW + sch * 16) = vv; }
                __syncthreads();
                { const u32x4 f0 = *(const LAS u32x4*)(flg + (it & 1) * 8), f1 = *(const LAS u32x4*)(flg + (it & 1) * 8 + 4);
                  if ((f0.x & f0.y & f0.z & f0.w & f1.x & f1.y & f1.z & f1.w) != 0u) break; }
            }
            bf16* op = o + (mb + tq0 + r32) * 1024 + h * 64 + 4 * hi;
#pragma unroll
            for (int g = 0; g < 4; ++g) {
                u32x2 w0, w1; w0.x = cvt_pk_bf16(o0[4 * g], o0[4 * g + 1]); w0.y = cvt_pk_bf16(o0[4 * g + 2], o0[4 * g + 3]);
                w1.x = cvt_pk_bf16(o1[4 * g], o1[4 * g + 1]); w1.y = cvt_pk_bf16(o1[4 * g + 2], o1[4 * g + 3]);
                *(u32x2*)(op + 8 * g) = w0; *(u32x2*)(op + 32 + 8 * g) = w1;
            }
        }
    }
}

__device__ __forceinline__ void swa_phase(const bf16* qkv, const float* sinks, bf16* o, LAS unsigned char* lds, int vcu, int G, int tid) {
    const int lane = tid & 63, wave = __builtin_amdgcn_readfirstlane(tid >> 6), r32 = lane & 31, hi = lane >> 5;
    const int i16 = lane & 15, tq = i16 >> 2, tp = i16 & 3, blk = (lane >> 4) & 1;
    const int vtr_off = (4 * hi + tq) * SB_ROW + (16 * blk + 4 * tp) * 2;
    LAS unsigned char* Kb = lds; LAS unsigned char* Vb = lds + 256 * SB_ROW;
    for (int u = vcu; u < 256; u += G) {
        const int kv = u & 1, n = (u >> 1) & 31, b = u >> 6;
        const int head = kv * 8 + wave;
        const float slope = exp2f(-0.5f * (float)(head + 1)), sink = sinks[head];
        __syncthreads();
#pragma unroll
        for (int c4 = 0; c4 < 4; ++c4) {
            const int idx = tid + NTHREADS * c4, kr = idx >> 3, ch = idx & 7;
            u32x4 kk = (u32x4){0u, 0u, 0u, 0u}, vv = kk;
            if (n > 0 || kr >= 128) { const bf16* p = qkv + ((size_t)b * SEQ + 128 * (n - 1) + kr) * 1280 + 1024 + kv * 64 + ch * 8; kk = *(const u32x4*)p; vv = *(const u32x4*)(p + 128); }
            *(LAS u32x4*)(Kb + kr * SB_ROW + ch * 16) = kk; *(LAS u32x4*)(Vb + kr * SB_ROW + ch * 16) = vv;
        }
        __syncthreads();
        for (int sb = 0; sb < 4; ++sb) {
            const size_t qrow = (size_t)b * SEQ + 128 * n + 32 * sb + r32;
            bf16x8 qf[4];
            { const bf16* qp = qkv + qrow * 1280 + head * 64 + 8 * hi;
#pragma unroll
              for (int d0 = 0; d0 < 4; ++d0) qf[d0] = *(const bf16x8*)(qp + 16 * d0); }
            const int kl = 128 + 32 * sb + r32;
            float lg[5][16]; float mx = sink;
#pragma unroll
            for (int kt = 0; kt < 5; ++kt) {
                f32x16 p;
#pragma unroll
                for (int r = 0; r < 16; ++r) p[r] = 0.f;
                const LAS unsigned char* kp = Kb + (32 * (sb + kt) + r32) * SB_ROW + 16 * hi;
#pragma unroll
                for (int d0 = 0; d0 < 4; ++d0) p = MFMA32(*(const LAS bf16x8*)(kp + 32 * d0), qf[d0], p);
#pragma unroll
                for (int r = 0; r < 16; ++r) {
                    const int kvl = 32 * (sb + kt) + (r & 3) + 8 * (r >> 2) + 4 * hi, dist = kl - kvl;
                    const bool valid = dist >= 0 && dist < 128 && (n > 0 || kvl >= 128);
                    const float v = valid ? p[r] - slope * (float)dist : -1e30f;
                    lg[kt][r] = v; mx = fmaxf(mx, v);
                }
            }
            mx = fmaxf(mx, __shfl_xor(mx, 32));
            float l = 0.f;
            f32x16 o0, o1;
#pragma unroll
            for (int r = 0; r < 16; ++r) { o0[r] = 0.f; o1[r] = 0.f; }
#pragma unroll
            for (int kt = 0; kt < 5; ++kt) {
#pragma unroll
                for (int r = 0; r < 16; ++r) { const float e = __expf(lg[kt][r] - mx); lg[kt][r] = e; l += e; }
                const bf16x8 pf0 = pack8(&lg[kt][0]), pf1 = pack8(&lg[kt][8]);
#pragma unroll
                for (int s = 0; s < 2; ++s) {
                    const LAS unsigned char* vp = Vb + (32 * (sb + kt) + 16 * s) * SB_ROW + vtr_off;
                    const s16x4 a0 = tr16(vp), a1 = tr16(vp + 8 * SB_ROW), b0 = tr16(vp + 64), b1 = tr16(vp + 64 + 8 * SB_ROW);
                    const bf16x8 vf0 = __builtin_shufflevector(a0, a1, 0, 1, 2, 3, 4, 5, 6, 7), vf1 = __builtin_shufflevector(b0, b1, 0, 1, 2, 3, 4, 5, 6, 7);
                    o0 = MFMA32(vf0, s ? pf1 : pf0, o0); o1 = MFMA32(vf1, s ? pf1 : pf0, o1);
                }
            }
            l += __shfl_xor(l, 32);
            const float inv = 1.f / (l + __expf(sink - mx));
            bf16* op = o + qrow * 1024 + head * 64 + 4 * hi;
#pragma unroll
            for (int g = 0; g < 4; ++g) {
                u32x2 w0, w1; w0.x = cvt_pk_bf16(o0[4 * g] * inv, o0[4 * g + 1] * inv); w0.y = cvt_pk_bf16(o0[4 * g + 2] * inv, o0[4 * g + 3] * inv);
                w1.x = cvt_pk_bf16(o1[4 * g] * inv, o1[4 * g + 1] * inv); w1.y = cvt_pk_bf16(o1[4 * g + 2] * inv, o1[4 * g + 3] * inv);
                *(u32x2*)(op + 8 * g) = w0; *(u32x2*)(op + 32 + 8 * g) = w1;
            }
        }
    }
}

__device__ __forceinline__ void ret_scores(bf16* qk, bf16* sc, int vcu, int G, int tid) {
    const int lane = tid & 63, wave = __builtin_amdgcn_readfirstlane(tid >> 6), r32 = lane & 31, hi = lane >> 5;
    const int it = wave >> 1, jh = wave & 1;
    for (int u = vcu; u < 512; u += G) {
        const int bh = u >> 5, n = u & 31, b = bh >> 2, h = bh & 3;
        const float lg = log2f(1.f - exp2f(-5.f - (float)h));
        const size_t row0 = (size_t)b * SEQ + n * 128;
        const bf16* qp = qk + (row0 + 32 * it + r32) * 2048 + h * 256 + 8 * hi;
        bf16x8 qf[16];
#pragma unroll
        for (int ks = 0; ks < 16; ++ks) qf[ks] = *(const bf16x8*)(qp + 16 * ks);
#pragma unroll
        for (int jt2 = 0; jt2 < 2; ++jt2) {
            const int jt = 2 * jh + jt2;
            if (jt <= it) {
                const bf16* kp = qk + (row0 + 32 * jt + r32) * 2048 + 1024 + h * 256 + 8 * hi;
                f32x16 p;
#pragma unroll
                for (int r = 0; r < 16; ++r) p[r] = 0.f;
#pragma unroll
                for (int ks = 0; ks < 16; ++ks) p = MFMA32(*(const bf16x8*)(kp + 16 * ks), qf[ks], p);
                const int i = 32 * it + r32;
                bf16* sp = sc + (size_t)u * 16384 + (size_t)(it * 8 + 2 * jt) * 512 + r32 * 8 + 4 * hi;
#pragma unroll
                for (int g = 0; g < 4; ++g) {
                    float v[4];
#pragma unroll
                    for (int e = 0; e < 4; ++e) { const int j = 32 * jt + 8 * g + 4 * hi + e; v[e] = (i >= j) ? p[4 * g + e] * exp2f((float)(i - j) * lg) : 0.f; }
                    u32x2 w; w.x = cvt_pk_bf16(v[0], v[1]); w.y = cvt_pk_bf16(v[2], v[3]);
                    *(u32x2*)(sp + (g >> 1) * 512 + (g & 1) * 256) = w;
                }
            }
        }
        __syncthreads();
        if (jh == 0) {
            char* qc = (char*)(qk + row0 * 2048 + h * 256) + (size_t)(it * 32 + hi) * 4096 + r32 * 16;
#pragma unroll
            for (int ks = 0; ks < 16; ++ks) *(bf16x8*)(qc + ks * 8192) = qf[ks];
        }
    }
}
constexpr int RT_ST_ROW = 528, RT_V_ROW = 80, RT_K_ROW = 144;
constexpr int RT_OFF_ST = 0, RT_OFF_V = 32 * RT_ST_ROW, RT_OFF_VD = RT_OFF_V + 128 * RT_V_ROW, RT_OFF_K = RT_OFF_VD + 128 * RT_V_ROW, RT_SLAB = 64 * RT_K_ROW;
__device__ __forceinline__ void ret_scan(const bf16* qk, bf16* vo, const bf16* sc, float* ssqo, LAS unsigned char* lds, int vcu, int G, int tid) {
    const int lane = tid & 63, wave = __builtin_amdgcn_readfirstlane(tid >> 6), r32 = lane & 31, hi = lane >> 5;
    const int i16 = lane & 15, tq = i16 >> 2, tp = i16 & 3, blk = (lane >> 4) & 1;
    const int trv = (8 * hi + tq) * RT_V_ROW + (16 * blk + 4 * tp) * 2, trk = (8 * hi + tq) * RT_K_ROW + (16 * blk + 4 * tp) * 2;
    const int vj = tid >> 2, vch = tid & 3;
    const int krj = lane >> 3, kch = lane & 7, uw = wave & 3;
    const bool owave = wave < 4;
    LAS unsigned char* slab = lds + RT_OFF_K + uw * RT_SLAB;
    for (int u = vcu; u < 256; u += G) {
        const int bh = u >> 4, es = u & 15, b = bh >> 2, h = bh & 3, e0 = 32 * es;
        const float lg = log2f(1.f - exp2f(-5.f - (float)h)), cdec = exp2f(128.f * lg);
        const float kd = exp2f((float)(127 - vj) * lg);
        const size_t rowb = (size_t)b * SEQ;
        const int i = 32 * uw + r32;
        const float qd = exp2f((float)(i + 1) * lg);
        f32x16 st0, st1;
#pragma unroll
        for (int r = 0; r < 16; ++r) { st0[r] = 0.f; st1[r] = 0.f; }
        u32x4 kreg[16], vreg; bf16x8 qreg[16], sreg[8];
        unsigned offq = (unsigned)(hi * 4096 + r32 * 16), offs = (unsigned)(lane * 16), offk = (unsigned)(krj * 2048 + 8 * kch) * 2u, offv = (unsigned)(vj * 2048 + 8 * vch) * 2u;
        unsigned offo = (unsigned)(i * 2048 + 4 * hi) * 2u, offsq = (unsigned)(i * 64) * 4u;
        const char* const qbase = (const char*)(qk + rowb * 2048 + h * 256);
        const char* const kbase = (const char*)(qk + rowb * 2048 + 1024 + h * 256 + 64 * uw);
        const char* const sbase = (const char*)(sc + (size_t)(bh * 32) * 16384);
        char* const vbase = (char*)(vo + rowb * 2048 + h * 512 + e0);
        char* const sqbase = (char*)(ssqo + (rowb * 4 + h) * 16 + es);
#define RT_LOAD_K(nn, half) do { const char* kb_ = kbase + (size_t)(128 * (nn) + 64 * (half)) * 4096; _Pragma("unroll") for (int c8 = 0; c8 < 8; ++c8) \
            kreg[8 * (half) + c8] = *(const u32x4*)(kb_ + c8 * 32768 + offk); } while (0)
#define RT_LOAD_QS(nn) do { const char* qb_ = qbase + (size_t)(128 * (nn) + 32 * uw) * 4096; \
            _Pragma("unroll") for (int ks = 0; ks < 16; ++ks) qreg[ks] = *(const bf16x8*)(qb_ + 8192 * ks + offq); \
            const char* sb_ = sbase + (size_t)(nn) * 32768 + uw * 8192; \
            _Pragma("unroll") for (int ks = 0; ks < 8; ++ks) if (ks < 2 * uw + 2) sreg[ks] = *(const bf16x8*)(sb_ + 1024 * ks + offs); } while (0)
#define RT_LOAD_V(nn) do { vreg = *(const u32x4*)(vbase + (size_t)(128 * (nn)) * 4096 + offv); } while (0)
#define RT_WRITE_V() do { *(LAS u32x4*)(lds + RT_OFF_V + vj * RT_V_ROW + vch * 16) = vreg; float f8[8]; UNPACK8(f8, vreg); \
            u32x4 wd; wd.x = cvt_pk_bf16(f8[0] * kd, f8[1] * kd); wd.y = cvt_pk_bf16(f8[2] * kd, f8[3] * kd); wd.z = cvt_pk_bf16(f8[4] * kd, f8[5] * kd); wd.w = cvt_pk_bf16(f8[6] * kd, f8[7] * kd); \
            *(LAS u32x4*)(lds + RT_OFF_VD + vj * RT_V_ROW + vch * 16) = wd; } while (0)
        __syncthreads();
        for (int x = tid * 16; x < 32 * RT_ST_ROW; x += NTHREADS * 16) *(LAS u32x4*)(lds + RT_OFF_ST + x) = (u32x4){0u, 0u, 0u, 0u};
        RT_LOAD_V(0); RT_WRITE_V();
#define RT_BAR() do { asm volatile("s_waitcnt lgkmcnt(0)" ::: "memory"); __builtin_amdgcn_s_barrier(); asm volatile("" ::: "memory"); } while (0)
        if (owave) {
            RT_LOAD_QS(0);
            for (int n = 0; n < 32; ++n) {
                RT_BAR();
                asm volatile("" : "+v"(offq), "+v"(offs), "+v"(offv), "+v"(offo), "+v"(offsq));
                if (n < 31) RT_LOAD_V(n + 1);
                f32x16 oc, oi;
#pragma unroll
                for (int r = 0; r < 16; ++r) { oc[r] = 0.f; oi[r] = 0.f; }
                const LAS unsigned char* sp = lds + RT_OFF_ST + r32 * RT_ST_ROW + 16 * hi;
#pragma unroll
                for (int ks = 0; ks < 16; ++ks) oc = MFMA32(*(const LAS bf16x8*)(sp + 32 * ks), qreg[ks], oc);
#pragma unroll
                for (int ks = 0; ks < 8; ++ks) if (ks < 2 * uw + 2) {
                    const LAS unsigned char* vp = lds + RT_OFF_V + 16 * ks * RT_V_ROW + trv;
                    const s16x4 a0 = tr16(vp), a1 = tr16(vp + 4 * RT_V_ROW);
                    const bf16x8 vf = __builtin_shufflevector(a0, a1, 0, 1, 2, 3, 4, 5, 6, 7);
                    oi = MFMA32(vf, sreg[ks], oi);
                }
                if (n < 31) RT_LOAD_QS(n + 1);
                float s = 0.f;
                char* const op = vbase + (size_t)(128 * n) * 4096 + offo;
#pragma unroll
                for (int g = 0; g < 4; ++g) {
                    float v[4];
#pragma unroll
                    for (int e = 0; e < 4; ++e) { v[e] = oi[4 * g + e] + qd * oc[4 * g + e]; s += v[e] * v[e]; }
                    u32x2 w; w.x = cvt_pk_bf16(v[0], v[1]); w.y = cvt_pk_bf16(v[2], v[3]);
                    *(u32x2*)(op + 16 * g) = w;
                }
                s += __shfl_xor(s, 32);
                if (hi == 0) *(float*)(sqbase + (size_t)(128 * n) * 256 + offsq) = s;
                RT_BAR();
                if (n < 31) RT_WRITE_V();
            }
        } else {
            RT_LOAD_K(0, 0); RT_LOAD_K(0, 1);
            for (int n = 0; n < 32; ++n) {
                RT_BAR();
                asm volatile("" : "+v"(offk), "+v"(offv));
                if (n < 31) RT_LOAD_V(n + 1);
#pragma unroll
                for (int r = 0; r < 16; ++r) { st0[r] *= cdec; st1[r] *= cdec; }
#pragma unroll
                for (int half = 0; half < 2; ++half) {
#pragma unroll
                    for (int c8 = 0; c8 < 8; ++c8) *(LAS u32x4*)(slab + (krj + 8 * c8) * RT_K_ROW + kch * 16) = kreg[8 * half + c8];
                    if (n < 31) { if (half == 0) RT_LOAD_K(n + 1, 0); else RT_LOAD_K(n + 1, 1); }
#pragma unroll
                    for (int ks = 0; ks < 4; ++ks) {
                        const LAS unsigned char* kp = slab + 16 * ks * RT_K_ROW + trk;
                        const LAS unsigned char* vp = lds + RT_OFF_VD + (64 * half + 16 * ks) * RT_V_ROW + trv;
                        const s16x4 v0 = tr16(vp), v1 = tr16(vp + 4 * RT_V_ROW);
                        const s16x4 k0 = tr16(kp), k1 = tr16(kp + 4 * RT_K_ROW), k2 = tr16(kp + 64), k3 = tr16(kp + 64 + 4 * RT_K_ROW);
                        const bf16x8 vf = __builtin_shufflevector(v0, v1, 0, 1, 2, 3, 4, 5, 6, 7);
                        const bf16x8 kf0 = __builtin_shufflevector(k0, k1, 0, 1, 2, 3, 4, 5, 6, 7), kf1 = __builtin_shufflevector(k2, k3, 0, 1, 2, 3, 4, 5, 6, 7);
                        st0 = MFMA32(kf0, vf, st0); st1 = MFMA32(kf1, vf, st1);
                    }
                }
                RT_BAR();
                { LAS unsigned char* wp = lds + RT_OFF_ST + r32 * RT_ST_ROW + (64 * uw + 4 * hi) * 2;
#pragma unroll
                  for (int g = 0; g < 4; ++g) {
                    u32x2 w0, w1; w0.x = cvt_pk_bf16(st0[4 * g], st0[4 * g + 1]); w0.y = cvt_pk_bf16(st0[4 * g + 2], st0[4 * g + 3]);
                    w1.x = cvt_pk_bf16(st1[4 * g], st1[4 * g + 1]); w1.y = cvt_pk_bf16(st1[4 * g + 2], st1[4 * g + 3]);
                    *(LAS u32x2*)(wp + 16 * g) = w0; *(LAS u32x2*)(wp + 64 + 16 * g) = w1;
                  } }
                if (n < 31) RT_WRITE_V();
            }
        }
#undef RT_BAR
#undef RT_LOAD_K
#undef RT_LOAD_QS
#undef RT_LOAD_V
#undef RT_WRITE_V
    }
}

#define XB_TMO      128
#define XB_XCNT(j)  (256  + 64 * (j))
#define XB_XSUB(j)  (1280 + 64 * (j))
#define XB_XGEN(j)  (2304 + 64 * (j))
#define XB_TOP      3328
#define XB_TOPGEN   3392
#define XCD_BAR_WORDS 3456
#define XB_SPIN_CAP (1u << 18)

__device__ __forceinline__ unsigned xb_ld(unsigned* p)              { return __hip_atomic_load(p, __ATOMIC_RELAXED, __HIP_MEMORY_SCOPE_AGENT); }
__device__ __forceinline__ unsigned xb_add(unsigned* p, unsigned v) { return __hip_atomic_fetch_add(p, v, __ATOMIC_RELAXED, __HIP_MEMORY_SCOPE_AGENT); }
__device__ __forceinline__ unsigned xb_xcc_id() { return (unsigned)__builtin_amdgcn_s_getreg((3 << 11) | 20) & 0xFu; }
#define XB_SPIN(cond, bar) do { unsigned _sp = 0; while (cond) { __builtin_amdgcn_s_sleep(1); \
    if ((++_sp & 255u) == 0u) { if (xb_ld(&(bar)[XB_TMO])) break; if (_sp > XB_SPIN_CAP) { atomicAdd(&(bar)[XB_TMO], 1u); break; } } } } while (0)

struct XcdBarrier {
    unsigned* bar; unsigned x;
    volatile LAS unsigned* st;
};

__device__ __forceinline__ XcdBarrier xcd_barrier_post(unsigned* bar, volatile LAS unsigned* st) {
    XcdBarrier b; b.bar = bar; b.x = xb_xcc_id(); b.st = st;
    if (threadIdx.x == 0) (void)xb_add(&bar[XB_XCNT(b.x)], 1u);
    return b;
}
__device__ __forceinline__ void xcd_barrier_complete(unsigned* bar, unsigned x, unsigned& nloc, unsigned& nx) {
    const unsigned G = gridDim.x * gridDim.y * gridDim.z;
    unsigned sum, cnt, mine, sp = 0u;
    for (;;) {
        sum = 0u; cnt = 0u; mine = 0u;
#pragma unroll
        for (unsigned j = 0; j < 16; ++j) { const unsigned c = xb_ld(&bar[XB_XCNT(j)]); sum += c; cnt += (c > 0u) ? 1u : 0u; mine = (j == x) ? c : mine; }
        if (sum == G) break;
        __builtin_amdgcn_s_sleep(1);
        if ((++sp & 255u) == 0u) { if (xb_ld(&bar[XB_TMO])) break; if (sp > XB_SPIN_CAP) { atomicAdd(&bar[XB_TMO], 1u); break; } }
    }
    nloc = mine > 0u ? mine : 1u; nx = cnt > 0u ? cnt : 1u;
}

__device__ __forceinline__ void xcd_barrier(const XcdBarrier& b) {
    asm volatile("s_waitcnt vmcnt(0)" ::: "memory");
    __syncthreads();
    if (threadIdx.x == 0) {
        unsigned* bar = b.bar;
        __builtin_amdgcn_s_waitcnt(0);
        unsigned nloc = b.st[0], nx = b.st[1];
        if (nloc == 0u) { xcd_barrier_complete(bar, b.x, nloc, nx); b.st[0] = nloc; b.st[1] = nx; }
        const unsigned old = xb_add(&bar[XB_XSUB(b.x)], 1u);
        const unsigned gen = old / nloc;
        if (old + 1u == (gen + 1u) * nloc) {
            __builtin_amdgcn_fence(__ATOMIC_RELEASE, "agent");
            asm volatile("s_waitcnt vmcnt(0)" ::: "memory");
            const unsigned og = xb_add(&bar[XB_TOP], 1u);
            const unsigned tg = og / nx;
            if (og + 1u == (tg + 1u) * nx) xb_add(&bar[XB_TOPGEN], 1u);
            else XB_SPIN(xb_ld(&bar[XB_TOPGEN]) == tg, bar);
            __builtin_amdgcn_fence(__ATOMIC_ACQUIRE, "agent");
            xb_add(&bar[XB_XGEN(b.x)], 1u);
            asm volatile("s_waitcnt vmcnt(0)" ::: "memory");
        } else {
            XB_SPIN(xb_ld(&bar[XB_XGEN(b.x)]) == gen, bar);
            __builtin_amdgcn_fence(__ATOMIC_ACQUIRE, "agent");
            asm volatile("s_waitcnt vmcnt(0)" ::: "memory");
        }
    }
    __syncthreads();
}

#define FILL_RS_TABLE(S_, kk_) do { _Pragma("unroll") for (int ui_ = 0; ui_ < 4; ++ui_) { pg8::Unit u_; kk_[ui_] = -1; \
        if (S_.next(ui_, u_)) { kk_[ui_] = u_.pm; if (tl_ < 256) rstab[ui_ * 256 + tl_] = row_rs(ssq, u_.pm * 256 + tl_); } } __syncthreads(); } while (0)
__global__ void __launch_bounds__(NTHREADS, 2) mega(Args a) {
    extern __shared__ __attribute__((aligned(16))) unsigned char lds_raw[];
    LAS unsigned char* lds = (LAS unsigned char*)lds_raw;
    cg::grid_group grid = cg::this_grid();
    const int tid = threadIdx.x, lane0 = tid & 63, wave = __builtin_amdgcn_readfirstlane(tid >> 6);
    const int G = gridDim.x, bx = blockIdx.x;
    const int gw = bx * NWAVES + wave, NGW = G * NWAVES, gthreads = G * NTHREADS;
    const int vcu = (G % 8 == 0) ? (bx % 8) * (G / 8) + bx / 8 : bx;
    unsigned char* ws = a.ws;
    float* ssq = (float*)(ws + WS_SSQ); bf16* hb = (bf16*)(ws + WS_HB);
    unsigned char* R = ws + WS_R;

    volatile LAS unsigned* xb_st = (volatile LAS unsigned*)(lds + 131072 + 64);
    LAS float* rstab = (LAS float*)(lds + 131072 + 256);
    if (tid < 2) xb_st[tid] = 0u;
    unsigned* barw = (unsigned*)(ws + WS_BAR);
    __syncthreads();
    const XcdBarrier xbar = xcd_barrier_post(barw, xb_st);
    const bool has_slack = (G < 320) && (2 * G > 320);
    convert_layer(a, 0, has_slack ? 1 : 15, lds, gw, NGW, wave, lane0);
    for (int m = gw; m < M; m += 2 * NGW) {
        const int lane = lane0; const int m1 = m + NGW; const bool two = m1 < M;
        const f32x4* xr0 = (const f32x4*)(a.in[0] + (size_t)m * D) + lane; const f32x4* xr1 = (const f32x4*)(a.in[0] + (size_t)(two ? m1 : m) * D) + lane;
        f32x4 v0[4], v1[4];
#pragma unroll
        for (int j = 0; j < 4; ++j) { v0[j] = __builtin_nontemporal_load(xr0 + 64 * j); v1[j] = __builtin_nontemporal_load(xr1 + 64 * j); }
        float s0 = 0.f, s1 = 0.f;
        unsigned long long* o0 = (unsigned long long*)(hb + (size_t)m * D) + lane; unsigned long long* o1 = (unsigned long long*)(hb + (size_t)m1 * D) + lane;
#pragma unroll
        for (int j = 0; j < 4; ++j) {
            s0 += (v0[j][0] * v0[j][0] + v0[j][1] * v0[j][1]) + (v0[j][2] * v0[j][2] + v0[j][3] * v0[j][3]);
            s1 += (v1[j][0] * v1[j][0] + v1[j][1] * v1[j][1]) + (v1[j][2] * v1[j][2] + v1[j][3] * v1[j][3]);
            o0[64 * j] = (unsigned long long)cvt_pk_bf16(v0[j][0], v0[j][1]) | ((unsigned long long)cvt_pk_bf16(v0[j][2], v0[j][3]) << 32);
            if (two) o1[64 * j] = (unsigned long long)cvt_pk_bf16(v1[j][0], v1[j][1]) | ((unsigned long long)cvt_pk_bf16(v1[j][2], v1[j][3]) << 32);
        }
        s0 = wave_sum(s0); s1 = wave_sum(s1);
        if (lane < 16) { ssq[(size_t)m * 16 + lane] = (lane == 0) ? s0 : 0.f; if (two) ssq[(size_t)m1 * 16 + lane] = (lane == 0) ? s1 : 0.f; }
    }
    if (a.ws == nullptr) grid.sync();
    xcd_barrier(xbar);

    for (int i = 0; i < DEPTH; ++i) {
        const int kind = i % 3, j = i / 3;
        unsigned char* wb = ws + ((i & 1) ? WS_WB1 : WS_WB0);
        int tl_ = threadIdx.x; asm volatile("" : "+v"(tl_));
        const int lane = tl_ & 63, gtid = bx * NTHREADS + tl_;
        {
            const int n_in = kind == 0 ? 1280 : (kind == 1 ? 3072 : 4096);
            pg8::Gemm g{hb, (const bf16*)(wb + WB_IN), M, n_in, D}; pg8::StaticOrder S; S.init(M, n_in, G, bx);
            int kk[4]; FILL_RS_TABLE(S, kk);
            EpiRowScale<0> E{(bf16*)R, kind == 2 ? 2048 : n_in, ssq, kind == 2 ? 2048 : 0, (size_t)(R_V / 2), rstab, kk[0], kk[1], kk[2], kk[3]};
            pg8::gemm_phase<EpiRowScale<0>, pg8::StaticOrder, true, true>(lds, g, S, E);
            if (kind == 0 && has_slack) {
                const int first = S.nwg - G;
                if (bx >= first) { convert_layer(a, i, 14, lds, (bx - first) * NWAVES + wave, (G - first) * NWAVES, wave, lane);
                    if (i + 1 < DEPTH) convert_layer(a, i + 1, 15, lds, (bx - first) * NWAVES + wave, (G - first) * NWAVES, wave, lane); }
            }
        }
        xcd_barrier(xbar);
        if (i + 1 < DEPTH && !(kind == 0 && has_slack)) { convert_layer(a, i + 1, (has_slack && (i + 1) % 3 == 0) ? 1 : 15, lds, gw, NGW, wave, lane); __syncthreads(); }
        if (kind == 0) swa_phase((const bf16*)R, a.in[5] + j * 16, (bf16*)(R + R_O), lds, vcu, G, tl_);
        else if (kind == 1) sb_phase((const bf16*)R, (bf16*)(R + R_O), lds, vcu, G, tl_);
        else {
            ret_scores((bf16*)R, (bf16*)(ws + WS_SC), vcu, G, tl_);
            xcd_barrier(xbar);
            ret_scan((const bf16*)R, (bf16*)(R + R_V), (const bf16*)(ws + WS_SC), (float*)(ws + WS_SSQO), lds, vcu, G, tl_);
            xcd_barrier(xbar);
            pg8::Gemm g{hb, (const bf16*)(wb + WB_IN) + (size_t)4096 * D, M, 2048, D}; pg8::StaticOrder S; S.init(M, 2048, G, bx);
            EpiGate E{(bf16*)R, (const bf16*)(R + R_V), ssq, (const float*)(ws + WS_SSQO)};
            pg8::gemm_phase<EpiGate, pg8::StaticOrder, true, true>(lds, g, S, E);
        }
        xcd_barrier(xbar);
        {
            const int k_o = kind == 2 ? 2048 : 1024;
            pg8::Gemm g{kind == 2 ? (const bf16*)R : (const bf16*)(R + R_O), (const bf16*)(wb + WB_O), M, D, k_o}; pg8::StaticOrder S; S.init(M, D, G, bx);
            EpiRes<false> E{nullptr, hb, ssq}; pg8::gemm_phase<EpiRes<false>, pg8::StaticOrder, true, true>(lds, g, S, E);
        }
        xcd_barrier(xbar);
        {
            pg8::Gemm g{hb, (const bf16*)(wb + WB_UP), M, FF, D}; pg8::StaticOrder S; S.init(M, FF, G, bx);
            int kk[4]; FILL_RS_TABLE(S, kk);
            EpiRowScale<1> E{(bf16*)R, FF, ssq, 0, 0, rstab, kk[0], kk[1], kk[2], kk[3]};
            pg8::gemm_phase<EpiRowScale<1>, pg8::StaticOrder, true, true>(lds, g, S, E);
        }
        xcd_barrier(xbar);
        {
            pg8::Gemm g{(const bf16*)R, (const bf16*)(wb + WB_DOWN), M, D, FF}; pg8::StaticOrder S; S.init(M, D, G, bx);
            EpiRes<false> E{nullptr, hb, ssq};
            pg8::gemm_phase<EpiRes<false>, pg8::StaticOrder, true, true>(lds, g, S, E);
        }
        xcd_barrier(xbar);
    }
    for (int m = gw; m < M; m += NGW) {
        const float rs = row_rs(ssq, m); const int lane = lane0;
        const u32x4* hr = (const u32x4*)(hb + (size_t)m * D) + lane; const f32x4* gr = (const f32x4*)a.in[3] + 2 * lane; f32x4* orow = (f32x4*)(a.out + (size_t)m * D) + 2 * lane;
#pragma unroll
        for (int jj = 0; jj < 2; ++jj) { const u32x4 hv = hr[64 * jj]; const f32x4 g0 = gr[128 * jj], g1 = gr[128 * jj + 1];
            const f32x4 v0 = (f32x4){bflo(hv.x), bfhi(hv.x), bflo(hv.y), bfhi(hv.y)}, v1 = (f32x4){bflo(hv.z), bfhi(hv.z), bflo(hv.w), bfhi(hv.w)};
            __builtin_nontemporal_store(v0 * rs * g0, orow + 128 * jj); __builtin_nontemporal_store(v1 * rs * g1, orow + 128 * jj + 1); }
    }
}

extern "C" void kernel_launch(void* const* d_in, const int* in_sizes, int n_in, void* d_out, int out_size, void* d_ws, size_t ws_size, hipStream_t stream) {
    static int grid = 0;
    if (grid == 0) {
        if (n_in != 13 || out_size != M * D || ws_size < WS_END) { fprintf(stderr, "kernel_launch: unexpected shapes (n_in %d out %d ws %zu)\n", n_in, out_size, ws_size); grid = -1; return; }
        int dev = 0, cus = 0, per_cu = 0;
        hipGetDevice(&dev); hipDeviceGetAttribute(&cus, hipDeviceAttributeMultiprocessorCount, dev);
        hipFuncSetAttribute((const void*)mega, hipFuncAttributeMaxDynamicSharedMemorySize, LDS_BYTES);
        if (hipOccupancyMaxActiveBlocksPerMultiprocessor(&per_cu, (const void*)mega, NTHREADS, LDS_BYTES) != hipSuccess || per_cu < 1) { fprintf(stderr, "kernel_launch: occupancy query gave %d\n", per_cu); per_cu = 1; }
        (void)hipGetLastError();
        grid = cus * per_cu;
        fprintf(stderr, "kernel_launch: grid %d (cus %d x %d)\n", grid, cus, per_cu);
    }
    if (grid < 0) return;
    Args a{};
    for (int i = 0; i < 13; ++i) a.in[i] = (const float*)d_in[i];
    a.out = (float*)d_out; a.ws = (unsigned char*)d_ws;
    if (hipMemsetAsync((char*)d_ws + WS_BAR, 0, XCD_BAR_WORDS * 4, stream) != hipSuccess) { fprintf(stderr, "kernel_launch: memset of the barrier words failed\n"); return; }
    void* args[] = {&a};
    hipError_t e = hipLaunchCooperativeKernel((const void*)mega, dim3(grid), dim3(NTHREADS), args, LDS_BYTES, stream);
    if (e != hipSuccess) fprintf(stderr, "cooperative launch failed: %s (grid %d)\n", hipGetErrorString(e), grid);
}
```

```cpp
#include <hip/hip_runtime.h>
#include <hip/hip_cooperative_groups.h>
#include <cstdio>
#include <cstdint>
namespace cg = cooperative_groups;
namespace pg8 {
#define PG8_LAS __attribute__((address_space(3)))
typedef unsigned short bf16_t;
typedef short bf16x8 __attribute__((ext_vector_type(8)));
typedef float f32x4 __attribute__((ext_vector_type(4)));
typedef unsigned u32x4 __attribute__((ext_vector_type(4)));
constexpr int BM = 256, BK = 64, HALF = 128, HTB = HALF * BK * 2  , STAGE_BYTES = 8 * HTB, NXCD = 8, WGM = 8;

__host__ __device__ __forceinline__ int lds_byte(int r, int c) { const int st = (r >> 4) * 2 + (c >> 5), rr = r & 15, cc = c & 31, ob = rr * 64 + cc * 2; return st * 1024 + (ob ^ (((ob >> 9) & 1) << 5)); }
__host__ __device__ __forceinline__ void stage_rc(int b, int& R, int& C) { const int st = b / 1024, sb = b % 1024, swz = sb ^ (((sb >> 9) & 1) << 5); R = (st >> 1) * 16 + swz / 64; C = (st & 1) * 32 + (swz % 64) / 2; }
__host__ __device__ __forceinline__ int perm32(int rho) { const int n = rho >> 4, i = rho & 15; return 8 * (i >> 2) + 4 * n + (i & 3); }

struct Unit { int pm, pn; };
struct Gemm { const bf16_t* A; const bf16_t* Bt; int M, N, K; };

struct StaticOrder {
    int nM, nN, nwg, G, c;
    __host__ __device__ void init(int M, int N, int G_, int c_) { nM = M / BM; nN = N / BM; nwg = nM * nN; G = G_; c = c_; }
    __host__ __device__ bool next(int i, Unit& u) const {
        const long L = (long)i * G + c; if (L >= nwg) return false;
        int wgid = (int)L; { const int q = nwg / NXCD, r = nwg % NXCD, xcd = wgid % NXCD, off = wgid / NXCD; wgid = (xcd < r ? xcd * (q + 1) : r * (q + 1) + (xcd - r) * q) + off; }
        const int nig = WGM * nN, gid = wgid / nig, fm = gid * WGM, gsz = (nM - fm) < WGM ? (nM - fm) : WGM;
        u.pm = fm + ((wgid % nig) % gsz); u.pn = (wgid % nig) / gsz; return true;
    }
    __device__ __forceinline__ void a_ready(const Unit&) const {}
    __device__ __forceinline__ void done(const Unit&) const {}
};

__device__ __forceinline__ unsigned cvt_pk_bf16(float lo, float hi) { unsigned r; asm volatile("v_cvt_pk_bf16_f32 %0, %1, %2" : "=v"(r) : "v"(lo), "v"(hi)); return r; }
typedef float f32x2 __attribute__((ext_vector_type(2)));
__device__ __forceinline__ f32x2 gelu_pk(f32x2 v) {
    const f32x2 av = __builtin_elementwise_abs(v), d = av * 0.2316418882f + 1.0f;
    f32x2 t; t.x = __builtin_amdgcn_rcpf(d.x); t.y = __builtin_amdgcn_rcpf(d.y);
    f32x2 q = t * 0.5307027145f + (-0.7265760135f); q = q * t + 0.7107068705f; q = q * t + (-0.142248368f); q = q * t + 0.127414796f; q = q * t;
    const f32x2 s = (v * v) * (-0.72134752044f);
    f32x2 e; e.x = __builtin_amdgcn_exp2f(s.x); e.y = __builtin_amdgcn_exp2f(s.y);
    const f32x2 m = v * (q * e), r = v - m;
    f32x2 o; o.x = v.x < 0.f ? m.x : r.x; o.y = v.y < 0.f ? m.y : r.y; return o;
}

template <int ACT  > struct EpiBf16 {
    static constexpr bool PERM = true, AFTER_DRAIN = false; static_assert(ACT == 0 || ACT == 1, "EpiBf16: ACT is 0 (none) or 1 (gelu_pk)");
    bf16_t* O; int ldc; const float* bias; int split_cols; size_t split_stride; float scale0;
    __device__ __forceinline__ void operator()(const f32x4 (&acc)[2][2][4][2], const Unit& u, int wr, int wc, int fr, int fq) const {
        const int row0 = u.pm * BM + wr * 64 + fr; int colt = u.pn * BM; bf16_t* base = O;
        float sc = 1.f; if (split_cols) { const int t = colt / split_cols; base += (size_t)t * split_stride; colt -= t * split_cols; if (t == 0) sc = scale0; }
        const int col0 = colt + wc * 32 + 8 * fq, bcol0 = u.pn * BM + wc * 32 + 8 * fq;
        f32x4 bv[2][2];
#pragma unroll
        for (int bj = 0; bj < 2; ++bj)
#pragma unroll
            for (int n = 0; n < 2; ++n) bv[bj][n] = bias ? *(const f32x4*)(bias + bcol0 + bj * HALF + 4 * n) : (f32x4){0.f, 0.f, 0.f, 0.f};
#pragma unroll
        for (int ai = 0; ai < 2; ++ai)
#pragma unroll
            for (int m = 0; m < 4; ++m) { bf16_t* rowp = base + (size_t)(row0 + ai * HALF + m * 16) * ldc + col0;
#pragma unroll
                for (int bj = 0; bj < 2; ++bj) { f32x4 v0 = acc[ai][bj][m][0] + bv[bj][0], v1 = acc[ai][bj][m][1] + bv[bj][1];
                    if (ACT == 1) { f32x2 a = gelu_pk((f32x2){v0[0], v0[1]}), b = gelu_pk((f32x2){v0[2], v0[3]}), c = gelu_pk((f32x2){v1[0], v1[1]}), d = gelu_pk((f32x2){v1[2], v1[3]});
                        v0 = (f32x4){a.x, a.y, b.x, b.y}; v1 = (f32x4){c.x, c.y, d.x, d.y}; }
                    v0 = v0 * sc; v1 = v1 * sc; u32x4 w; w.x = cvt_pk_bf16(v0[0], v0[1]); w.y = cvt_pk_bf16(v0[2], v0[3]); w.z = cvt_pk_bf16(v1[0], v1[1]); w.w = cvt_pk_bf16(v1[2], v1[3]);
                    *(u32x4*)(rowp + bj * HALF) = w; } }
    }
};

template <class Epi, class Sched, bool ALIGN_EPI = false, bool SP2 = false>
__device__ __forceinline__ void gemm_phase(PG8_LAS unsigned char* lds, const Gemm g, const Sched& S, const Epi& E) {
    int tid_ = threadIdx.x; asm volatile("" : "+v"(tid_));
    const int tid = tid_, wid = __builtin_amdgcn_readfirstlane(tid >> 6), lane = tid & 63, wr = wid >> 2, wc = wid & 3, fr = lane & 15, fq = lane >> 4;
    const int K = g.K, nt = K / BK;
    unsigned voffA[2], voffB[2];
#pragma unroll
    for (int i = 0; i < 2; ++i) { int R, C; stage_rc(tid * 16 + i * 8192, R, C); const int Rb = Epi::PERM ? ((R & ~31) + perm32(R & 31)) : R;
        voffA[i] = (unsigned)(R * K + C) * 2u; voffB[i] = (unsigned)(Rb * K + C) * 2u; }
    const size_t kstep = (size_t)(BK * 2);
    const size_t hstep = (size_t)HALF * K * 2;
    const size_t tstep = 2 * hstep;
    const unsigned ldsw = (unsigned)wid * 1024u;
    const int aoff = lds_byte(wr * 64 + fr, fq * 8), boff = lds_byte(wc * 32 + fr, fq * 8);
#define PG8_SA(b, h) (((b) * 2 + (h)) * HTB)
#define PG8_SB(b, h) ((4 + (b) * 2 + (h)) * HTB)
#define PG8_STAGE(bufoff, gbase, voff) do { _Pragma("unroll") for (int _i = 0; _i < 2; ++_i) \
        __builtin_amdgcn_global_load_lds((const unsigned*)((const char*)(gbase) + (voff)[_i]), (PG8_LAS unsigned*)(lds + (bufoff) + ldsw + _i * 8192), 16, 0, 0); } while (0)
#define PG8_LDA(dst, b, h) do { _Pragma("unroll") for (int m = 0; m < 4; ++m) _Pragma("unroll") for (int k = 0; k < 2; ++k) dst[m][k] = *(const PG8_LAS bf16x8*)(lds + PG8_SA(b, h) + aoff + m * 2048 + k * 1024); } while (0)
#define PG8_LDB(dst, b, h) do { _Pragma("unroll") for (int n = 0; n < 2; ++n) _Pragma("unroll") for (int k = 0; k < 2; ++k) dst[n][k] = *(const PG8_LAS bf16x8*)(lds + PG8_SB(b, h) + boff + n * 2048 + k * 1024); } while (0)
#define PG8_MMA(ai, bj, At, Bt) do { __builtin_amdgcn_s_setprio(1); _Pragma("unroll") for (int m = 0; m < 4; ++m) _Pragma("unroll") for (int n = 0; n < 2; ++n) _Pragma("unroll") for (int k = 0; k < 2; ++k) \
        acc[ai][bj][m][n] = __builtin_amdgcn_mfma_f32_16x16x32_bf16(Bt[n][k], At[m][k], acc[ai][bj][m][n], 0, 0, 0); __builtin_amdgcn_s_setprio(0); } while (0)
#define PG8_WAIT_V(n) asm volatile("s_waitcnt vmcnt(" #n ")" ::: "memory")
#define PG8_WAIT_L(n) asm volatile("s_waitcnt lgkmcnt(" #n ")" ::: "memory")
#define PG8_BAR __builtin_amdgcn_s_barrier()
#define PG8_SCHED __builtin_amdgcn_sched_barrier(0)
    Unit cur, nxt; int ui = 0;
    if (!S.next(0, cur)) return;
    f32x4 acc[2][2][4][2];
#pragma unroll
    for (int a = 0; a < 2; ++a)
#pragma unroll
        for (int b = 0; b < 2; ++b)
#pragma unroll
            for (int m = 0; m < 4; ++m)
#pragma unroll
                for (int n = 0; n < 2; ++n) acc[a][b][m][n] = (f32x4){0.f, 0.f, 0.f, 0.f};
    bf16x8 At[4][2], B0[2][2], B1[2][2];
    const char* cA = (const char*)g.A + (size_t)cur.pm * tstep; const char* cB = (const char*)g.Bt + (size_t)cur.pn * tstep;
    S.a_ready(cur);
    if constexpr (SP2) {
        PG8_STAGE(PG8_SB(0, 0), cB, voffB); PG8_STAGE(PG8_SB(0, 1), cB + hstep, voffB); PG8_STAGE(PG8_SA(0, 0), cA, voffA); PG8_STAGE(PG8_SA(0, 1), cA + hstep, voffA);
        if (wr == 1) PG8_BAR;
        PG8_WAIT_V(2); PG8_BAR;
        PG8_STAGE(PG8_SB(1, 0), cB + kstep, voffB); PG8_STAGE(PG8_SA(1, 0), cA + kstep, voffA); PG8_STAGE(PG8_SB(1, 1), cB + hstep + kstep, voffB);
        PG8_WAIT_V(6); PG8_BAR;
    } else {
        PG8_STAGE(PG8_SB(0, 0), cB, voffB); PG8_STAGE(PG8_SA(0, 0), cA, voffA); PG8_STAGE(PG8_SB(0, 1), cB + hstep, voffB); PG8_STAGE(PG8_SA(0, 1), cA + hstep, voffA);
        if (wr == 1) PG8_BAR;
        PG8_WAIT_V(4); PG8_BAR;
        PG8_STAGE(PG8_SB(1, 0), cB + kstep, voffB); PG8_STAGE(PG8_SA(1, 0), cA + kstep, voffA); PG8_STAGE(PG8_SB(1, 1), cB + hstep + kstep, voffB);
        PG8_WAIT_V(6); PG8_BAR;
    }
    for (;;) {
        const bool has_next = S.next(ui + 1, nxt);
        const char* nA = has_next ? (const char*)g.A + (size_t)nxt.pm * tstep : cA; const char* nB = has_next ? (const char*)g.Bt + (size_t)nxt.pn * tstep : cB;
        for (int t = 0; t < nt; t += 2) {
            const bool last = (t == nt - 2);
            const char* a1 = cA + (size_t)(t + 1) * kstep;
            const char* a2 = last ? nA : cA + (size_t)(t + 2) * kstep; const char* b2 = last ? nB : cB + (size_t)(t + 2) * kstep;
            const char* a3 = a2 + kstep; const char* b3 = b2 + kstep;
            if (last && has_next) S.a_ready(nxt);
            if constexpr (SP2) {
            PG8_LDB(B0, 0, 0); PG8_LDB(B1, 0, 1); PG8_SCHED; PG8_LDA(At, 0, 0); PG8_STAGE(PG8_SA(1, 1), a1 + hstep, voffA);
            PG8_WAIT_V(8); PG8_WAIT_L(0); PG8_BAR; PG8_MMA(0, 0, At, B0); PG8_MMA(0, 1, At, B1); PG8_BAR; PG8_SCHED;
            PG8_LDA(At, 0, 1); PG8_STAGE(PG8_SB(0, 0), b2, voffB); PG8_STAGE(PG8_SB(0, 1), b2 + hstep, voffB); PG8_STAGE(PG8_SA(0, 0), a2, voffA);
            PG8_WAIT_V(8); PG8_WAIT_L(0); PG8_BAR; PG8_MMA(1, 0, At, B0); PG8_MMA(1, 1, At, B1); PG8_BAR; PG8_SCHED;
            PG8_LDB(B0, 1, 0); PG8_LDB(B1, 1, 1); PG8_SCHED; PG8_LDA(At, 1, 0); PG8_STAGE(PG8_SA(0, 1), a2 + hstep, voffA);
            PG8_WAIT_V(8); PG8_WAIT_L(0); PG8_BAR; PG8_MMA(0, 0, At, B0); PG8_MMA(0, 1, At, B1); PG8_BAR; PG8_SCHED;
            PG8_LDA(At, 1, 1); PG8_STAGE(PG8_SB(1, 0), b3, voffB); PG8_STAGE(PG8_SB(1, 1), b3 + hstep, voffB); PG8_STAGE(PG8_SA(1, 0), a3, voffA);
            PG8_WAIT_V(8); PG8_WAIT_L(0); PG8_BAR; PG8_MMA(1, 0, At, B0); PG8_MMA(1, 1, At, B1); PG8_BAR; PG8_SCHED;
            } else {
            PG8_LDB(B0, 0, 0); PG8_SCHED; PG8_LDA(At, 0, 0); PG8_STAGE(PG8_SA(1, 1), a1 + hstep, voffA);
            PG8_WAIT_L(8); PG8_BAR; PG8_WAIT_L(0); PG8_MMA(0, 0, At, B0); PG8_BAR; PG8_SCHED;
            PG8_LDB(B1, 0, 1); PG8_STAGE(PG8_SB(0, 0), b2, voffB);
            PG8_BAR; PG8_WAIT_L(0); PG8_MMA(0, 1, At, B1); PG8_BAR;
            PG8_LDA(At, 0, 1); PG8_STAGE(PG8_SA(0, 0), a2, voffA);
            PG8_BAR; PG8_WAIT_L(0); PG8_MMA(1, 0, At, B0); PG8_BAR; PG8_SCHED;
            PG8_STAGE(PG8_SB(0, 1), b2 + hstep, voffB);
            PG8_WAIT_V(6); PG8_BAR; PG8_MMA(1, 1, At, B1); PG8_BAR;
            PG8_LDB(B0, 1, 0); PG8_SCHED; PG8_LDA(At, 1, 0); PG8_STAGE(PG8_SA(0, 1), a2 + hstep, voffA);
            PG8_WAIT_L(8); PG8_BAR; PG8_WAIT_L(0); PG8_MMA(0, 0, At, B0); PG8_BAR; PG8_SCHED;
            PG8_LDB(B1, 1, 1); PG8_STAGE(PG8_SB(1, 0), b3, voffB);
            PG8_BAR; PG8_WAIT_L(0); PG8_MMA(0, 1, At, B1); PG8_BAR;
            PG8_LDA(At, 1, 1); PG8_STAGE(PG8_SA(1, 0), a3, voffA);
            PG8_BAR; PG8_WAIT_L(0); PG8_MMA(1, 0, At, B0); PG8_BAR; PG8_SCHED;
            PG8_STAGE(PG8_SB(1, 1), b3 + hstep, voffB);
            PG8_WAIT_V(6); PG8_BAR; PG8_MMA(1, 1, At, B1); PG8_BAR;
            }
        }
        if constexpr (ALIGN_EPI) { if (wr == 0) PG8_BAR; }
        if constexpr (!Epi::AFTER_DRAIN) { E(acc, cur, wr, wc, fr, fq); S.done(cur); }
        if (!has_next) break;
#pragma unroll
        for (int a = 0; a < 2; ++a)
#pragma unroll
            for (int b = 0; b < 2; ++b)
#pragma unroll
                for (int m = 0; m < 4; ++m)
#pragma unroll
                    for (int n = 0; n < 2; ++n) acc[a][b][m][n] = (f32x4){0.f, 0.f, 0.f, 0.f};
        cur = nxt; cA = nA; cB = nB; ++ui;
        if constexpr (ALIGN_EPI) { if (wr == 1) PG8_BAR; }
    }
    PG8_WAIT_V(0);
    if constexpr (!ALIGN_EPI) { if (wr == 0) PG8_BAR; }
    PG8_BAR;
    if constexpr (Epi::AFTER_DRAIN) { E.fused(acc, cur, wr, wc, fr, fq, lds, wid, lane); S.done(cur); }
#undef PG8_SA
#undef PG8_SB
#undef PG8_STAGE
#undef PG8_LDA
#undef PG8_LDB
#undef PG8_MMA
#undef PG8_WAIT_V
#undef PG8_WAIT_L
#undef PG8_BAR
#undef PG8_SCHED
}
}

#define LAS __attribute__((address_space(3)))
typedef unsigned short bf16;
typedef pg8::f32x4 f32x4;
typedef pg8::u32x4 u32x4;
typedef unsigned u32x2 __attribute__((ext_vector_type(2)));
typedef float f32x2_t __attribute__((ext_vector_type(2))); typedef __bf16 bf16x2_t __attribute__((ext_vector_type(2)));
__device__ __forceinline__ unsigned cvt_pk_bf16(float lo, float hi) { f32x2_t v = {lo, hi}; bf16x2_t r = __builtin_convertvector(v, bf16x2_t); return __builtin_bit_cast(unsigned, r); }
constexpr int D = 1024, BATCH = 4, SEQ = 4096, M = BATCH * SEQ, FF = 4096, DEPTH = 4;
constexpr int NWAVES = 8, NTHREADS = 512;
constexpr float RMS_EPS = 1e-6f;
constexpr size_t MiB = 1u << 20;
constexpr size_t WS_SSQ = 0;
constexpr size_t WS_BAR = 1 * MiB;
constexpr size_t WS_HB = 2 * MiB;
constexpr size_t WS_WB0 = 34 * MiB, WS_WB1 = 66 * MiB;
constexpr size_t WS_R = 98 * MiB;
constexpr size_t WS_SC = 226 * MiB;
constexpr size_t WS_SSQO = 242 * MiB;
constexpr size_t WS_END = 246 * MiB;
constexpr size_t WB_IN = 0, WB_O = 12 * MiB, WB_UP = 16 * MiB, WB_DOWN = 24 * MiB;
constexpr size_t R_O = 96 * MiB;
constexpr size_t R_V = 64 * MiB;
constexpr int LDS_BYTES = 147456;

__device__ __forceinline__ float bflo(unsigned u) { return __uint_as_float(u << 16); }
__device__ __forceinline__ float bfhi(unsigned u) { return __uint_as_float(u & 0xffff0000u); }
__device__ __forceinline__ float wave_sum(float v) {
#pragma unroll
    for (int o = 1; o < 64; o <<= 1) v += __shfl_xor(v, o);
    return v;
}
__device__ __forceinline__ float row_rs(const float* ssq, int row) {
    const f32x4* p = (const f32x4*)(ssq + (size_t)row * 16);
    const f32x4 a = p[0], b = p[1], c = p[2], d = p[3];
    const float s = (((a[0] + a[1]) + (a[2] + a[3])) + ((b[0] + b[1]) + (b[2] + b[3]))) + (((c[0] + c[1]) + (c[2] + c[3])) + ((d[0] + d[1]) + (d[2] + d[3])));
    return rsqrtf(s * (1.f / 1024.f) + RMS_EPS);
}

template <int ACT> struct EpiRowScale {
    static constexpr bool PERM = true, AFTER_DRAIN = false;
    bf16* O; int ldc; const float* ssq; int split_cols; size_t split_stride;
    const LAS float* tab; int k0, k1, k2, k3;
    __device__ __forceinline__ void operator()(const f32x4 (&acc)[2][2][4][2], const pg8::Unit& u, int wr, int wc, int fr, int fq) const {
        const int row0 = u.pm * 256 + wr * 64 + fr; int colt = u.pn * 256; bf16* base = O;
        if (split_cols) { const int t = colt / split_cols; base += (size_t)t * split_stride; colt -= t * split_cols; }
        const int col0 = colt + wc * 32 + 8 * fq;
        const int slot = (u.pm == k0) ? 0 : (u.pm == k1) ? 1 : (u.pm == k2) ? 2 : (u.pm == k3) ? 3 : -1;
#pragma unroll
        for (int ai = 0; ai < 2; ++ai)
#pragma unroll
            for (int m = 0; m < 4; ++m) {
                const int row = row0 + ai * 128 + m * 16; const float rs = slot >= 0 ? tab[slot * 256 + wr * 64 + fr + ai * 128 + m * 16] : row_rs(ssq, row);
                bf16* rowp = base + (size_t)row * ldc + col0;
#pragma unroll
                for (int bj = 0; bj < 2; ++bj) {
                    f32x4 v0 = acc[ai][bj][m][0] * rs, v1 = acc[ai][bj][m][1] * rs;
                    if (ACT == 1) {
#pragma unroll
                        for (int e = 0; e < 4; ++e) { float a = fmaxf(v0[e], 0.f), b = fmaxf(v1[e], 0.f); v0[e] = a * a; v1[e] = b * b; }
                    }
                    u32x4 w; w.x = cvt_pk_bf16(v0[0], v0[1]); w.y = cvt_pk_bf16(v0[2], v0[3]); w.z = cvt_pk_bf16(v1[0], v1[1]); w.w = cvt_pk_bf16(v1[2], v1[3]);
                    *(u32x4*)(rowp + bj * 128) = w;
                }
            }
    }
};
template <bool BASE_F32> struct EpiRes {
    static constexpr bool PERM = true, AFTER_DRAIN = false;
    const float* xbase; bf16* hb; float* ssq;
    __device__ __forceinline__ void operator()(const f32x4 (&acc)[2][2][4][2], const pg8::Unit& u, int wr, int wc, int fr, int fq) const {
        const int col0 = u.pn * 256 + wc * 32 + 8 * fq;
#pragma unroll
        for (int ai = 0; ai < 2; ++ai)
#pragma unroll
            for (int m = 0; m < 4; ++m) {
                const int row = u.pm * 256 + ai * 128 + wr * 64 + m * 16 + fr; const size_t off = (size_t)row * D + col0; float s = 0.f;
#pragma unroll
                for (int bj = 0; bj < 2; ++bj) {
                    const size_t o = off + bj * 128;
                    f32x4 v0, v1;
                    if (BASE_F32) { v0 = *(const f32x4*)(xbase + o); v1 = *(const f32x4*)(xbase + o + 4); }
                    else { const u32x4 hv = *(const u32x4*)(hb + o); v0 = (f32x4){bflo(hv.x), bfhi(hv.x), bflo(hv.y), bfhi(hv.y)}; v1 = (f32x4){bflo(hv.z), bfhi(hv.z), bflo(hv.w), bfhi(hv.w)}; }
                    v0 = v0 + acc[ai][bj][m][0]; v1 = v1 + acc[ai][bj][m][1];
                    s += ((v0[0] * v0[0] + v0[1] * v0[1]) + (v0[2] * v0[2] + v0[3] * v0[3])) + ((v1[0] * v1[0] + v1[1] * v1[1]) + (v1[2] * v1[2] + v1[3] * v1[3]));
                    u32x4 w; w.x = cvt_pk_bf16(v0[0], v0[1]); w.y = cvt_pk_bf16(v0[2], v0[3]); w.z = cvt_pk_bf16(v1[0], v1[1]); w.w = cvt_pk_bf16(v1[2], v1[3]);
                    *(u32x4*)(hb + o) = w;
                }
                s += __shfl_xor(s, 16); s += __shfl_xor(s, 32);
                if (fq == 0) ssq[(size_t)row * 16 + u.pn * 4 + wc] = s;
            }
    }
};
struct EpiGate {
    static constexpr bool PERM = true, AFTER_DRAIN = false;
    bf16* Y; const bf16* Oin; const float* ssq; const float* rmso;
    __device__ __forceinline__ void operator()(const f32x4 (&acc)[2][2][4][2], const pg8::Unit& u, int wr, int wc, int fr, int fq) const {
        const int row0 = u.pm * 256 + wr * 64 + fr; const int col0 = u.pn * 256 + wc * 32 + 8 * fq;
#pragma unroll
        for (int ai = 0; ai < 2; ++ai)
#pragma unroll
            for (int m = 0; m < 4; ++m) {
                const int row = row0 + ai * 128 + m * 16; const float rs = row_rs(ssq, row);
                float ro; { const f32x4* p = (const f32x4*)(rmso + ((size_t)row * 4 + (u.pn >> 1)) * 16); const f32x4 a = p[0], b = p[1], c = p[2], d = p[3];
                    const float s = (((a[0] + a[1]) + (a[2] + a[3])) + ((b[0] + b[1]) + (b[2] + b[3]))) + (((c[0] + c[1]) + (c[2] + c[3])) + ((d[0] + d[1]) + (d[2] + d[3]))); ro = rsqrtf(s * (1.f / 512.f) + RMS_EPS); }
#pragma unroll
                for (int bj = 0; bj < 2; ++bj) {
                    const int c = col0 + bj * 128;
                    const u32x4 ov = *(const u32x4*)(Oin + (size_t)row * 2048 + c);
                    float o8[8] = {bflo(ov.x), bfhi(ov.x), bflo(ov.y), bfhi(ov.y), bflo(ov.z), bfhi(ov.z), bflo(ov.w), bfhi(ov.w)};
                    float y8[8];
#pragma unroll
                    for (int e = 0; e < 8; ++e) { const float g = (e < 4 ? acc[ai][bj][m][0][e & 3] : acc[ai][bj][m][1][e & 3]) * rs; const float sg = g / (1.f + __expf(-g)); y8[e] = sg * o8[e] * ro; }
                    u32x4 w; w.x = cvt_pk_bf16(y8[0], y8[1]); w.y = cvt_pk_bf16(y8[2], y8[3]); w.z = cvt_pk_bf16(y8[4], y8[5]); w.w = cvt_pk_bf16(y8[6], y8[7]);
                    *(u32x4*)(Y + (size_t)row * 2048 + c) = w;
                }
            }
    }
};

struct Args { const float* in[13]; float* out; unsigned char* ws; };

struct CvItem { const float* src; bf16* dst; const float* gain; float cs; int N, K; };
__device__ __forceinline__ void cv_load(const CvItem& d, float (&r)[32]) {
#pragma unroll
    for (int i = 0; i < 32; ++i) r[i] = __builtin_nontemporal_load(d.src + (size_t)(2 * i) * d.N);
}
__device__ __forceinline__ void cv_store(const CvItem& d, const float (&r)[32], LAS float* scr, int lane) {
#pragma unroll
    for (int i = 0; i < 32; ++i) scr[(2 * i + (lane >> 5)) * 33 + (lane & 31)] = r[i] * d.cs;
    asm volatile("s_waitcnt lgkmcnt(0)" ::: "memory");
    const int c = lane & 7;
    f32x4 g0 = (f32x4){1.f, 1.f, 1.f, 1.f}, g1 = g0;
    if (d.gain) { g0 = *(const f32x4*)(d.gain + 8 * c); g1 = *(const f32x4*)(d.gain + 8 * c + 4); }
#pragma unroll
    for (int j = 0; j < 4; ++j) { const int nn = (lane >> 3) + 8 * j; const LAS float* s = scr + (8 * c) * 33 + nn;
        u32x4 o; o.x = cvt_pk_bf16(s[0 * 33] * g0[0], s[1 * 33] * g0[1]); o.y = cvt_pk_bf16(s[2 * 33] * g0[2], s[3 * 33] * g0[3]);
        o.z = cvt_pk_bf16(s[4 * 33] * g1[0], s[5 * 33] * g1[1]); o.w = cvt_pk_bf16(s[6 * 33] * g1[2], s[7 * 33] * g1[3]);
        *(u32x4*)(d.dst + (size_t)nn * d.K + 8 * c) = o; }
    asm volatile("s_waitcnt lgkmcnt(0)" ::: "memory");
}
__device__ __forceinline__ void convert_layer(const Args& a, int i, int mask, LAS unsigned char* lds, int gw, int NGW, int wave, int lane) {
    const int kind = i % 3, j = i / 3;
    const float* w_in; int n_in; const float* w_o; int k_o; int sc_lo, sc_hi; float sc;
    if (kind == 0) { w_in = a.in[4] + (size_t)j * D * 1280; n_in = 1280; w_o = a.in[6] + (size_t)j * D * D; k_o = 1024; sc_lo = 0; sc_hi = 1024; sc = 0.125f; }
    else if (kind == 1) { w_in = a.in[7] + (size_t)j * D * 3072; n_in = 3072; w_o = a.in[8] + (size_t)j * D * D; k_o = 1024; sc_lo = 0; sc_hi = 1024; sc = 0.125f * 1.4426950408889634f; }
    else { w_in = a.in[9] + (size_t)j * D * 6144; n_in = 6144; w_o = a.in[10] + (size_t)j * 2048 * D; k_o = 2048; sc_lo = 1024; sc_hi = 2048; sc = 0.0625f; }
    const float* w_up = a.in[11] + (size_t)i * D * FF; const float* w_dn = a.in[12] + (size_t)i * FF * D;
    const float* g_attn = a.in[1] + (size_t)i * D; const float* g_mlp = a.in[2] + (size_t)i * D;
    unsigned char* wb = a.ws + ((i & 1) ? WS_WB1 : WS_WB0);
    LAS float* scr = (LAS float*)(lds + wave * 16384);
    const int I_in = (mask & 1) ? (D / 64) * (n_in / 32) : 0, I_o = (mask & 2) ? (k_o / 64) * (D / 32) : 0, I_up = (mask & 4) ? (D / 64) * (FF / 32) : 0, I_dn = (mask & 8) ? (FF / 64) * (D / 32) : 0;
    const int NITEMS = I_in + I_o + I_up + I_dn;
#define CV_DECODE(dsc, itv) do { int r_ = (itv); const float* W_; int K_, N_; bf16* WT_; const float* gn_; int lo_ = 0, hi_ = 0; \
        if (r_ < I_in) { W_ = w_in; K_ = D; N_ = n_in; WT_ = (bf16*)(wb + WB_IN); gn_ = g_attn; lo_ = sc_lo; hi_ = sc_hi; } \
        else if ((r_ -= I_in) < I_o) { W_ = w_o; K_ = k_o; N_ = D; WT_ = (bf16*)(wb + WB_O); gn_ = nullptr; } \
        else if ((r_ -= I_o) < I_up) { W_ = w_up; K_ = D; N_ = FF; WT_ = (bf16*)(wb + WB_UP); gn_ = g_mlp; } \
        else { r_ -= I_up; W_ = w_dn; K_ = FF; N_ = D; WT_ = (bf16*)(wb + WB_DOWN); gn_ = nullptr; } \
        const int nblk_ = N_ / 32, kb_ = r_ / nblk_, nb_ = r_ % nblk_, k0_ = 64 * kb_, n0_ = 32 * nb_, n_ = n0_ + (lane & 31); \
        (dsc).src = W_ + (size_t)(k0_ + (lane >> 5)) * N_ + n_; (dsc).dst = WT_ + (size_t)n0_ * K_ + k0_; (dsc).gain = gn_ ? gn_ + k0_ : nullptr; \
        (dsc).cs = (n_ >= lo_ && n_ < hi_) ? sc : 1.f; (dsc).N = N_; (dsc).K = K_; } while (0)
    for (int it = gw; it < NITEMS; it += 2 * NGW) {
        CvItem d0, d1; float r0[32], r1[32];
        CV_DECODE(d0, it); cv_load(d0, r0);
        const bool two = it + NGW < NITEMS;
        if (two) { CV_DECODE(d1, it + NGW); cv_load(d1, r1); }
        cv_store(d0, r0, scr, lane);
        if (two) cv_store(d1, r1, scr, lane);
    }
#undef CV_DECODE
}

#define UNPACK8(dst, vv_) do { (dst)[0] = bflo((vv_)[0]); (dst)[1] = bfhi((vv_)[0]); (dst)[2] = bflo((vv_)[1]); (dst)[3] = bfhi((vv_)[1]); (dst)[4] = bflo((vv_)[2]); (dst)[5] = bfhi((vv_)[2]); (dst)[6] = bflo((vv_)[3]); (dst)[7] = bfhi((vv_)[3]); } while (0)
__device__ __forceinline__ void swa_naive(const bf16* qkv, const float* sinks, bf16* o, int gtid, int gthreads) {
    for (int idx = gtid; idx < M * 16; idx += gthreads) {
        const int head = idx & 15, m = idx >> 4, t = m & (SEQ - 1), kv = head >> 3;
        float q[64], acc[64];
        { const u32x4* qp = (const u32x4*)(qkv + (size_t)m * 1280 + head * 64);
#pragma unroll
          for (int c = 0; c < 8; ++c) { const u32x4 w = qp[c]; UNPACK8(q + 8 * c, w); } }
#pragma unroll
        for (int d = 0; d < 64; ++d) acc[d] = 0.f;
        const float slope = exp2f(-0.5f * (float)(head + 1));
        float mr = sinks[head], l = 1.f;
        const int s0 = t - 127 < 0 ? 0 : t - 127;
        for (int s = s0; s <= t; ++s) {
            const bf16* kp = qkv + (size_t)(m - (t - s)) * 1280 + 1024 + kv * 64; const bf16* vp = kp + 128;
            float z = 0.f;
#pragma unroll
            for (int c = 0; c < 8; ++c) { const u32x4 w = ((const u32x4*)kp)[c]; float k8[8]; UNPACK8(k8, w);
#pragma unroll
                for (int e = 0; e < 8; ++e) z += q[8 * c + e] * k8[e]; }
            z -= slope * (float)(t - s);
            const float mn = fmaxf(mr, z), corr = __expf(mr - mn), p = __expf(z - mn);
            l = l * corr + p; mr = mn;
#pragma unroll
            for (int c = 0; c < 8; ++c) { const u32x4 w = ((const u32x4*)vp)[c]; float v8[8]; UNPACK8(v8, w);
#pragma unroll
                for (int e = 0; e < 8; ++e) acc[8 * c + e] = acc[8 * c + e] * corr + p * v8[e]; }
        }
        const float inv = 1.f / l;
        u32x4* op = (u32x4*)(o + (size_t)m * 1024 + head * 64);
#pragma unroll
        for (int c = 0; c < 8; ++c) { u32x4 w; w.x = cvt_pk_bf16(acc[8 * c] * inv, acc[8 * c + 1] * inv); w.y = cvt_pk_bf16(acc[8 * c + 2] * inv, acc[8 * c + 3] * inv);
            w.z = cvt_pk_bf16(acc[8 * c + 4] * inv, acc[8 * c + 5] * inv); w.w = cvt_pk_bf16(acc[8 * c + 6] * inv, acc[8 * c + 7] * inv); op[c] = w; }
    }
}
__device__ __forceinline__ void sb_naive(const bf16* qkv, bf16* o, int gtid, int gthreads) {
    int it = 0; const bool mir = (gthreads % (SEQ * 16)) == 0;
    for (int idx = gtid; idx < M * 16; idx += gthreads, ++it) {
        const int head = idx & 15; int m = idx >> 4; int t = m & (SEQ - 1);
        if (mir && (it & 1)) { t = SEQ - 1 - t; m = (m & ~(SEQ - 1)) + t; }
        float q[64], acc[64];
        { const u32x4* qp = (const u32x4*)(qkv + (size_t)m * 3072 + head * 64);
#pragma unroll
          for (int c = 0; c < 8; ++c) { const u32x4 w = qp[c]; UNPACK8(q + 8 * c, w); } }
#pragma unroll
        for (int d = 0; d < 64; ++d) acc[d] = 0.f;
        float carry = 0.f;
        for (int s = t - 1; s >= 0; --s) {
            const bf16* kp = qkv + (size_t)(m - (t - s)) * 3072 + 1024 + head * 64; const bf16* vp = kp + 1024;
            float z = 0.f;
#pragma unroll
            for (int c = 0; c < 8; ++c) { const u32x4 w = ((const u32x4*)kp)[c]; float k8[8]; UNPACK8(k8, w);
#pragma unroll
                for (int e = 0; e < 8; ++e) z += q[8 * c + e] * k8[e]; }
            const float sp = fmaxf(z, 0.f) + __logf(1.f + __expf(-fabsf(z)));
            const float p = __expf(z - sp + carry);
            carry -= sp;
#pragma unroll
            for (int c = 0; c < 8; ++c) { const u32x4 w = ((const u32x4*)vp)[c]; float v8[8]; UNPACK8(v8, w);
#pragma unroll
                for (int e = 0; e < 8; ++e) acc[8 * c + e] += p * v8[e]; }
        }
        u32x4* op = (u32x4*)(o + (size_t)m * 1024 + head * 64);
#pragma unroll
        for (int c = 0; c < 8; ++c) { u32x4 w; w.x = cvt_pk_bf16(acc[8 * c], acc[8 * c + 1]); w.y = cvt_pk_bf16(acc[8 * c + 2], acc[8 * c + 3]);
            w.z = cvt_pk_bf16(acc[8 * c + 4], acc[8 * c + 5]); w.w = cvt_pk_bf16(acc[8 * c + 6], acc[8 * c + 7]); op[c] = w; }
    }
}
__device__ __forceinline__ void ret_naive(const bf16* qk, bf16* vo, int gtid, int gthreads) {
    for (int idx = gtid; idx < 16 * 512 * 16; idx += gthreads) {
        const int dqi = idx & 15, e = (idx >> 4) & 511, bh = idx >> 13, b = bh >> 2, h = bh & 3;
        const float gamma = 1.f - exp2f(-5.f - (float)h);
        float S[16];
#pragma unroll
        for (int j = 0; j < 16; ++j) S[j] = 0.f;
        for (int t = 0; t < SEQ; ++t) {
            const size_t row = (size_t)b * SEQ + t;
            const u32x4* qp = (const u32x4*)(qk + row * 2048 + h * 256 + dqi * 16);
            const u32x4* kp = (const u32x4*)(qk + row * 2048 + 1024 + h * 256 + dqi * 16);
            bf16* vp = vo + row * 2048 + h * 512 + e;
            const float v = __uint_as_float((unsigned)(*vp) << 16);
            float q16[16], k16[16];
            { const u32x4 w0 = qp[0], w1 = qp[1]; UNPACK8(q16, w0); UNPACK8(q16 + 8, w1); }
            { const u32x4 w0 = kp[0], w1 = kp[1]; UNPACK8(k16, w0); UNPACK8(k16 + 8, w1); }
            float part = 0.f;
#pragma unroll
            for (int j = 0; j < 16; ++j) { S[j] = gamma * S[j] + k16[j] * v; part += q16[j] * S[j]; }
            part += __shfl_xor(part, 1); part += __shfl_xor(part, 2); part += __shfl_xor(part, 4); part += __shfl_xor(part, 8);
            if (dqi == 0) *vp = (bf16)(cvt_pk_bf16(part, 0.f) & 0xffffu);
        }
    }
}

typedef short bf16x8 __attribute__((ext_vector_type(8)));
typedef short s16x4 __attribute__((ext_vector_type(4)));
typedef float f32x16 __attribute__((ext_vector_type(16)));
#define MFMA32(a, b, c) __builtin_amdgcn_mfma_f32_32x32x16_bf16((a), (b), (c), 0, 0, 0)
__device__ __forceinline__ s16x4 tr16(const LAS unsigned char* p) { return __builtin_bit_cast(s16x4, __builtin_amdgcn_ds_read_tr16_b64_v4i16((LAS s16x4*)p)); }
__device__ __forceinline__ bf16x8 pack8(const float* a) {
    u32x4 w; w.x = cvt_pk_bf16(a[0], a[1]); w.y = cvt_pk_bf16(a[2], a[3]); w.z = cvt_pk_bf16(a[4], a[5]); w.w = cvt_pk_bf16(a[6], a[7]);
    return __builtin_bit_cast(bf16x8, w);
}
constexpr int SB_ROW = 144, SB_TILE = 64 * SB_ROW;
__device__ __forceinline__ void sb_phase(const bf16* qkv, bf16* o, LAS unsigned char* lds, int vcu, int G, int tid) {
    const int lane = tid & 63, wave = __builtin_amdgcn_readfirstlane(tid >> 6), r32 = lane & 31, hi = lane >> 5;
    const int srow = tid >> 3, sch = tid & 7;
    const int i16 = lane & 15, tq = i16 >> 2, tp = i16 & 3, blk = (lane >> 4) & 1;
    const int vtr_off = (4 * hi + tq) * SB_ROW + (16 * blk + 4 * tp) * 2;
    LAS unsigned* flg = (LAS unsigned*)(lds + 4 * SB_TILE);
    for (int P = vcu; P < 512; P += G) {
        const int bh = P >> 3, jj = P & 7, b = bh >> 4, h = bh & 15;
        for (int half = 0; half < 2; ++half) {
            const int jq = half ? 15 - jj : jj;
            const size_t mb = (size_t)b * SEQ;
            const bf16* kbase = qkv + mb * 3072 + 1024 + h * 64; const bf16* vbase = kbase + 1024;
            const int tq0 = 256 * jq + 32 * wave;
            bf16x8 qf[4];
            { const bf16* qp = qkv + (mb + tq0 + r32) * 3072 + h * 64 + 8 * hi;
#pragma unroll
              for (int d0 = 0; d0 < 4; ++d0) qf[d0] = *(const bf16x8*)(qp + 16 * d0); }
            f32x16 o0, o1;
#pragma unroll
            for (int r = 0; r < 16; ++r) { o0[r] = 0.f; o1[r] = 0.f; }
            float carry = 0.f; bool mydone = false;
            const int nst = 4 * jq + 4;
            { const size_t roff = (size_t)(64 * (nst - 1) + srow) * 3072 + sch * 8;
              const u32x4 kk = *(const u32x4*)(kbase + roff), vv = *(const u32x4*)(vbase + roff);
              *(LAS u32x4*)(lds + srow * SB_ROW + sch * 16) = kk; *(LAS u32x4*)(lds + 2 * SB_TILE + srow * SB_ROW + sch * 16) = vv; }
            __syncthreads();
            for (int st = nst - 1, it = 0; st >= 0; --st, ++it) {
                const int cb = it & 1;
                const LAS unsigned char* Kb = lds + cb * SB_TILE; const LAS unsigned char* Vb = lds + 2 * SB_TILE + cb * SB_TILE;
                u32x4 kk, vv;
                if (st > 0) { const size_t roff = (size_t)(64 * (st - 1) + srow) * 3072 + sch * 8; kk = *(const u32x4*)(kbase + roff); vv = *(const u32x4*)(vbase + roff); }
                if (64 * st < tq0 + 32 && !mydone) {
                    const bool diag = (64 * st + 63 >= tq0);
#pragma unroll
                    for (int sub = 1; sub >= 0; --sub) {
                        f32x16 p;
#pragma unroll
                        for (int r = 0; r < 16; ++r) p[r] = 0.f;
                        const LAS unsigned char* kp = Kb + (32 * sub + r32) * SB_ROW + 16 * hi;
#pragma unroll
                        for (int d0 = 0; d0 < 4; ++d0) p = MFMA32(*(const LAS bf16x8*)(kp + 32 * d0), qf[d0], p);
                        float l[16]; const int sg0 = 64 * st + 32 * sub + 4 * hi, tg = tq0 + r32;
#pragma unroll
                        for (int r = 0; r < 16; ++r) {
                            const float z = p[r]; const float e = __builtin_amdgcn_exp2f(z); float lg = __builtin_amdgcn_logf(1.f + e); lg = z > 32.f ? z : lg;
                            const bool valid = !diag || (sg0 + (r & 3) + 8 * (r >> 2) < tg);
                            l[r] = valid ? -lg : 0.f;
                        }
                        float gs[4], ot[4], ps[4];
#pragma unroll
                        for (int g = 0; g < 4; ++g) { gs[g] = (l[4 * g] + l[4 * g + 1]) + (l[4 * g + 2] + l[4 * g + 3]); ot[g] = __shfl_xor(gs[g], 32); ps[g] = gs[g] + ot[g]; }
                        float T[4]; T[3] = 0.f; T[2] = ps[3]; T[1] = ps[3] + ps[2]; T[0] = T[1] + ps[1];
                        const float total = T[0] + ps[0];
                        float A[16];
#pragma unroll
                        for (int g = 0; g < 4; ++g) {
                            const float base = carry + T[g] + (hi == 0 ? ot[g] : 0.f);
                            const float i3 = base + l[4 * g + 3], i2 = i3 + l[4 * g + 2], i1 = i2 + l[4 * g + 1], i0 = i1 + l[4 * g];
                            A[4 * g + 3] = __builtin_amdgcn_exp2f(p[4 * g + 3] + i3); A[4 * g + 2] = __builtin_amdgcn_exp2f(p[4 * g + 2] + i2);
                            A[4 * g + 1] = __builtin_amdgcn_exp2f(p[4 * g + 1] + i1); A[4 * g] = __builtin_amdgcn_exp2f(p[4 * g] + i0);
                        }
                        if (diag) {
#pragma unroll
                            for (int r = 0; r < 16; ++r) A[r] = (sg0 + (r & 3) + 8 * (r >> 2) < tg) ? A[r] : 0.f;
                        }
                        carry += total;
                        const bf16x8 pf0 = pack8(A), pf1 = pack8(A + 8);
#pragma unroll
                        for (int s = 0; s < 2; ++s) {
                            const LAS unsigned char* vp = Vb + (32 * sub + 16 * s) * SB_ROW + vtr_off;
                            const s16x4 a0 = tr16(vp), a1 = tr16(vp + 8 * SB_ROW), b0 = tr16(vp + 64), b1 = tr16(vp + 64 + 8 * SB_ROW);
                            const bf16x8 vf0 = __builtin_shufflevector(a0, a1, 0, 1, 2, 3, 4, 5, 6, 7), vf1 = __builtin_shufflevector(b0, b1, 0, 1, 2, 3, 4, 5, 6, 7);
                            o0 = MFMA32(vf0, s ? pf1 : pf0, o0); o1 = MFMA32(vf1, s ? pf1 : pf0, o1);
                        }
                    }
                }
                if (64 * st < tq0 + 32) mydone = __all(carry <= -150.f);
                if (lane == 0) flg[(it & 1) * 8 + wave] = mydone ? 1u : 0u;
                if (st > 0) { LAS unsigned char* Kn = lds + (cb ^ 1) * SB_TILE; *(LAS u32x4*)(Kn + srow * SB_ROW + sch * 16) = kk; *(LAS u32x4*)(Kn + 2 * SB_TILE + srow * SB_ROW + sch * 16) = vv; }
                __syncthreads();
                { const u32x4 f0 = *(const LAS u32x4*)(flg + (it & 1) * 8), f1 = *(const LAS u32x4*)(flg + (it & 1) * 8 + 4);
                  if ((f0.x & f0.y & f0.z & f0.w & f1.x & f1.y & f1.z & f1.w) != 0u) break; }
            }
            bf16* op = o + (mb + tq0 + r32) * 1024 + h * 64 + 4 * hi;
#pragma unroll
            for (int g = 0; g < 4; ++g) {
                u32x2 w0, w1; w0.x = cvt_pk_bf16(o0[4 * g], o0[4 * g + 1]); w0.y = cvt_pk_bf16(o0[4 * g + 2], o0[4 * g + 3]);
                w1.x = cvt_pk_bf16(o1[4 * g], o1[4 * g + 1]); w1.y = cvt_pk_bf16(o1[4 * g + 2], o1[4 * g + 3]);
                *(u32x2*)(op + 8 * g) = w0; *(u32x2*)(op + 32 + 8 * g) = w1;
            }
        }
    }
}

constexpr int SBW_SLAB = 2 * 32 * SB_ROW;
__device__ __forceinline__ void sb_phase_w(const bf16* qkv, bf16* o, LAS unsigned char* lds, int vcu, int G, int tid) {
    const int lane = tid & 63, wave = __builtin_amdgcn_readfirstlane(tid >> 6), r32 = lane & 31, hi = lane >> 5;
    const int i16 = lane & 15, tq = i16 >> 2, tp = i16 & 3, blk = (lane >> 4) & 1;
    const int vtr_off = (4 * hi + tq) * SB_ROW + (16 * blk + 4 * tp) * 2;
    LAS unsigned char* Ks = lds + wave * SBW_SLAB; LAS unsigned char* Vs = Ks + 32 * SB_ROW;
    const int srow = lane >> 3, sch = lane & 7;
    for (int T = vcu * NWAVES + wave; T < 64 * 128; T += G * NWAVES) {
        const int bh = T >> 7, qb = T & 127, b = bh >> 4, h = bh & 15;
        const size_t mb = (size_t)b * SEQ;
        const bf16* kbase = qkv + mb * 3072 + 1024 + h * 64 + (size_t)srow * 3072 + sch * 8; const bf16* vbase = kbase + 1024;
        const int tg = 32 * qb + r32;
        bf16x8 qf[4];
        { const bf16* qp = qkv + (mb + tg) * 3072 + h * 64 + 8 * hi;
#pragma unroll
          for (int d0 = 0; d0 < 4; ++d0) qf[d0] = *(const bf16x8*)(qp + 16 * d0); }
        f32x16 o0, o1;
#pragma unroll
        for (int r = 0; r < 16; ++r) { o0[r] = 0.f; o1[r] = 0.f; }
        float carry = 0.f;
        u32x4 kreg[4], vreg[4];
#pragma unroll
        for (int c = 0; c < 4; ++c) { const size_t ro = (size_t)(32 * qb + 8 * c) * 3072; kreg[c] = *(const u32x4*)(kbase + ro); vreg[c] = *(const u32x4*)(vbase + ro); }
        for (int t = qb; t >= 0; --t) {
#pragma unroll
            for (int c = 0; c < 4; ++c) { *(LAS u32x4*)(Ks + (srow + 8 * c) * SB_ROW + sch * 16) = kreg[c]; *(LAS u32x4*)(Vs + (srow + 8 * c) * SB_ROW + sch * 16) = vreg[c]; }
            if (t > 0) {
#pragma unroll
                for (int c = 0; c < 4; ++c) { const size_t ro = (size_t)(32 * (t - 1) + 8 * c) * 3072; kreg[c] = *(const u32x4*)(kbase + ro); vreg[c] = *(const u32x4*)(vbase + ro); }
            }
            const bool diag = (t == qb);
            f32x16 p;
#pragma unroll
            for (int r = 0; r < 16; ++r) p[r] = 0.f;
            const LAS unsigned char* kp = Ks + r32 * SB_ROW + 16 * hi;
#pragma unroll
            for (int d0 = 0; d0 < 4; ++d0) p = MFMA32(*(const LAS bf16x8*)(kp + 32 * d0), qf[d0], p);
            float l[16]; const int sg0 = 32 * t + 4 * hi;
#pragma unroll
            for (int r = 0; r < 16; ++r) {
                const float z = p[r]; const float e = __builtin_amdgcn_exp2f(z); float lg = __builtin_amdgcn_logf(1.f + e); lg = z > 32.f ? z : lg;
                const bool valid = !diag || (sg0 + (r & 3) + 8 * (r >> 2) < tg);
                l[r] = valid ? -lg : 0.f;
            }
            float gs[4], ot[4], ps[4];
#pragma unroll
            for (int g = 0; g < 4; ++g) { gs[g] = (l[4 * g] + l[4 * g + 1]) + (l[4 * g + 2] + l[4 * g + 3]); ot[g] = __shfl_xor(gs[g], 32); ps[g] = gs[g] + ot[g]; }
            float Tt[4]; Tt[3] = 0.f; Tt[2] = ps[3]; Tt[1] = ps[3] + ps[2]; Tt[0] = Tt[1] + ps[1];
            const float total = Tt[0] + ps[0];
            float A[16];
#pragma unroll
            for (int g = 0; g < 4; ++g) {
                const float base = carry + Tt[g] + (hi == 0 ? ot[g] : 0.f);
                const float i3 = base + l[4 * g + 3], i2 = i3 + l[4 * g + 2], i1 = i2 + l[4 * g + 1], i0 = i1 + l[4 * g];
                A[4 * g + 3] = __builtin_amdgcn_exp2f(p[4 * g + 3] + i3); A[4 * g + 2] = __builtin_amdgcn_exp2f(p[4 * g + 2] + i2);
                A[4 * g + 1] = __builtin_amdgcn_exp2f(p[4 * g + 1] + i1); A[4 * g] = __builtin_amdgcn_exp2f(p[4 * g] + i0);
            }
            if (diag) {
#pragma unroll
                for (int r = 0; r < 16; ++r) A[r] = (sg0 + (r & 3) + 8 * (r >> 2) < tg) ? A[r] : 0.f;
            }
            carry += total;
            const bf16x8 pf0 = pack8(A), pf1 = pack8(A + 8);
#pragma unroll
            for (int s = 0; s < 2; ++s) {
                const LAS unsigned char* vp = Vs + 16 * s * SB_ROW + vtr_off;
                const s16x4 a0 = tr16(vp), a1 = tr16(vp + 8 * SB_ROW), b0 = tr16(vp + 64), b1 = tr16(vp + 64 + 8 * SB_ROW);
                const bf16x8 vf0 = __builtin_shufflevector(a0, a1, 0, 1, 2, 3, 4, 5, 6, 7), vf1 = __builtin_shufflevector(b0, b1, 0, 1, 2, 3, 4, 5, 6, 7);
                o0 = MFMA32(vf0, s ? pf1 : pf0, o0); o1 = MFMA32(vf1, s ? pf1 : pf0, o1);
            }
            if (__all(carry <= -150.f)) break;
        }
        bf16* op = o + (mb + tg) * 1024 + h * 64 + 4 * hi;
#pragma unroll
        for (int g = 0; g < 4; ++g) {
            u32x2 w0, w1; w0.x = cvt_pk_bf16(o0[4 * g], o0[4 * g + 1]); w0.y = cvt_pk_bf16(o0[4 * g + 2], o0[4 * g + 3]);
            w1.x = cvt_pk_bf16(o1[4 * g], o1[4 * g + 1]); w1.y = cvt_pk_bf16(o1[4 * g + 2], o1[4 * g + 3]);
            *(u32x2*)(op + 8 * g) = w0; *(u32x2*)(op + 32 + 8 * g) = w1;
        }
    }
}

__device__ __forceinline__ void swa_phase(const bf16* qkv, const float* sinks, bf16* o, LAS unsigned char* lds, int vcu, int G, int tid) {
    const int lane = tid & 63, wave = __builtin_amdgcn_readfirstlane(tid >> 6), r32 = lane & 31, hi = lane >> 5;
    const int i16 = lane & 15, tq = i16 >> 2, tp = i16 & 3, blk = (lane >> 4) & 1;
    const int vtr_off = (4 * hi + tq) * SB_ROW + (16 * blk + 4 * tp) * 2;
    LAS unsigned char* Kb = lds; LAS unsigned char* Vb = lds + 256 * SB_ROW;
    for (int u = vcu; u < 256; u += G) {
        const int kv = u & 1, n = (u >> 1) & 31, b = u >> 6;
        const int head = kv * 8 + wave;
        const float slope = exp2f(-0.5f * (float)(head + 1)), sink = sinks[head];
        __syncthreads();
#pragma unroll
        for (int c4 = 0; c4 < 4; ++c4) {
            const int idx = tid + NTHREADS * c4, kr = idx >> 3, ch = idx & 7;
            u32x4 kk = (u32x4){0u, 0u, 0u, 0u}, vv = kk;
            if (n > 0 || kr >= 128) { const bf16* p = qkv + ((size_t)b * SEQ + 128 * (n - 1) + kr) * 1280 + 1024 + kv * 64 + ch * 8; kk = *(const u32x4*)p; vv = *(const u32x4*)(p + 128); }
            *(LAS u32x4*)(Kb + kr * SB_ROW + ch * 16) = kk; *(LAS u32x4*)(Vb + kr * SB_ROW + ch * 16) = vv;
        }
        __syncthreads();
        for (int sb = 0; sb < 4; ++sb) {
            const size_t qrow = (size_t)b * SEQ + 128 * n + 32 * sb + r32;
            bf16x8 qf[4];
            { const bf16* qp = qkv + qrow * 1280 + head * 64 + 8 * hi;
#pragma unroll
              for (int d0 = 0; d0 < 4; ++d0) qf[d0] = *(const bf16x8*)(qp + 16 * d0); }
            const int kl = 128 + 32 * sb + r32;
            float lg[5][16]; float mx = sink;
#pragma unroll
            for (int kt = 0; kt < 5; ++kt) {
                f32x16 p;
#pragma unroll
                for (int r = 0; r < 16; ++r) p[r] = 0.f;
                const LAS unsigned char* kp = Kb + (32 * (sb + kt) + r32) * SB_ROW + 16 * hi;
#pragma unroll
                for (int d0 = 0; d0 < 4; ++d0) p = MFMA32(*(const LAS bf16x8*)(kp + 32 * d0), qf[d0], p);
#pragma unroll
                for (int r = 0; r < 16; ++r) {
                    const int kvl = 32 * (sb + kt) + (r & 3) + 8 * (r >> 2) + 4 * hi, dist = kl - kvl;
                    const bool valid = dist >= 0 && dist < 128 && (n > 0 || kvl >= 128);
                    const float v = valid ? p[r] - slope * (float)dist : -1e30f;
                    lg[kt][r] = v; mx = fmaxf(mx, v);
                }
            }
            mx = fmaxf(mx, __shfl_xor(mx, 32));
            float l = 0.f;
            f32x16 o0, o1;
#pragma unroll
            for (int r = 0; r < 16; ++r) { o0[r] = 0.f; o1[r] = 0.f; }
#pragma unroll
            for (int kt = 0; kt < 5; ++kt) {
#pragma unroll
                for (int r = 0; r < 16; ++r) { const float e = __expf(lg[kt][r] - mx); lg[kt][r] = e; l += e; }
                const bf16x8 pf0 = pack8(&lg[kt][0]), pf1 = pack8(&lg[kt][8]);
#pragma unroll
                for (int s = 0; s < 2; ++s) {
                    const LAS unsigned char* vp = Vb + (32 * (sb + kt) + 16 * s) * SB_ROW + vtr_off;
                    const s16x4 a0 = tr16(vp), a1 = tr16(vp + 8 * SB_ROW), b0 = tr16(vp + 64), b1 = tr16(vp + 64 + 8 * SB_ROW);
                    const bf16x8 vf0 = __builtin_shufflevector(a0, a1, 0, 1, 2, 3, 4, 5, 6, 7), vf1 = __builtin_shufflevector(b0, b1, 0, 1, 2, 3, 4, 5, 6, 7);
                    o0 = MFMA32(vf0, s ? pf1 : pf0, o0); o1 = MFMA32(vf1, s ? pf1 : pf0, o1);
                }
            }
            l += __shfl_xor(l, 32);
            const float inv = 1.f / (l + __expf(sink - mx));
            bf16* op = o + qrow * 1024 + head * 64 + 4 * hi;
#pragma unroll
            for (int g = 0; g < 4; ++g) {
                u32x2 w0, w1; w0.x = cvt_pk_bf16(o0[4 * g] * inv, o0[4 * g + 1] * inv); w0.y = cvt_pk_bf16(o0[4 * g + 2] * inv, o0[4 * g + 3] * inv);
                w1.x = cvt_pk_bf16(o1[4 * g] * inv, o1[4 * g + 1] * inv); w1.y = cvt_pk_bf16(o1[4 * g + 2] * inv, o1[4 * g + 3] * inv);
                *(u32x2*)(op + 8 * g) = w0; *(u32x2*)(op + 32 + 8 * g) = w1;
            }
        }
    }
}

__device__ __forceinline__ void ret_scores(bf16* qk, bf16* sc, int vcu, int G, int tid) {
    const int lane = tid & 63, wave = __builtin_amdgcn_readfirstlane(tid >> 6), r32 = lane & 31, hi = lane >> 5;
    const int it = wave >> 1, jh = wave & 1;
    for (int u = vcu; u < 512; u += G) {
        const int bh = u >> 5, n = u & 31, b = bh >> 2, h = bh & 3;
        const float lg = log2f(1.f - exp2f(-5.f - (float)h));
        const size_t row0 = (size_t)b * SEQ + n * 128;
        const bf16* qp = qk + (row0 + 32 * it + r32) * 2048 + h * 256 + 8 * hi;
        bf16x8 qf[16];
#pragma unroll
        for (int ks = 0; ks < 16; ++ks) qf[ks] = *(const bf16x8*)(qp + 16 * ks);
#pragma unroll
        for (int jt2 = 0; jt2 < 2; ++jt2) {
            const int jt = 2 * jh + jt2;
            if (jt <= it) {
                const bf16* kp = qk + (row0 + 32 * jt + r32) * 2048 + 1024 + h * 256 + 8 * hi;
                f32x16 p;
#pragma unroll
                for (int r = 0; r < 16; ++r) p[r] = 0.f;
#pragma unroll
                for (int ks = 0; ks < 16; ++ks) p = MFMA32(*(const bf16x8*)(kp + 16 * ks), qf[ks], p);
                const int i = 32 * it + r32;
                bf16* sp = sc + (size_t)u * 16384 + (size_t)(it * 8 + 2 * jt) * 512 + r32 * 8 + 4 * hi;
#pragma unroll
                for (int g = 0; g < 4; ++g) {
                    float v[4];
#pragma unroll
                    for (int e = 0; e < 4; ++e) { const int j = 32 * jt + 8 * g + 4 * hi + e; v[e] = (i >= j) ? p[4 * g + e] * exp2f((float)(i - j) * lg) : 0.f; }
                    u32x2 w; w.x = cvt_pk_bf16(v[0], v[1]); w.y = cvt_pk_bf16(v[2], v[3]);
                    *(u32x2*)(sp + (g >> 1) * 512 + (g & 1) * 256) = w;
                }
            }
        }
        __syncthreads();
        if (jh == 0) {
            char* qc = (char*)(qk + row0 * 2048 + h * 256) + (size_t)(it * 32 + hi) * 4096 + r32 * 16;
#pragma unroll
            for (int ks = 0; ks < 16; ++ks) *(bf16x8*)(qc + ks * 8192) = qf[ks];
        }
    }
}
constexpr int RT_ST_ROW = 528, RT_V_ROW = 80, RT_K_ROW = 144;
constexpr int RT_OFF_ST = 0, RT_OFF_V = 32 * RT_ST_ROW, RT_OFF_VD = RT_OFF_V + 128 * RT_V_ROW, RT_OFF_K = RT_OFF_VD + 128 * RT_V_ROW, RT_SLAB = 64 * RT_K_ROW;
__device__ __forceinline__ void ret_scan(const bf16* qk, bf16* vo, const bf16* sc, float* ssqo, LAS unsigned char* lds, int vcu, int G, int tid) {
    const int lane = tid & 63, wave = __builtin_amdgcn_readfirstlane(tid >> 6), r32 = lane & 31, hi = lane >> 5;
    const int i16 = lane & 15, tq = i16 >> 2, tp = i16 & 3, blk = (lane >> 4) & 1;
    const int trv = (8 * hi + tq) * RT_V_ROW + (16 * blk + 4 * tp) * 2, trk = (8 * hi + tq) * RT_K_ROW + (16 * blk + 4 * tp) * 2;
    const int vj = tid >> 2, vch = tid & 3;
    const int krj = lane >> 3, kch = lane & 7, uw = wave & 3;
    const bool owave = wave < 4;
    LAS unsigned char* slab = lds + RT_OFF_K + uw * RT_SLAB;
    for (int u = vcu; u < 256; u += G) {
        const int bh = u >> 4, es = u & 15, b = bh >> 2, h = bh & 3, e0 = 32 * es;
        const float lg = log2f(1.f - exp2f(-5.f - (float)h)), cdec = exp2f(128.f * lg);
        const float kd = exp2f((float)(127 - vj) * lg);
        const size_t rowb = (size_t)b * SEQ;
        const int i = 32 * uw + r32;
        const float qd = exp2f((float)(i + 1) * lg);
        f32x16 st0, st1;
#pragma unroll
        for (int r = 0; r < 16; ++r) { st0[r] = 0.f; st1[r] = 0.f; }
        u32x4 kreg[16], vreg; bf16x8 qreg[16], sreg[8];
        unsigned offq = (unsigned)(hi * 4096 + r32 * 16), offs = (unsigned)(lane * 16), offk = (unsigned)(krj * 2048 + 8 * kch) * 2u, offv = (unsigned)(vj * 2048 + 8 * vch) * 2u;
        unsigned offo = (unsigned)(i * 2048 + 4 * hi) * 2u, offsq = (unsigned)(i * 64) * 4u;
        const char* const qbase = (const char*)(qk + rowb * 2048 + h * 256);
        const char* const kbase = (const char*)(qk + rowb * 2048 + 1024 + h * 256 + 64 * uw);
        const char* const sbase = (const char*)(sc + (size_t)(bh * 32) * 16384);
        char* const vbase = (char*)(vo + rowb * 2048 + h * 512 + e0);
        char* const sqbase = (char*)(ssqo + (rowb * 4 + h) * 16 + es);
#define RT_LOAD_K(nn, half) do { const char* kb_ = kbase + (size_t)(128 * (nn) + 64 * (half)) * 4096; _Pragma("unroll") for (int c8 = 0; c8 < 8; ++c8) \
            kreg[8 * (half) + c8] = *(const u32x4*)(kb_ + c8 * 32768 + offk); } while (0)
#define RT_LOAD_QS(nn) do { const char* qb_ = qbase + (size_t)(128 * (nn) + 32 * uw) * 4096; \
            _Pragma("unroll") for (int ks = 0; ks < 16; ++ks) qreg[ks] = *(const bf16x8*)(qb_ + 8192 * ks + offq); \
            const char* sb_ = sbase + (size_t)(nn) * 32768 + uw * 8192; \
            _Pragma("unroll") for (int ks = 0; ks < 8; ++ks) if (ks < 2 * uw + 2) sreg[ks] = *(const bf16x8*)(sb_ + 1024 * ks + offs); } while (0)
#define RT_LOAD_V(nn) do { vreg = *(const u32x4*)(vbase + (size_t)(128 * (nn)) * 4096 + offv); } while (0)
#define RT_WRITE_V() do { *(LAS u32x4*)(lds + RT_OFF_V + vj * RT_V_ROW + vch * 16) = vreg; float f8[8]; UNPACK8(f8, vreg); \
            u32x4 wd; wd.x = cvt_pk_bf16(f8[0] * kd, f8[1] * kd); wd.y = cvt_pk_bf16(f8[2] * kd, f8[3] * kd); wd.z = cvt_pk_bf16(f8[4] * kd, f8[5] * kd); wd.w = cvt_pk_bf16(f8[6] * kd, f8[7] * kd); \
            *(LAS u32x4*)(lds + RT_OFF_VD + vj * RT_V_ROW + vch * 16) = wd; } while (0)
        __syncthreads();
        for (int x = tid * 16; x < 32 * RT_ST_ROW; x += NTHREADS * 16) *(LAS u32x4*)(lds + RT_OFF_ST + x) = (u32x4){0u, 0u, 0u, 0u};
        RT_LOAD_V(0); RT_WRITE_V();
#define RT_BAR() do { asm volatile("s_waitcnt lgkmcnt(0)" ::: "memory"); __builtin_amdgcn_s_barrier(); asm volatile("" ::: "memory"); } while (0)
        if (owave) {
            RT_LOAD_QS(0);
            for (int n = 0; n < 32; ++n) {
                RT_BAR();
                asm volatile("" : "+v"(offq), "+v"(offs), "+v"(offv), "+v"(offo), "+v"(offsq));
                if (n < 31) RT_LOAD_V(n + 1);
                f32x16 oc, oi;
#pragma unroll
                for (int r = 0; r < 16; ++r) { oc[r] = 0.f; oi[r] = 0.f; }
                const LAS unsigned char* sp = lds + RT_OFF_ST + r32 * RT_ST_ROW + 16 * hi;
#pragma unroll
                for (int ks = 0; ks < 16; ++ks) oc = MFMA32(*(const LAS bf16x8*)(sp + 32 * ks), qreg[ks], oc);
#pragma unroll
                for (int ks = 0; ks < 8; ++ks) if (ks < 2 * uw + 2) {
                    const LAS unsigned char* vp = lds + RT_OFF_V + 16 * ks * RT_V_ROW + trv;
                    const s16x4 a0 = tr16(vp), a1 = tr16(vp + 4 * RT_V_ROW);
                    const bf16x8 vf = __builtin_shufflevector(a0, a1, 0, 1, 2, 3, 4, 5, 6, 7);
                    oi = MFMA32(vf, sreg[ks], oi);
                }
                if (n < 31) RT_LOAD_QS(n + 1);
                float s = 0.f;
                char* const op = vbase + (size_t)(128 * n) * 4096 + offo;
#pragma unroll
                for (int g = 0; g < 4; ++g) {
                    float v[4];
#pragma unroll
                    for (int e = 0; e < 4; ++e) { v[e] = oi[4 * g + e] + qd * oc[4 * g + e]; s += v[e] * v[e]; }
                    u32x2 w; w.x = cvt_pk_bf16(v[0], v[1]); w.y = cvt_pk_bf16(v[2], v[3]);
                    *(u32x2*)(op + 16 * g) = w;
                }
                s += __shfl_xor(s, 32);
                if (hi == 0) *(float*)(sqbase + (size_t)(128 * n) * 256 + offsq) = s;
                RT_BAR();
                if (n < 31) RT_WRITE_V();
            }
        } else {
            RT_LOAD_K(0, 0); RT_LOAD_K(0, 1);
            for (int n = 0; n < 32; ++n) {
                RT_BAR();
                asm volatile("" : "+v"(offk), "+v"(offv));
                if (n < 31) RT_LOAD_V(n + 1);
#pragma unroll
                for (int r = 0; r < 16; ++r) { st0[r] *= cdec; st1[r] *= cdec; }
#pragma unroll
                for (int half = 0; half < 2; ++half) {
#pragma unroll
                    for (int c8 = 0; c8 < 8; ++c8) *(LAS u32x4*)(slab + (krj + 8 * c8) * RT_K_ROW + kch * 16) = kreg[8 * half + c8];
                    if (n < 31) { if (half == 0) RT_LOAD_K(n + 1, 0); else RT_LOAD_K(n + 1, 1); }
#pragma unroll
                    for (int ks = 0; ks < 4; ++ks) {
                        const LAS unsigned char* kp = slab + 16 * ks * RT_K_ROW + trk;
                        const LAS unsigned char* vp = lds + RT_OFF_VD + (64 * half + 16 * ks) * RT_V_ROW + trv;
                        const s16x4 v0 = tr16(vp), v1 = tr16(vp + 4 * RT_V_ROW);
                        const s16x4 k0 = tr16(kp), k1 = tr16(kp + 4 * RT_K_ROW), k2 = tr16(kp + 64), k3 = tr16(kp + 64 + 4 * RT_K_ROW);
                        const bf16x8 vf = __builtin_shufflevector(v0, v1, 0, 1, 2, 3, 4, 5, 6, 7);
                        const bf16x8 kf0 = __builtin_shufflevector(k0, k1, 0, 1, 2, 3, 4, 5, 6, 7), kf1 = __builtin_shufflevector(k2, k3, 0, 1, 2, 3, 4, 5, 6, 7);
                        st0 = MFMA32(kf0, vf, st0); st1 = MFMA32(kf1, vf, st1);
                    }
                }
                RT_BAR();
                { LAS unsigned char* wp = lds + RT_OFF_ST + r32 * RT_ST_ROW + (64 * uw + 4 * hi) * 2;
#pragma unroll
                  for (int g = 0; g < 4; ++g) {
                    u32x2 w0, w1; w0.x = cvt_pk_bf16(st0[4 * g], st0[4 * g + 1]); w0.y = cvt_pk_bf16(st0[4 * g + 2], st0[4 * g + 3]);
                    w1.x = cvt_pk_bf16(st1[4 * g], st1[4 * g + 1]); w1.y = cvt_pk_bf16(st1[4 * g + 2], st1[4 * g + 3]);
                    *(LAS u32x2*)(wp + 16 * g) = w0; *(LAS u32x2*)(wp + 64 + 16 * g) = w1;
                  } }
                if (n < 31) RT_WRITE_V();
            }
        }
#undef RT_BAR
#undef RT_LOAD_K
#undef RT_LOAD_QS
#undef RT_LOAD_V
#undef RT_WRITE_V
    }
}

#define XB_TMO      128
#define XB_XCNT(j)  (256  + 64 * (j))
#define XB_XSUB(j)  (1280 + 64 * (j))
#define XB_XGEN(j)  (2304 + 64 * (j))
#define XB_TOP      3328
#define XB_TOPGEN   3392
#define XCD_BAR_WORDS 3456
#define XB_SPIN_CAP (1u << 18)

__device__ __forceinline__ unsigned xb_ld(unsigned* p)              { return __hip_atomic_load(p, __ATOMIC_RELAXED, __HIP_MEMORY_SCOPE_AGENT); }
__device__ __forceinline__ unsigned xb_add(unsigned* p, unsigned v) { return __hip_atomic_fetch_add(p, v, __ATOMIC_RELAXED, __HIP_MEMORY_SCOPE_AGENT); }
__device__ __forceinline__ unsigned xb_xcc_id() { return (unsigned)__builtin_amdgcn_s_getreg((3 << 11) | 20) & 0xFu; }
#define XB_SPIN(cond, bar) do { unsigned _sp = 0; while (cond) { __builtin_amdgcn_s_sleep(1); \
    if ((++_sp & 255u) == 0u) { if (xb_ld(&(bar)[XB_TMO])) break; if (_sp > XB_SPIN_CAP) { atomicAdd(&(bar)[XB_TMO], 1u); break; } } } } while (0)

struct XcdBarrier {
    unsigned* bar; unsigned x;
    volatile LAS unsigned* st;
};

__device__ __forceinline__ XcdBarrier xcd_barrier_post(unsigned* bar, volatile LAS unsigned* st) {
    XcdBarrier b; b.bar = bar; b.x = xb_xcc_id(); b.st = st;
    if (threadIdx.x == 0) (void)xb_add(&bar[XB_XCNT(b.x)], 1u);
    return b;
}
__device__ __forceinline__ void xcd_barrier_complete(unsigned* bar, unsigned x, unsigned& nloc, unsigned& nx) {
    const unsigned G = gridDim.x * gridDim.y * gridDim.z;
    unsigned sum, cnt, mine, sp = 0u;
    for (;;) {
        sum = 0u; cnt = 0u; mine = 0u;
#pragma unroll
        for (unsigned j = 0; j < 16; ++j) { const unsigned c = xb_ld(&bar[XB_XCNT(j)]); sum += c; cnt += (c > 0u) ? 1u : 0u; mine = (j == x) ? c : mine; }
        if (sum == G) break;
        __builtin_amdgcn_s_sleep(1);
        if ((++sp & 255u) == 0u) { if (xb_ld(&bar[XB_TMO])) break; if (sp > XB_SPIN_CAP) { atomicAdd(&bar[XB_TMO], 1u); break; } }
    }
    nloc = mine > 0u ? mine : 1u; nx = cnt > 0u ? cnt : 1u;
}

__device__ __forceinline__ void xcd_barrier(const XcdBarrier& b) {
    asm volatile("s_waitcnt vmcnt(0)" ::: "memory");
    __syncthreads();
    if (threadIdx.x == 0) {
        unsigned* bar = b.bar;
        __builtin_amdgcn_s_waitcnt(0);
        unsigned nloc = b.st[0], nx = b.st[1];
        if (nloc == 0u) { xcd_barrier_complete(bar, b.x, nloc, nx); b.st[0] = nloc; b.st[1] = nx; }
        const unsigned old = xb_add(&bar[XB_XSUB(b.x)], 1u);
        const unsigned gen = old / nloc;
        if (old + 1u == (gen + 1u) * nloc) {
            __builtin_amdgcn_fence(__ATOMIC_RELEASE, "agent");
            asm volatile("s_waitcnt vmcnt(0)" ::: "memory");
            const unsigned og = xb_add(&bar[XB_TOP], 1u);
            const unsigned tg = og / nx;
            if (og + 1u == (tg + 1u) * nx) xb_add(&bar[XB_TOPGEN], 1u);
            else XB_SPIN(xb_ld(&bar[XB_TOPGEN]) == tg, bar);
            __builtin_amdgcn_fence(__ATOMIC_ACQUIRE, "agent");
            xb_add(&bar[XB_XGEN(b.x)], 1u);
            asm volatile("s_waitcnt vmcnt(0)" ::: "memory");
        } else {
            XB_SPIN(xb_ld(&bar[XB_XGEN(b.x)]) == gen, bar);
            __builtin_amdgcn_fence(__ATOMIC_ACQUIRE, "agent");
            asm volatile("s_waitcnt vmcnt(0)" ::: "memory");
        }
    }
    __syncthreads();
}

#define FILL_RS_TABLE(S_, kk_) do { _Pragma("unroll") for (int ui_ = 0; ui_ < 4; ++ui_) { pg8::Unit u_; kk_[ui_] = -1; \
        if (S_.next(ui_, u_)) { kk_[ui_] = u_.pm; if (tl_ < 256) rstab[ui_ * 256 + tl_] = row_rs(ssq, u_.pm * 256 + tl_); } } __syncthreads(); } while (0)
__global__ void __launch_bounds__(NTHREADS, 2) mega(Args a) {
    extern __shared__ __attribute__((aligned(16))) unsigned char lds_raw[];
    LAS unsigned char* lds = (LAS unsigned char*)lds_raw;
    cg::grid_group grid = cg::this_grid();
    const int tid = threadIdx.x, lane0 = tid & 63, wave = __builtin_amdgcn_readfirstlane(tid >> 6);
    const int G = gridDim.x, bx = blockIdx.x;
    const int gw = bx * NWAVES + wave, NGW = G * NWAVES, gthreads = G * NTHREADS;
    const int vcu = (G % 8 == 0) ? (bx % 8) * (G / 8) + bx / 8 : bx;
    unsigned char* ws = a.ws;
    float* ssq = (float*)(ws + WS_SSQ); bf16* hb = (bf16*)(ws + WS_HB);
    unsigned char* R = ws + WS_R;

    volatile LAS unsigned* xb_st = (volatile LAS unsigned*)(lds + 131072 + 64);
    LAS float* rstab = (LAS float*)(lds + 131072 + 256);
    if (tid < 2) xb_st[tid] = 0u;
    unsigned* barw = (unsigned*)(ws + WS_BAR);
    __syncthreads();
    const XcdBarrier xbar = xcd_barrier_post(barw, xb_st);
    const bool has_slack = (G < 320) && (2 * G > 320);
    convert_layer(a, 0, has_slack ? 1 : 15, lds, gw, NGW, wave, lane0);
    for (int m = gw; m < M; m += 2 * NGW) {
        const int lane = lane0; const int m1 = m + NGW; const bool two = m1 < M;
        const f32x4* xr0 = (const f32x4*)(a.in[0] + (size_t)m * D) + lane; const f32x4* xr1 = (const f32x4*)(a.in[0] + (size_t)(two ? m1 : m) * D) + lane;
        f32x4 v0[4], v1[4];
#pragma unroll
        for (int j = 0; j < 4; ++j) { v0[j] = __builtin_nontemporal_load(xr0 + 64 * j); v1[j] = __builtin_nontemporal_load(xr1 + 64 * j); }
        float s0 = 0.f, s1 = 0.f;
        unsigned long long* o0 = (unsigned long long*)(hb + (size_t)m * D) + lane; unsigned long long* o1 = (unsigned long long*)(hb + (size_t)m1 * D) + lane;
#pragma unroll
        for (int j = 0; j < 4; ++j) {
            s0 += (v0[j][0] * v0[j][0] + v0[j][1] * v0[j][1]) + (v0[j][2] * v0[j][2] + v0[j][3] * v0[j][3]);
            s1 += (v1[j][0] * v1[j][0] + v1[j][1] * v1[j][1]) + (v1[j][2] * v1[j][2] + v1[j][3] * v1[j][3]);
            o0[64 * j] = (unsigned long long)cvt_pk_bf16(v0[j][0], v0[j][1]) | ((unsigned long long)cvt_pk_bf16(v0[j][2], v0[j][3]) << 32);
            if (two) o1[64 * j] = (unsigned long long)cvt_pk_bf16(v1[j][0], v1[j][1]) | ((unsigned long long)cvt_pk_bf16(v1[j][2], v1[j][3]) << 32);
        }
        s0 = wave_sum(s0); s1 = wave_sum(s1);
        if (lane < 16) { ssq[(size_t)m * 16 + lane] = (lane == 0) ? s0 : 0.f; if (two) ssq[(size_t)m1 * 16 + lane] = (lane == 0) ? s1 : 0.f; }
    }
    if (a.ws == nullptr) grid.sync();
    xcd_barrier(xbar);

    for (int i = 0; i < DEPTH; ++i) {
        const int kind = i % 3, j = i / 3;
        unsigned char* wb = ws + ((i & 1) ? WS_WB1 : WS_WB0);
        int tl_ = threadIdx.x; asm volatile("" : "+v"(tl_));
        const int lane = tl_ & 63, gtid = bx * NTHREADS + tl_;
        {
            const int n_in = kind == 0 ? 1280 : (kind == 1 ? 3072 : 4096);
            pg8::Gemm g{hb, (const bf16*)(wb + WB_IN), M, n_in, D}; pg8::StaticOrder S; S.init(M, n_in, G, bx);
            int kk[4]; FILL_RS_TABLE(S, kk);
            EpiRowScale<0> E{(bf16*)R, kind == 2 ? 2048 : n_in, ssq, kind == 2 ? 2048 : 0, (size_t)(R_V / 2), rstab, kk[0], kk[1], kk[2], kk[3]};
            pg8::gemm_phase<EpiRowScale<0>, pg8::StaticOrder, true, true>(lds, g, S, E);
            if (kind == 0 && has_slack) {
                const int first = S.nwg - G;
                if (bx >= first) { convert_layer(a, i, 14, lds, (bx - first) * NWAVES + wave, (G - first) * NWAVES, wave, lane);
                    if (i + 1 < DEPTH) convert_layer(a, i + 1, 15, lds, (bx - first) * NWAVES + wave, (G - first) * NWAVES, wave, lane); }
            }
        }
        xcd_barrier(xbar);
        if (i + 1 < DEPTH && !(kind == 0 && has_slack)) { convert_layer(a, i + 1, (has_slack && (i + 1) % 3 == 0) ? 1 : 15, lds, gw, NGW, wave, lane); __syncthreads(); }
        if (kind == 0) swa_phase((const bf16*)R, a.in[5] + j * 16, (bf16*)(R + R_O), lds, vcu, G, tl_);
        else if (kind == 1) sb_phase_w((const bf16*)R, (bf16*)(R + R_O), lds, vcu, G, tl_);
        else {
            ret_scores((bf16*)R, (bf16*)(ws + WS_SC), vcu, G, tl_);
            xcd_barrier(xbar);
            ret_scan((const bf16*)R, (bf16*)(R + R_V), (const bf16*)(ws + WS_SC), (float*)(ws + WS_SSQO), lds, vcu, G, tl_);
            xcd_barrier(xbar);
            pg8::Gemm g{hb, (const bf16*)(wb + WB_IN) + (size_t)4096 * D, M, 2048, D}; pg8::StaticOrder S; S.init(M, 2048, G, bx);
            EpiGate E{(bf16*)R, (const bf16*)(R + R_V), ssq, (const float*)(ws + WS_SSQO)};
            pg8::gemm_phase<EpiGate, pg8::StaticOrder, true, true>(lds, g, S, E);
        }
        xcd_barrier(xbar);
        {
            const int k_o = kind == 2 ? 2048 : 1024;
            pg8::Gemm g{kind == 2 ? (const bf16*)R : (const bf16*)(R + R_O), (const bf16*)(wb + WB_O), M, D, k_o}; pg8::StaticOrder S; S.init(M, D, G, bx);
            EpiRes<false> E{nullptr, hb, ssq}; pg8::gemm_phase<EpiRes<false>, pg8::StaticOrder, true, true>(lds, g, S, E);
        }
        xcd_barrier(xbar);
        {
            pg8::Gemm g{hb, (const bf16*)(wb + WB_UP), M, FF, D}; pg8::StaticOrder S; S.init(M, FF, G, bx);
            int kk[4]; FILL_RS_TABLE(S, kk);
            EpiRowScale<1> E{(bf16*)R, FF, ssq, 0, 0, rstab, kk[0], kk[1], kk[2], kk[3]};
            pg8::gemm_phase<EpiRowScale<1>, pg8::StaticOrder, true, true>(lds, g, S, E);
        }
        xcd_barrier(xbar);
        {
            pg8::Gemm g{(const bf16*)R, (const bf16*)(wb + WB_DOWN), M, D, FF}; pg8::StaticOrder S; S.init(M, D, G, bx);
            EpiRes<false> E{nullptr, hb, ssq};
            pg8::gemm_phase<EpiRes<false>, pg8::StaticOrder, true, true>(lds, g, S, E);
        }
        xcd_barrier(xbar);
    }
    for (int m = gw; m < M; m += NGW) {
        const float rs = row_rs(ssq, m); const int lane = lane0;
        const u32x4* hr = (const u32x4*)(hb + (size_t)m * D) + lane; const f32x4* gr = (const f32x4*)a.in[3] + 2 * lane; f32x4* orow = (f32x4*)(a.out + (size_t)m * D) + 2 * lane;
#pragma unroll
        for (int jj = 0; jj < 2; ++jj) { const u32x4 hv = hr[64 * jj]; const f32x4 g0 = gr[128 * jj], g1 = gr[128 * jj + 1];
            const f32x4 v0 = (f32x4){bflo(hv.x), bfhi(hv.x), bflo(hv.y), bfhi(hv.y)}, v1 = (f32x4){bflo(hv.z), bfhi(hv.z), bflo(hv.w), bfhi(hv.w)};
            __builtin_nontemporal_store(v0 * rs * g0, orow + 128 * jj); __builtin_nontemporal_store(v1 * rs * g1, orow + 128 * jj + 1); }
    }
}

extern "C" void kernel_launch(void* const* d_in, const int* in_sizes, int n_in, void* d_out, int out_size, void* d_ws, size_t ws_size, hipStream_t stream) {
    static int grid = 0;
    if (grid == 0) {
        if (n_in != 13 || out_size != M * D || ws_size < WS_END) { fprintf(stderr, "kernel_launch: unexpected shapes (n_in %d out %d ws %zu)\n", n_in, out_size, ws_size); grid = -1; return; }
        int dev = 0, cus = 0, per_cu = 0;
        hipGetDevice(&dev); hipDeviceGetAttribute(&cus, hipDeviceAttributeMultiprocessorCount, dev);
        hipFuncSetAttribute((const void*)mega, hipFuncAttributeMaxDynamicSharedMemorySize, LDS_BYTES);
        if (hipOccupancyMaxActiveBlocksPerMultiprocessor(&per_cu, (const void*)mega, NTHREADS, LDS_BYTES) != hipSuccess || per_cu < 1) { fprintf(stderr, "kernel_launch: occupancy query gave %d\n", per_cu); per_cu = 1; }
        (void)hipGetLastError();
        grid = cus * per_cu;
        fprintf(stderr, "kernel_launch: grid %d (cus %d x %d)\n", grid, cus, per_cu);
    }
    if (grid < 0) return;
    Args a{};
    for (int i = 0; i < 13; ++i) a.in[i] = (const float*)d_in[i];
    a.out = (float*)d_out; a.ws = (unsigned char*)d_ws;
    if (hipMemsetAsync((char*)d_ws + WS_BAR, 0, XCD_BAR_WORDS * 4, stream) != hipSuccess) { fprintf(stderr, "kernel_launch: memset of the barrier words failed\n"); return; }
    void* args[] = {&a};
    hipError_t e = hipLaunchCooperativeKernel((const void*)mega, dim3(grid), dim3(NTHREADS), args, LDS_BYTES, stream);
    if (e != hipSuccess) fprintf(stderr, "cooperative launch failed: %s (grid %d)\n", hipGetErrorString(e), grid);
}
```

```cpp
#include <hip/hip_runtime.h>
#include <hip/hip_cooperative_groups.h>
#include <cstdio>
#include <cstdint>
namespace cg = cooperative_groups;
namespace pg8 {
#define PG8_LAS __attribute__((address_space(3)))
typedef unsigned short bf16_t;
typedef short bf16x8 __attribute__((ext_vector_type(8)));
typedef float f32x4 __attribute__((ext_vector_type(4)));
typedef unsigned u32x4 __attribute__((ext_vector_type(4)));
constexpr int BM = 256, BK = 64, HALF = 128, HTB = HALF * BK * 2  , STAGE_BYTES = 8 * HTB, NXCD = 8, WGM = 8;

__host__ __device__ __forceinline__ int lds_byte(int r, int c) { const int st = (r >> 4) * 2 + (c >> 5), rr = r & 15, cc = c & 31, ob = rr * 64 + cc * 2; return st * 1024 + (ob ^ (((ob >> 9) & 1) << 5)); }
__host__ __device__ __forceinline__ void stage_rc(int b, int& R, int& C) { const int st = b / 1024, sb = b % 1024, swz = sb ^ (((sb >> 9) & 1) << 5); R = (st >> 1) * 16 + swz / 64; C = (st & 1) * 32 + (swz % 64) / 2; }
__host__ __device__ __forceinline__ int perm32(int rho) { const int n = rho >> 4, i = rho & 15; return 8 * (i >> 2) + 4 * n + (i & 3); }

struct Unit { int pm, pn; };
struct Gemm { const bf16_t* A; const bf16_t* Bt; int M, N, K; };

struct StaticOrder {
    int nM, nN, nwg, G, c;
    __host__ __device__ void init(int M, int N, int G_, int c_) { nM = M / BM; nN = N / BM; nwg = nM * nN; G = G_; c = c_; }
    __host__ __device__ bool next(int i, Unit& u) const {
        const long L = (long)i * G + c; if (L >= nwg) return false;
        int wgid = (int)L; { const int q = nwg / NXCD, r = nwg % NXCD, xcd = wgid % NXCD, off = wgid / NXCD; wgid = (xcd < r ? xcd * (q + 1) : r * (q + 1) + (xcd - r) * q) + off; }
        const int nig = WGM * nN, gid = wgid / nig, fm = gid * WGM, gsz = (nM - fm) < WGM ? (nM - fm) : WGM;
        u.pm = fm + ((wgid % nig) % gsz); u.pn = (wgid % nig) / gsz; return true;
    }
    __device__ __forceinline__ void a_ready(const Unit&) const {}
    __device__ __forceinline__ void done(const Unit&) const {}
};

__device__ __forceinline__ unsigned cvt_pk_bf16(float lo, float hi) { unsigned r; asm volatile("v_cvt_pk_bf16_f32 %0, %1, %2" : "=v"(r) : "v"(lo), "v"(hi)); return r; }
typedef float f32x2 __attribute__((ext_vector_type(2)));
__device__ __forceinline__ f32x2 gelu_pk(f32x2 v) {
    const f32x2 av = __builtin_elementwise_abs(v), d = av * 0.2316418882f + 1.0f;
    f32x2 t; t.x = __builtin_amdgcn_rcpf(d.x); t.y = __builtin_amdgcn_rcpf(d.y);
    f32x2 q = t * 0.5307027145f + (-0.7265760135f); q = q * t + 0.7107068705f; q = q * t + (-0.142248368f); q = q * t + 0.127414796f; q = q * t;
    const f32x2 s = (v * v) * (-0.72134752044f);
    f32x2 e; e.x = __builtin_amdgcn_exp2f(s.x); e.y = __builtin_amdgcn_exp2f(s.y);
    const f32x2 m = v * (q * e), r = v - m;
    f32x2 o; o.x = v.x < 0.f ? m.x : r.x; o.y = v.y < 0.f ? m.y : r.y; return o;
}

template <int ACT  > struct EpiBf16 {
    static constexpr bool PERM = true, AFTER_DRAIN = false; static_assert(ACT == 0 || ACT == 1, "EpiBf16: ACT is 0 (none) or 1 (gelu_pk)");
    bf16_t* O; int ldc; const float* bias; int split_cols; size_t split_stride; float scale0;
    __device__ __forceinline__ void operator()(const f32x4 (&acc)[2][2][4][2], const Unit& u, int wr, int wc, int fr, int fq) const {
        const int row0 = u.pm * BM + wr * 64 + fr; int colt = u.pn * BM; bf16_t* base = O;
        float sc = 1.f; if (split_cols) { const int t = colt / split_cols; base += (size_t)t * split_stride; colt -= t * split_cols; if (t == 0) sc = scale0; }
        const int col0 = colt + wc * 32 + 8 * fq, bcol0 = u.pn * BM + wc * 32 + 8 * fq;
        f32x4 bv[2][2];
#pragma unroll
        for (int bj = 0; bj < 2; ++bj)
#pragma unroll
            for (int n = 0; n < 2; ++n) bv[bj][n] = bias ? *(const f32x4*)(bias + bcol0 + bj * HALF + 4 * n) : (f32x4){0.f, 0.f, 0.f, 0.f};
#pragma unroll
        for (int ai = 0; ai < 2; ++ai)
#pragma unroll
            for (int m = 0; m < 4; ++m) { bf16_t* rowp = base + (size_t)(row0 + ai * HALF + m * 16) * ldc + col0;
#pragma unroll
                for (int bj = 0; bj < 2; ++bj) { f32x4 v0 = acc[ai][bj][m][0] + bv[bj][0], v1 = acc[ai][bj][m][1] + bv[bj][1];
                    if (ACT == 1) { f32x2 a = gelu_pk((f32x2){v0[0], v0[1]}), b = gelu_pk((f32x2){v0[2], v0[3]}), c = gelu_pk((f32x2){v1[0], v1[1]}), d = gelu_pk((f32x2){v1[2], v1[3]});
                        v0 = (f32x4){a.x, a.y, b.x, b.y}; v1 = (f32x4){c.x, c.y, d.x, d.y}; }
                    v0 = v0 * sc; v1 = v1 * sc; u32x4 w; w.x = cvt_pk_bf16(v0[0], v0[1]); w.y = cvt_pk_bf16(v0[2], v0[3]); w.z = cvt_pk_bf16(v1[0], v1[1]); w.w = cvt_pk_bf16(v1[2], v1[3]);
                    *(u32x4*)(rowp + bj * HALF) = w; } }
    }
};

template <class Epi, class Sched, bool ALIGN_EPI = false, bool SP2 = false>
__device__ __forceinline__ void gemm_phase(PG8_LAS unsigned char* lds, const Gemm g, const Sched& S, const Epi& E) {
    int tid_ = threadIdx.x; asm volatile("" : "+v"(tid_));
    const int tid = tid_, wid = __builtin_amdgcn_readfirstlane(tid >> 6), lane = tid & 63, wr = wid >> 2, wc = wid & 3, fr = lane & 15, fq = lane >> 4;
    const int K = g.K, nt = K / BK;
    unsigned voffA[2], voffB[2];
#pragma unroll
    for (int i = 0; i < 2; ++i) { int R, C; stage_rc(tid * 16 + i * 8192, R, C); const int Rb = Epi::PERM ? ((R & ~31) + perm32(R & 31)) : R;
        voffA[i] = (unsigned)(R * K + C) * 2u; voffB[i] = (unsigned)(Rb * K + C) * 2u; }
    const size_t kstep = (size_t)(BK * 2);
    const size_t hstep = (size_t)HALF * K * 2;
    const size_t tstep = 2 * hstep;
    const unsigned ldsw = (unsigned)wid * 1024u;
    const int aoff = lds_byte(wr * 64 + fr, fq * 8), boff = lds_byte(wc * 32 + fr, fq * 8);
#define PG8_SA(b, h) (((b) * 2 + (h)) * HTB)
#define PG8_SB(b, h) ((4 + (b) * 2 + (h)) * HTB)
#define PG8_STAGE(bufoff, gbase, voff) do { _Pragma("unroll") for (int _i = 0; _i < 2; ++_i) \
        __builtin_amdgcn_global_load_lds((const unsigned*)((const char*)(gbase) + (voff)[_i]), (PG8_LAS unsigned*)(lds + (bufoff) + ldsw + _i * 8192), 16, 0, 0); } while (0)
#define PG8_LDA(dst, b, h) do { _Pragma("unroll") for (int m = 0; m < 4; ++m) _Pragma("unroll") for (int k = 0; k < 2; ++k) dst[m][k] = *(const PG8_LAS bf16x8*)(lds + PG8_SA(b, h) + aoff + m * 2048 + k * 1024); } while (0)
#define PG8_LDB(dst, b, h) do { _Pragma("unroll") for (int n = 0; n < 2; ++n) _Pragma("unroll") for (int k = 0; k < 2; ++k) dst[n][k] = *(const PG8_LAS bf16x8*)(lds + PG8_SB(b, h) + boff + n * 2048 + k * 1024); } while (0)
#define PG8_MMA(ai, bj, At, Bt) do { __builtin_amdgcn_s_setprio(1); _Pragma("unroll") for (int m = 0; m < 4; ++m) _Pragma("unroll") for (int n = 0; n < 2; ++n) _Pragma("unroll") for (int k = 0; k < 2; ++k) \
        acc[ai][bj][m][n] = __builtin_amdgcn_mfma_f32_16x16x32_bf16(Bt[n][k], At[m][k], acc[ai][bj][m][n], 0, 0, 0); __builtin_amdgcn_s_setprio(0); } while (0)
#define PG8_WAIT_V(n) asm volatile("s_waitcnt vmcnt(" #n ")" ::: "memory")
#define PG8_WAIT_L(n) asm volatile("s_waitcnt lgkmcnt(" #n ")" ::: "memory")
#define PG8_BAR __builtin_amdgcn_s_barrier()
#define PG8_SCHED __builtin_amdgcn_sched_barrier(0)
    Unit cur, nxt; int ui = 0;
    if (!S.next(0, cur)) return;
    f32x4 acc[2][2][4][2];
#pragma unroll
    for (int a = 0; a < 2; ++a)
#pragma unroll
        for (int b = 0; b < 2; ++b)
#pragma unroll
            for (int m = 0; m < 4; ++m)
#pragma unroll
                for (int n = 0; n < 2; ++n) acc[a][b][m][n] = (f32x4){0.f, 0.f, 0.f, 0.f};
    bf16x8 At[4][2], B0[2][2], B1[2][2];
    const char* cA = (const char*)g.A + (size_t)cur.pm * tstep; const char* cB = (const char*)g.Bt + (size_t)cur.pn * tstep;
    S.a_ready(cur);
    if constexpr (SP2) {
        PG8_STAGE(PG8_SB(0, 0), cB, voffB); PG8_STAGE(PG8_SB(0, 1), cB + hstep, voffB); PG8_STAGE(PG8_SA(0, 0), cA, voffA); PG8_STAGE(PG8_SA(0, 1), cA + hstep, voffA);
        if (wr == 1) PG8_BAR;
        PG8_WAIT_V(2); PG8_BAR;
        PG8_STAGE(PG8_SB(1, 0), cB + kstep, voffB); PG8_STAGE(PG8_SA(1, 0), cA + kstep, voffA); PG8_STAGE(PG8_SB(1, 1), cB + hstep + kstep, voffB);
        PG8_WAIT_V(6); PG8_BAR;
    } else {
        PG8_STAGE(PG8_SB(0, 0), cB, voffB); PG8_STAGE(PG8_SA(0, 0), cA, voffA); PG8_STAGE(PG8_SB(0, 1), cB + hstep, voffB); PG8_STAGE(PG8_SA(0, 1), cA + hstep, voffA);
        if (wr == 1) PG8_BAR;
        PG8_WAIT_V(4); PG8_BAR;
        PG8_STAGE(PG8_SB(1, 0), cB + kstep, voffB); PG8_STAGE(PG8_SA(1, 0), cA + kstep, voffA); PG8_STAGE(PG8_SB(1, 1), cB + hstep + kstep, voffB);
        PG8_WAIT_V(6); PG8_BAR;
    }
    for (;;) {
        const bool has_next = S.next(ui + 1, nxt);
        const char* nA = has_next ? (const char*)g.A + (size_t)nxt.pm * tstep : cA; const char* nB = has_next ? (const char*)g.Bt + (size_t)nxt.pn * tstep : cB;
        for (int t = 0; t < nt; t += 2) {
            const bool last = (t == nt - 2);
            const char* a1 = cA + (size_t)(t + 1) * kstep;
            const char* a2 = last ? nA : cA + (size_t)(t + 2) * kstep; const char* b2 = last ? nB : cB + (size_t)(t + 2) * kstep;
            const char* a3 = a2 + kstep; const char* b3 = b2 + kstep;
            if (last && has_next) S.a_ready(nxt);
            if constexpr (SP2) {
            PG8_LDB(B0, 0, 0); PG8_LDB(B1, 0, 1); PG8_SCHED; PG8_LDA(At, 0, 0); PG8_STAGE(PG8_SA(1, 1), a1 + hstep, voffA);
            PG8_WAIT_V(8); PG8_WAIT_L(0); PG8_BAR; PG8_MMA(0, 0, At, B0); PG8_MMA(0, 1, At, B1); PG8_BAR; PG8_SCHED;
            PG8_LDA(At, 0, 1); PG8_STAGE(PG8_SB(0, 0), b2, voffB); PG8_STAGE(PG8_SB(0, 1), b2 + hstep, voffB); PG8_STAGE(PG8_SA(0, 0), a2, voffA);
            PG8_WAIT_V(8); PG8_WAIT_L(0); PG8_BAR; PG8_MMA(1, 0, At, B0); PG8_MMA(1, 1, At, B1); PG8_BAR; PG8_SCHED;
            PG8_LDB(B0, 1, 0); PG8_LDB(B1, 1, 1); PG8_SCHED; PG8_LDA(At, 1, 0); PG8_STAGE(PG8_SA(0, 1), a2 + hstep, voffA);
            PG8_WAIT_V(8); PG8_WAIT_L(0); PG8_BAR; PG8_MMA(0, 0, At, B0); PG8_MMA(0, 1, At, B1); PG8_BAR; PG8_SCHED;
            PG8_LDA(At, 1, 1); PG8_STAGE(PG8_SB(1, 0), b3, voffB); PG8_STAGE(PG8_SB(1, 1), b3 + hstep, voffB); PG8_STAGE(PG8_SA(1, 0), a3, voffA);
            PG8_WAIT_V(8); PG8_WAIT_L(0); PG8_BAR; PG8_MMA(1, 0, At, B0); PG8_MMA(1, 1, At, B1); PG8_BAR; PG8_SCHED;
            } else {
            PG8_LDB(B0, 0, 0); PG8_SCHED; PG8_LDA(At, 0, 0); PG8_STAGE(PG8_SA(1, 1), a1 + hstep, voffA);
            PG8_WAIT_L(8); PG8_BAR; PG8_WAIT_L(0); PG8_MMA(0, 0, At, B0); PG8_BAR; PG8_SCHED;
            PG8_LDB(B1, 0, 1); PG8_STAGE(PG8_SB(0, 0), b2, voffB);
            PG8_BAR; PG8_WAIT_L(0); PG8_MMA(0, 1, At, B1); PG8_BAR;
            PG8_LDA(At, 0, 1); PG8_STAGE(PG8_SA(0, 0), a2, voffA);
            PG8_BAR; PG8_WAIT_L(0); PG8_MMA(1, 0, At, B0); PG8_BAR; PG8_SCHED;
            PG8_STAGE(PG8_SB(0, 1), b2 + hstep, voffB);
            PG8_WAIT_V(6); PG8_BAR; PG8_MMA(1, 1, At, B1); PG8_BAR;
            PG8_LDB(B0, 1, 0); PG8_SCHED; PG8_LDA(At, 1, 0); PG8_STAGE(PG8_SA(0, 1), a2 + hstep, voffA);
            PG8_WAIT_L(8); PG8_BAR; PG8_WAIT_L(0); PG8_MMA(0, 0, At, B0); PG8_BAR; PG8_SCHED;
            PG8_LDB(B1, 1, 1); PG8_STAGE(PG8_SB(1, 0), b3, voffB);
            PG8_BAR; PG8_WAIT_L(0); PG8_MMA(0, 1, At, B1); PG8_BAR;
            PG8_LDA(At, 1, 1); PG8_STAGE(PG8_SA(1, 0), a3, voffA);
            PG8_BAR; PG8_WAIT_L(0); PG8_MMA(1, 0, At, B0); PG8_BAR; PG8_SCHED;
            PG8_STAGE(PG8_SB(1, 1), b3 + hstep, voffB);
            PG8_WAIT_V(6); PG8_BAR; PG8_MMA(1, 1, At, B1); PG8_BAR;
            }
        }
        if constexpr (ALIGN_EPI) { if (wr == 0) PG8_BAR; }
        if constexpr (!Epi::AFTER_DRAIN) { E(acc, cur, wr, wc, fr, fq); S.done(cur); }
        if (!has_next) break;
#pragma unroll
        for (int a = 0; a < 2; ++a)
#pragma unroll
            for (int b = 0; b < 2; ++b)
#pragma unroll
                for (int m = 0; m < 4; ++m)
#pragma unroll
                    for (int n = 0; n < 2; ++n) acc[a][b][m][n] = (f32x4){0.f, 0.f, 0.f, 0.f};
        cur = nxt; cA = nA; cB = nB; ++ui;
        if constexpr (ALIGN_EPI) { if (wr == 1) PG8_BAR; }
    }
    PG8_WAIT_V(0);
    if constexpr (!ALIGN_EPI) { if (wr == 0) PG8_BAR; }
    PG8_BAR;
    if constexpr (Epi::AFTER_DRAIN) { E.fused(acc, cur, wr, wc, fr, fq, lds, wid, lane); S.done(cur); }
#undef PG8_SA
#undef PG8_SB
#undef PG8_STAGE
#undef PG8_LDA
#undef PG8_LDB
#undef PG8_MMA
#undef PG8_WAIT_V
#undef PG8_WAIT_L
#undef PG8_BAR
#undef PG8_SCHED
}
}

#define LAS __attribute__((address_space(3)))
typedef unsigned short bf16;
typedef pg8::f32x4 f32x4;
typedef pg8::u32x4 u32x4;
typedef unsigned u32x2 __attribute__((ext_vector_type(2)));
typedef float f32x2_t __attribute__((ext_vector_type(2))); typedef __bf16 bf16x2_t __attribute__((ext_vector_type(2)));
__device__ __forceinline__ unsigned cvt_pk_bf16(float lo, float hi) { f32x2_t v = {lo, hi}; bf16x2_t r = __builtin_convertvector(v, bf16x2_t); return __builtin_bit_cast(unsigned, r); }
constexpr int D = 1024, BATCH = 4, SEQ = 4096, M = BATCH * SEQ, FF = 4096, DEPTH = 4;
constexpr int NWAVES = 8, NTHREADS = 512;
constexpr float RMS_EPS = 1e-6f;
constexpr size_t MiB = 1u << 20;
constexpr size_t WS_SSQ = 0;
constexpr size_t WS_BAR = 1 * MiB;
constexpr size_t WS_HB = 2 * MiB;
constexpr size_t WS_WB0 = 34 * MiB, WS_WB1 = 66 * MiB;
constexpr size_t WS_R = 98 * MiB;
constexpr size_t WS_SC = 226 * MiB;
constexpr size_t WS_SSQO = 242 * MiB;
constexpr size_t WS_END = 246 * MiB;
constexpr size_t WB_IN = 0, WB_O = 12 * MiB, WB_UP = 16 * MiB, WB_DOWN = 24 * MiB;
constexpr size_t R_O = 96 * MiB;
constexpr size_t R_V = 64 * MiB;
constexpr int LDS_BYTES = 147456;

__device__ __forceinline__ float bflo(unsigned u) { return __uint_as_float(u << 16); }
__device__ __forceinline__ float bfhi(unsigned u) { return __uint_as_float(u & 0xffff0000u); }
__device__ __forceinline__ float wave_sum(float v) {
#pragma unroll
    for (int o = 1; o < 64; o <<= 1) v += __shfl_xor(v, o);
    return v;
}
__device__ __forceinline__ float row_rs(const float* ssq, int row) {
    const f32x4* p = (const f32x4*)(ssq + (size_t)row * 16);
    const f32x4 a = p[0], b = p[1], c = p[2], d = p[3];
    const float s = (((a[0] + a[1]) + (a[2] + a[3])) + ((b[0] + b[1]) + (b[2] + b[3]))) + (((c[0] + c[1]) + (c[2] + c[3])) + ((d[0] + d[1]) + (d[2] + d[3])));
    return rsqrtf(s * (1.f / 1024.f) + RMS_EPS);
}

template <int ACT> struct EpiRowScale {
    static constexpr bool PERM = true, AFTER_DRAIN = false;
    bf16* O; int ldc; const float* ssq; int split_cols; size_t split_stride;
    const LAS float* tab; int k0, k1, k2, k3;
    __device__ __forceinline__ void operator()(const f32x4 (&acc)[2][2][4][2], const pg8::Unit& u, int wr, int wc, int fr, int fq) const {
        const int row0 = u.pm * 256 + wr * 64 + fr; int colt = u.pn * 256; bf16* base = O;
        if (split_cols) { const int t = colt / split_cols; base += (size_t)t * split_stride; colt -= t * split_cols; }
        const int col0 = colt + wc * 32 + 8 * fq;
        const int slot = (u.pm == k0) ? 0 : (u.pm == k1) ? 1 : (u.pm == k2) ? 2 : (u.pm == k3) ? 3 : -1;
#pragma unroll
        for (int ai = 0; ai < 2; ++ai)
#pragma unroll
            for (int m = 0; m < 4; ++m) {
                const int row = row0 + ai * 128 + m * 16; const float rs = slot >= 0 ? tab[slot * 256 + wr * 64 + fr + ai * 128 + m * 16] : row_rs(ssq, row);
                bf16* rowp = base + (size_t)row * ldc + col0;
#pragma unroll
                for (int bj = 0; bj < 2; ++bj) {
                    f32x4 v0 = acc[ai][bj][m][0] * rs, v1 = acc[ai][bj][m][1] * rs;
                    if (ACT == 1) {
#pragma unroll
                        for (int e = 0; e < 4; ++e) { float a = fmaxf(v0[e], 0.f), b = fmaxf(v1[e], 0.f); v0[e] = a * a; v1[e] = b * b; }
                    }
                    u32x4 w; w.x = cvt_pk_bf16(v0[0], v0[1]); w.y = cvt_pk_bf16(v0[2], v0[3]); w.z = cvt_pk_bf16(v1[0], v1[1]); w.w = cvt_pk_bf16(v1[2], v1[3]);
                    *(u32x4*)(rowp + bj * 128) = w;
                }
            }
    }
};
template <bool BASE_F32> struct EpiRes {
    static constexpr bool PERM = true, AFTER_DRAIN = false;
    const float* xbase; bf16* hb; float* ssq;
    __device__ __forceinline__ void operator()(const f32x4 (&acc)[2][2][4][2], const pg8::Unit& u, int wr, int wc, int fr, int fq) const {
        const int col0 = u.pn * 256 + wc * 32 + 8 * fq;
#pragma unroll
        for (int ai = 0; ai < 2; ++ai)
#pragma unroll
            for (int m = 0; m < 4; ++m) {
                const int row = u.pm * 256 + ai * 128 + wr * 64 + m * 16 + fr; const size_t off = (size_t)row * D + col0; float s = 0.f;
#pragma unroll
                for (int bj = 0; bj < 2; ++bj) {
                    const size_t o = off + bj * 128;
                    f32x4 v0, v1;
                    if (BASE_F32) { v0 = *(const f32x4*)(xbase + o); v1 = *(const f32x4*)(xbase + o + 4); }
                    else { const u32x4 hv = *(const u32x4*)(hb + o); v0 = (f32x4){bflo(hv.x), bfhi(hv.x), bflo(hv.y), bfhi(hv.y)}; v1 = (f32x4){bflo(hv.z), bfhi(hv.z), bflo(hv.w), bfhi(hv.w)}; }
                    v0 = v0 + acc[ai][bj][m][0]; v1 = v1 + acc[ai][bj][m][1];
                    s += ((v0[0] * v0[0] + v0[1] * v0[1]) + (v0[2] * v0[2] + v0[3] * v0[3])) + ((v1[0] * v1[0] + v1[1] * v1[1]) + (v1[2] * v1[2] + v1[3] * v1[3]));
                    u32x4 w; w.x = cvt_pk_bf16(v0[0], v0[1]); w.y = cvt_pk_bf16(v0[2], v0[3]); w.z = cvt_pk_bf16(v1[0], v1[1]); w.w = cvt_pk_bf16(v1[2], v1[3]);
                    *(u32x4*)(hb + o) = w;
                }
                s += __shfl_xor(s, 16); s += __shfl_xor(s, 32);
                if (fq == 0) ssq[(size_t)row * 16 + u.pn * 4 + wc] = s;
            }
    }
};
struct EpiGate {
    static constexpr bool PERM = true, AFTER_DRAIN = false;
    bf16* Y; const bf16* Oin; const float* ssq; const float* rmso;
    __device__ __forceinline__ void operator()(const f32x4 (&acc)[2][2][4][2], const pg8::Unit& u, int wr, int wc, int fr, int fq) const {
        const int row0 = u.pm * 256 + wr * 64 + fr; const int col0 = u.pn * 256 + wc * 32 + 8 * fq;
#pragma unroll
        for (int ai = 0; ai < 2; ++ai)
#pragma unroll
            for (int m = 0; m < 4; ++m) {
                const int row = row0 + ai * 128 + m * 16; const float rs = row_rs(ssq, row);
                float ro; { const f32x4* p = (const f32x4*)(rmso + ((size_t)row * 4 + (u.pn >> 1)) * 16); const f32x4 a = p[0], b = p[1], c = p[2], d = p[3];
                    const float s = (((a[0] + a[1]) + (a[2] + a[3])) + ((b[0] + b[1]) + (b[2] + b[3]))) + (((c[0] + c[1]) + (c[2] + c[3])) + ((d[0] + d[1]) + (d[2] + d[3]))); ro = rsqrtf(s * (1.f / 512.f) + RMS_EPS); }
#pragma unroll
                for (int bj = 0; bj < 2; ++bj) {
                    const int c = col0 + bj * 128;
                    const u32x4 ov = *(const u32x4*)(Oin + (size_t)row * 2048 + c);
                    float o8[8] = {bflo(ov.x), bfhi(ov.x), bflo(ov.y), bfhi(ov.y), bflo(ov.z), bfhi(ov.z), bflo(ov.w), bfhi(ov.w)};
                    float y8[8];
#pragma unroll
                    for (int e = 0; e < 8; ++e) { const float g = (e < 4 ? acc[ai][bj][m][0][e & 3] : acc[ai][bj][m][1][e & 3]) * rs; const float sg = g / (1.f + __expf(-g)); y8[e] = sg * o8[e] * ro; }
                    u32x4 w; w.x = cvt_pk_bf16(y8[0], y8[1]); w.y = cvt_pk_bf16(y8[2], y8[3]); w.z = cvt_pk_bf16(y8[4], y8[5]); w.w = cvt_pk_bf16(y8[6], y8[7]);
                    *(u32x4*)(Y + (size_t)row * 2048 + c) = w;
                }
            }
    }
};

struct Args { const float* in[13]; float* out; unsigned char* ws; };

struct CvItem { const float* src; bf16* dst; const float* gain; float cs; int N, K; };
__device__ __forceinline__ void cv_load(const CvItem& d, float (&r)[32]) {
#pragma unroll
    for (int i = 0; i < 32; ++i) r[i] = __builtin_nontemporal_load(d.src + (size_t)(2 * i) * d.N);
}
__device__ __forceinline__ void cv_store(const CvItem& d, const float (&r)[32], LAS float* scr, int lane) {
#pragma unroll
    for (int i = 0; i < 32; ++i) scr[(2 * i + (lane >> 5)) * 33 + (lane & 31)] = r[i] * d.cs;
    asm volatile("s_waitcnt lgkmcnt(0)" ::: "memory");
    const int c = lane & 7;
    f32x4 g0 = (f32x4){1.f, 1.f, 1.f, 1.f}, g1 = g0;
    if (d.gain) { g0 = *(const f32x4*)(d.gain + 8 * c); g1 = *(const f32x4*)(d.gain + 8 * c + 4); }
#pragma unroll
    for (int j = 0; j < 4; ++j) { const int nn = (lane >> 3) + 8 * j; const LAS float* s = scr + (8 * c) * 33 + nn;
        u32x4 o; o.x = cvt_pk_bf16(s[0 * 33] * g0[0], s[1 * 33] * g0[1]); o.y = cvt_pk_bf16(s[2 * 33] * g0[2], s[3 * 33] * g0[3]);
        o.z = cvt_pk_bf16(s[4 * 33] * g1[0], s[5 * 33] * g1[1]); o.w = cvt_pk_bf16(s[6 * 33] * g1[2], s[7 * 33] * g1[3]);
        *(u32x4*)(d.dst + (size_t)nn * d.K + 8 * c) = o; }
    asm volatile("s_waitcnt lgkmcnt(0)" ::: "memory");
}
__device__ __forceinline__ void convert_layer(const Args& a, int i, int mask, LAS unsigned char* lds, int gw, int NGW, int wave, int lane) {
    const int kind = i % 3, j = i / 3;
    const float* w_in; int n_in; const float* w_o; int k_o; int sc_lo, sc_hi; float sc;
    if (kind == 0) { w_in = a.in[4] + (size_t)j * D * 1280; n_in = 1280; w_o = a.in[6] + (size_t)j * D * D; k_o = 1024; sc_lo = 0; sc_hi = 1024; sc = 0.125f; }
    else if (kind == 1) { w_in = a.in[7] + (size_t)j * D * 3072; n_in = 3072; w_o = a.in[8] + (size_t)j * D * D; k_o = 1024; sc_lo = 0; sc_hi = 1024; sc = 0.125f * 1.4426950408889634f; }
    else { w_in = a.in[9] + (size_t)j * D * 6144; n_in = 6144; w_o = a.in[10] + (size_t)j * 2048 * D; k_o = 2048; sc_lo = 1024; sc_hi = 2048; sc = 0.0625f; }
    const float* w_up = a.in[11] + (size_t)i * D * FF; const float* w_dn = a.in[12] + (size_t)i * FF * D;
    const float* g_attn = a.in[1] + (size_t)i * D; const float* g_mlp = a.in[2] + (size_t)i * D;
    unsigned char* wb = a.ws + ((i & 1) ? WS_WB1 : WS_WB0);
    LAS float* scr = (LAS float*)(lds + wave * 16384);
    const int I_in = (mask & 1) ? (D / 64) * (n_in / 32) : 0, I_o = (mask & 2) ? (k_o / 64) * (D / 32) : 0, I_up = (mask & 4) ? (D / 64) * (FF / 32) : 0, I_dn = (mask & 8) ? (FF / 64) * (D / 32) : 0;
    const int NITEMS = I_in + I_o + I_up + I_dn;
#define CV_DECODE(dsc, itv) do { int r_ = (itv); const float* W_; int K_, N_; bf16* WT_; const float* gn_; int lo_ = 0, hi_ = 0; \
        if (r_ < I_in) { W_ = w_in; K_ = D; N_ = n_in; WT_ = (bf16*)(wb + WB_IN); gn_ = g_attn; lo_ = sc_lo; hi_ = sc_hi; } \
        else if ((r_ -= I_in) < I_o) { W_ = w_o; K_ = k_o; N_ = D; WT_ = (bf16*)(wb + WB_O); gn_ = nullptr; } \
        else if ((r_ -= I_o) < I_up) { W_ = w_up; K_ = D; N_ = FF; WT_ = (bf16*)(wb + WB_UP); gn_ = g_mlp; } \
        else { r_ -= I_up; W_ = w_dn; K_ = FF; N_ = D; WT_ = (bf16*)(wb + WB_DOWN); gn_ = nullptr; } \
        const int nblk_ = N_ / 32, kb_ = r_ / nblk_, nb_ = r_ % nblk_, k0_ = 64 * kb_, n0_ = 32 * nb_, n_ = n0_ + (lane & 31); \
        (dsc).src = W_ + (size_t)(k0_ + (lane >> 5)) * N_ + n_; (dsc).dst = WT_ + (size_t)n0_ * K_ + k0_; (dsc).gain = gn_ ? gn_ + k0_ : nullptr; \
        (dsc).cs = (n_ >= lo_ && n_ < hi_) ? sc : 1.f; (dsc).N = N_; (dsc).K = K_; } while (0)
    for (int it = gw; it < NITEMS; it += 2 * NGW) {
        CvItem d0, d1; float r0[32], r1[32];
        CV_DECODE(d0, it); cv_load(d0, r0);
        const bool two = it + NGW < NITEMS;
        if (two) { CV_DECODE(d1, it + NGW); cv_load(d1, r1); }
        cv_store(d0, r0, scr, lane);
        if (two) cv_store(d1, r1, scr, lane);
    }
#undef CV_DECODE
}

#define UNPACK8(dst, vv_) do { (dst)[0] = bflo((vv_)[0]); (dst)[1] = bfhi((vv_)[0]); (dst)[2] = bflo((vv_)[1]); (dst)[3] = bfhi((vv_)[1]); (dst)[4] = bflo((vv_)[2]); (dst)[5] = bfhi((vv_)[2]); (dst)[6] = bflo((vv_)[3]); (dst)[7] = bfhi((vv_)[3]); } while (0)
__device__ __forceinline__ void swa_naive(const bf16* qkv, const float* sinks, bf16* o, int gtid, int gthreads) {
    for (int idx = gtid; idx < M * 16; idx += gthreads) {
        const int head = idx & 15, m = idx >> 4, t = m & (SEQ - 1), kv = head >> 3;
        float q[64], acc[64];
        { const u32x4* qp = (const u32x4*)(qkv + (size_t)m * 1280 + head * 64);
#pragma unroll
          for (int c = 0; c < 8; ++c) { const u32x4 w = qp[c]; UNPACK8(q + 8 * c, w); } }
#pragma unroll
        for (int d = 0; d < 64; ++d) acc[d] = 0.f;
        const float slope = exp2f(-0.5f * (float)(head + 1));
        float mr = sinks[head], l = 1.f;
        const int s0 = t - 127 < 0 ? 0 : t - 127;
        for (int s = s0; s <= t; ++s) {
            const bf16* kp = qkv + (size_t)(m - (t - s)) * 1280 + 1024 + kv * 64; const bf16* vp = kp + 128;
            float z = 0.f;
#pragma unroll
            for (int c = 0; c < 8; ++c) { const u32x4 w = ((const u32x4*)kp)[c]; float k8[8]; UNPACK8(k8, w);
#pragma unroll
                for (int e = 0; e < 8; ++e) z += q[8 * c + e] * k8[e]; }
            z -= slope * (float)(t - s);
            const float mn = fmaxf(mr, z), corr = __expf(mr - mn), p = __expf(z - mn);
            l = l * corr + p; mr = mn;
#pragma unroll
            for (int c = 0; c < 8; ++c) { const u32x4 w = ((const u32x4*)vp)[c]; float v8[8]; UNPACK8(v8, w);
#pragma unroll
                for (int e = 0; e < 8; ++e) acc[8 * c + e] = acc[8 * c + e] * corr + p * v8[e]; }
        }
        const float inv = 1.f / l;
        u32x4* op = (u32x4*)(o + (size_t)m * 1024 + head * 64);
#pragma unroll
        for (int c = 0; c < 8; ++c) { u32x4 w; w.x = cvt_pk_bf16(acc[8 * c] * inv, acc[8 * c + 1] * inv); w.y = cvt_pk_bf16(acc[8 * c + 2] * inv, acc[8 * c + 3] * inv);
            w.z = cvt_pk_bf16(acc[8 * c + 4] * inv, acc[8 * c + 5] * inv); w.w = cvt_pk_bf16(acc[8 * c + 6] * inv, acc[8 * c + 7] * inv); op[c] = w; }
    }
}
__device__ __forceinline__ void sb_naive(const bf16* qkv, bf16* o, int gtid, int gthreads) {
    int it = 0; const bool mir = (gthreads % (SEQ * 16)) == 0;
    for (int idx = gtid; idx < M * 16; idx += gthreads, ++it) {
        const int head = idx & 15; int m = idx >> 4; int t = m & (SEQ - 1);
        if (mir && (it & 1)) { t = SEQ - 1 - t; m = (m & ~(SEQ - 1)) + t; }
        float q[64], acc[64];
        { const u32x4* qp = (const u32x4*)(qkv + (size_t)m * 3072 + head * 64);
#pragma unroll
          for (int c = 0; c < 8; ++c) { const u32x4 w = qp[c]; UNPACK8(q + 8 * c, w); } }
#pragma unroll
        for (int d = 0; d < 64; ++d) acc[d] = 0.f;
        float carry = 0.f;
        for (int s = t - 1; s >= 0; --s) {
            const bf16* kp = qkv + (size_t)(m - (t - s)) * 3072 + 1024 + head * 64; const bf16* vp = kp + 1024;
            float z = 0.f;
#pragma unroll
            for (int c = 0; c < 8; ++c) { const u32x4 w = ((const u32x4*)kp)[c]; float k8[8]; UNPACK8(k8, w);
#pragma unroll
                for (int e = 0; e < 8; ++e) z += q[8 * c + e] * k8[e]; }
            const float sp = fmaxf(z, 0.f) + __logf(1.f + __expf(-fabsf(z)));
            const float p = __expf(z - sp + carry);
            carry -= sp;
#pragma unroll
            for (int c = 0; c < 8; ++c) { const u32x4 w = ((const u32x4*)vp)[c]; float v8[8]; UNPACK8(v8, w);
#pragma unroll
                for (int e = 0; e < 8; ++e) acc[8 * c + e] += p * v8[e]; }
        }
        u32x4* op = (u32x4*)(o + (size_t)m * 1024 + head * 64);
#pragma unroll
        for (int c = 0; c < 8; ++c) { u32x4 w; w.x = cvt_pk_bf16(acc[8 * c], acc[8 * c + 1]); w.y = cvt_pk_bf16(acc[8 * c + 2], acc[8 * c + 3]);
            w.z = cvt_pk_bf16(acc[8 * c + 4], acc[8 * c + 5]); w.w = cvt_pk_bf16(acc[8 * c + 6], acc[8 * c + 7]); op[c] = w; }
    }
}
__device__ __forceinline__ void ret_naive(const bf16* qk, bf16* vo, int gtid, int gthreads) {
    for (int idx = gtid; idx < 16 * 512 * 16; idx += gthreads) {
        const int dqi = idx & 15, e = (idx >> 4) & 511, bh = idx >> 13, b = bh >> 2, h = bh & 3;
        const float gamma = 1.f - exp2f(-5.f - (float)h);
        float S[16];
#pragma unroll
        for (int j = 0; j < 16; ++j) S[j] = 0.f;
        for (int t = 0; t < SEQ; ++t) {
            const size_t row = (size_t)b * SEQ + t;
            const u32x4* qp = (const u32x4*)(qk + row * 2048 + h * 256 + dqi * 16);
            const u32x4* kp = (const u32x4*)(qk + row * 2048 + 1024 + h * 256 + dqi * 16);
            bf16* vp = vo + row * 2048 + h * 512 + e;
            const float v = __uint_as_float((unsigned)(*vp) << 16);
            float q16[16], k16[16];
            { const u32x4 w0 = qp[0], w1 = qp[1]; UNPACK8(q16, w0); UNPACK8(q16 + 8, w1); }
            { const u32x4 w0 = kp[0], w1 = kp[1]; UNPACK8(k16, w0); UNPACK8(k16 + 8, w1); }
            float part = 0.f;
#pragma unroll
            for (int j = 0; j < 16; ++j) { S[j] = gamma * S[j] + k16[j] * v; part += q16[j] * S[j]; }
            part += __shfl_xor(part, 1); part += __shfl_xor(part, 2); part += __shfl_xor(part, 4); part += __shfl_xor(part, 8);
            if (dqi == 0) *vp = (bf16)(cvt_pk_bf16(part, 0.f) & 0xffffu);
        }
    }
}

typedef short bf16x8 __attribute__((ext_vector_type(8)));
typedef short s16x4 __attribute__((ext_vector_type(4)));
typedef float f32x16 __attribute__((ext_vector_type(16)));
#define MFMA32(a, b, c) __builtin_amdgcn_mfma_f32_32x32x16_bf16((a), (b), (c), 0, 0, 0)
__device__ __forceinline__ s16x4 tr16(const LAS unsigned char* p) { return __builtin_bit_cast(s16x4, __builtin_amdgcn_ds_read_tr16_b64_v4i16((LAS s16x4*)p)); }
__device__ __forceinline__ bf16x8 pack8(const float* a) {
    u32x4 w; w.x = cvt_pk_bf16(a[0], a[1]); w.y = cvt_pk_bf16(a[2], a[3]); w.z = cvt_pk_bf16(a[4], a[5]); w.w = cvt_pk_bf16(a[6], a[7]);
    return __builtin_bit_cast(bf16x8, w);
}
constexpr int SB_ROW = 144, SB_TILE = 64 * SB_ROW;
__device__ __forceinline__ void sb_phase(const bf16* qkv, bf16* o, LAS unsigned char* lds, int vcu, int G, int tid) {
    const int lane = tid & 63, wave = __builtin_amdgcn_readfirstlane(tid >> 6), r32 = lane & 31, hi = lane >> 5;
    const int srow = tid >> 3, sch = tid & 7;
    const int i16 = lane & 15, tq = i16 >> 2, tp = i16 & 3, blk = (lane >> 4) & 1;
    const int vtr_off = (4 * hi + tq) * SB_ROW + (16 * blk + 4 * tp) * 2;
    LAS unsigned* flg = (LAS unsigned*)(lds + 4 * SB_TILE);
    for (int P = vcu; P < 512; P += G) {
        const int bh = P >> 3, jj = P & 7, b = bh >> 4, h = bh & 15;
        for (int half = 0; half < 2; ++half) {
            const int jq = half ? 15 - jj : jj;
            const size_t mb = (size_t)b * SEQ;
            const bf16* kbase = qkv + mb * 3072 + 1024 + h * 64; const bf16* vbase = kbase + 1024;
            const int tq0 = 256 * jq + 32 * wave;
            bf16x8 qf[4];
            { const bf16* qp = qkv + (mb + tq0 + r32) * 3072 + h * 64 + 8 * hi;
#pragma unroll
              for (int d0 = 0; d0 < 4; ++d0) qf[d0] = *(const bf16x8*)(qp + 16 * d0); }
            f32x16 o0, o1;
#pragma unroll
            for (int r = 0; r < 16; ++r) { o0[r] = 0.f; o1[r] = 0.f; }
            float carry = 0.f; bool mydone = false;
            const int nst = 4 * jq + 4;
            { const size_t roff = (size_t)(64 * (nst - 1) + srow) * 3072 + sch * 8;
              const u32x4 kk = *(const u32x4*)(kbase + roff), vv = *(const u32x4*)(vbase + roff);
              *(LAS u32x4*)(lds + srow * SB_ROW + sch * 16) = kk; *(LAS u32x4*)(lds + 2 * SB_TILE + srow * SB_ROW + sch * 16) = vv; }
            __syncthreads();
            for (int st = nst - 1, it = 0; st >= 0; --st, ++it) {
                const int cb = it & 1;
                const LAS unsigned char* Kb = lds + cb * SB_TILE; const LAS unsigned char* Vb = lds + 2 * SB_TILE + cb * SB_TILE;
                u32x4 kk, vv;
                if (st > 0) { const size_t roff = (size_t)(64 * (st - 1) + srow) * 3072 + sch * 8; kk = *(const u32x4*)(kbase + roff); vv = *(const u32x4*)(vbase + roff); }
                if (64 * st < tq0 + 32 && !mydone) {
                    const bool diag = (64 * st + 63 >= tq0);
#pragma unroll
                    for (int sub = 1; sub >= 0; --sub) {
                        f32x16 p;
#pragma unroll
                        for (int r = 0; r < 16; ++r) p[r] = 0.f;
                        const LAS unsigned char* kp = Kb + (32 * sub + r32) * SB_ROW + 16 * hi;
#pragma unroll
                        for (int d0 = 0; d0 < 4; ++d0) p = MFMA32(*(const LAS bf16x8*)(kp + 32 * d0), qf[d0], p);
                        float l[16]; const int sg0 = 64 * st + 32 * sub + 4 * hi, tg = tq0 + r32;
#pragma unroll
                        for (int r = 0; r < 16; ++r) {
                            const float z = p[r]; const float e = __builtin_amdgcn_exp2f(z); float lg = __builtin_amdgcn_logf(1.f + e); lg = z > 32.f ? z : lg;
                            const bool valid = !diag || (sg0 + (r & 3) + 8 * (r >> 2) < tg);
                            l[r] = valid ? -lg : 0.f;
                        }
                        float gs[4], ot[4], ps[4];
#pragma unroll
                        for (int g = 0; g < 4; ++g) { gs[g] = (l[4 * g] + l[4 * g + 1]) + (l[4 * g + 2] + l[4 * g + 3]); ot[g] = __shfl_xor(gs[g], 32); ps[g] = gs[g] + ot[g]; }
                        float T[4]; T[3] = 0.f; T[2] = ps[3]; T[1] = ps[3] + ps[2]; T[0] = T[1] + ps[1];
                        const float total = T[0] + ps[0];
                        float A[16];
#pragma unroll
                        for (int g = 0; g < 4; ++g) {
                            const float base = carry + T[g] + (hi == 0 ? ot[g] : 0.f);
                            const float i3 = base + l[4 * g + 3], i2 = i3 + l[4 * g + 2], i1 = i2 + l[4 * g + 1], i0 = i1 + l[4 * g];
                            A[4 * g + 3] = __builtin_amdgcn_exp2f(p[4 * g + 3] + i3); A[4 * g + 2] = __builtin_amdgcn_exp2f(p[4 * g + 2] + i2);
                            A[4 * g + 1] = __builtin_amdgcn_exp2f(p[4 * g + 1] + i1); A[4 * g] = __builtin_amdgcn_exp2f(p[4 * g] + i0);
                        }
                        if (diag) {
#pragma unroll
                            for (int r = 0; r < 16; ++r) A[r] = (sg0 + (r & 3) + 8 * (r >> 2) < tg) ? A[r] : 0.f;
                        }
                        carry += total;
                        const bf16x8 pf0 = pack8(A), pf1 = pack8(A + 8);
#pragma unroll
                        for (int s = 0; s < 2; ++s) {
                            const LAS unsigned char* vp = Vb + (32 * sub + 16 * s) * SB_ROW + vtr_off;
                            const s16x4 a0 = tr16(vp), a1 = tr16(vp + 8 * SB_ROW), b0 = tr16(vp + 64), b1 = tr16(vp + 64 + 8 * SB_ROW);
                            const bf16x8 vf0 = __builtin_shufflevector(a0, a1, 0, 1, 2, 3, 4, 5, 6, 7), vf1 = __builtin_shufflevector(b0, b1, 0, 1, 2, 3, 4, 5, 6, 7);
                            o0 = MFMA32(vf0, s ? pf1 : pf0, o0); o1 = MFMA32(vf1, s ? pf1 : pf0, o1);
                        }
                    }
                }
                if (64 * st < tq0 + 32) mydone = __all(carry <= -150.f);
                if (lane == 0) flg[(it & 1) * 8 + wave] = mydone ? 1u : 0u;
                if (st > 0) { LAS unsigned char* Kn = lds + (cb ^ 1) * SB_TILE; *(LAS u32x4*)(Kn + srow * SB_ROW + sch * 16) = kk; *(LAS u32x4*)(Kn + 2 * SB_TILE + srow * SB_ROW + sch * 16) = vv; }
                __syncthreads();
                { const u32x4 f0 = *(const LAS u32x4*)(flg + (it & 1) * 8), f1 = *(const LAS u32x4*)(flg + (it & 1) * 8 + 4);
                  if ((f0.x & f0.y & f0.z & f0.w & f1.x & f1.y & f1.z & f1.w) != 0u) break; }
            }
            bf16* op = o + (mb + tq0 + r32) * 1024 + h * 64 + 4 * hi;
#pragma unroll
            for (int g = 0; g < 4; ++g) {
                u32x2 w0, w1; w0.x = cvt_pk_bf16(o0[4 * g], o0[4 * g + 1]); w0.y = cvt_pk_bf16(o0[4 * g + 2], o0[4 * g + 3]);
                w1.x = cvt_pk_bf16(o1[4 * g], o1[4 * g + 1]); w1.y = cvt_pk_bf16(o1[4 * g + 2], o1[4 * g + 3]);
                *(u32x2*)(op + 8 * g) = w0; *(u32x2*)(op + 32 + 8 * g) = w1;
            }
        }
    }
}

constexpr int SBW_SLAB = 2 * 32 * SB_ROW;
__device__ __forceinline__ void sb_phase_w(const bf16* qkv, bf16* o, LAS unsigned char* lds, int vcu, int G, int tid) {
    const int lane = tid & 63, wave = __builtin_amdgcn_readfirstlane(tid >> 6), r32 = lane & 31, hi = lane >> 5;
    const int i16 = lane & 15, tq = i16 >> 2, tp = i16 & 3, blk = (lane >> 4) & 1;
    const int vtr_off = (4 * hi + tq) * SB_ROW + (16 * blk + 4 * tp) * 2;
    LAS unsigned char* Ks = lds + wave * SBW_SLAB; LAS unsigned char* Vs = Ks + 32 * SB_ROW;
    const int srow = lane >> 3, sch = lane & 7;
    for (int T = vcu * NWAVES + wave; T < 64 * 128; T += G * NWAVES) {
        const int bh = T >> 7, qb = T & 127, b = bh >> 4, h = bh & 15;
        const size_t mb = (size_t)b * SEQ;
        const bf16* kbase = qkv + mb * 3072 + 1024 + h * 64 + (size_t)srow * 3072 + sch * 8; const bf16* vbase = kbase + 1024;
        const int tg = 32 * qb + r32;
        bf16x8 qf[4];
        { const bf16* qp = qkv + (mb + tg) * 3072 + h * 64 + 8 * hi;
#pragma unroll
          for (int d0 = 0; d0 < 4; ++d0) qf[d0] = *(const bf16x8*)(qp + 16 * d0); }
        f32x16 o0, o1;
#pragma unroll
        for (int r = 0; r < 16; ++r) { o0[r] = 0.f; o1[r] = 0.f; }
        float carry = 0.f;
        u32x4 kreg[4], vreg[4];
#pragma unroll
        for (int c = 0; c < 4; ++c) { const size_t ro = (size_t)(32 * qb + 8 * c) * 3072; kreg[c] = *(const u32x4*)(kbase + ro); vreg[c] = *(const u32x4*)(vbase + ro); }
        for (int t = qb; t >= 0; --t) {
#pragma unroll
            for (int c = 0; c < 4; ++c) { *(LAS u32x4*)(Ks + (srow + 8 * c) * SB_ROW + sch * 16) = kreg[c]; *(LAS u32x4*)(Vs + (srow + 8 * c) * SB_ROW + sch * 16) = vreg[c]; }
            if (t > 0) {
#pragma unroll
                for (int c = 0; c < 4; ++c) { const size_t ro = (size_t)(32 * (t - 1) + 8 * c) * 3072; kreg[c] = *(const u32x4*)(kbase + ro); vreg[c] = *(const u32x4*)(vbase + ro); }
            }
            const bool diag = (t == qb);
            f32x16 p;
#pragma unroll
            for (int r = 0; r < 16; ++r) p[r] = 0.f;
            const LAS unsigned char* kp = Ks + r32 * SB_ROW + 16 * hi;
#pragma unroll
            for (int d0 = 0; d0 < 4; ++d0) p = MFMA32(*(const LAS bf16x8*)(kp + 32 * d0), qf[d0], p);
            float l[16]; const int sg0 = 32 * t + 4 * hi;
#pragma unroll
            for (int r = 0; r < 16; ++r) {
                const float z = p[r]; const float e = __builtin_amdgcn_exp2f(z); float lg = __builtin_amdgcn_logf(1.f + e); lg = z > 32.f ? z : lg;
                const bool valid = !diag || (sg0 + (r & 3) + 8 * (r >> 2) < tg);
                l[r] = valid ? -lg : 0.f;
            }
            float gs[4], ot[4], ps[4];
#pragma unroll
            for (int g = 0; g < 4; ++g) { gs[g] = (l[4 * g] + l[4 * g + 1]) + (l[4 * g + 2] + l[4 * g + 3]); ot[g] = __shfl_xor(gs[g], 32); ps[g] = gs[g] + ot[g]; }
            float Tt[4]; Tt[3] = 0.f; Tt[2] = ps[3]; Tt[1] = ps[3] + ps[2]; Tt[0] = Tt[1] + ps[1];
            const float total = Tt[0] + ps[0];
            float A[16];
#pragma unroll
            for (int g = 0; g < 4; ++g) {
                const float base = carry + Tt[g] + (hi == 0 ? ot[g] : 0.f);
                const float i3 = base + l[4 * g + 3], i2 = i3 + l[4 * g + 2], i1 = i2 + l[4 * g + 1], i0 = i1 + l[4 * g];
                A[4 * g + 3] = __builtin_amdgcn_exp2f(p[4 * g + 3] + i3); A[4 * g + 2] = __builtin_amdgcn_exp2f(p[4 * g + 2] + i2);
                A[4 * g + 1] = __builtin_amdgcn_exp2f(p[4 * g + 1] + i1); A[4 * g] = __builtin_amdgcn_exp2f(p[4 * g] + i0);
            }
            if (diag) {
#pragma unroll
                for (int r = 0; r < 16; ++r) A[r] = (sg0 + (r & 3) + 8 * (r >> 2) < tg) ? A[r] : 0.f;
            }
            carry += total;
            const bf16x8 pf0 = pack8(A), pf1 = pack8(A + 8);
#pragma unroll
            for (int s = 0; s < 2; ++s) {
                const LAS unsigned char* vp = Vs + 16 * s * SB_ROW + vtr_off;
                const s16x4 a0 = tr16(vp), a1 = tr16(vp + 8 * SB_ROW), b0 = tr16(vp + 64), b1 = tr16(vp + 64 + 8 * SB_ROW);
                const bf16x8 vf0 = __builtin_shufflevector(a0, a1, 0, 1, 2, 3, 4, 5, 6, 7), vf1 = __builtin_shufflevector(b0, b1, 0, 1, 2, 3, 4, 5, 6, 7);
                o0 = MFMA32(vf0, s ? pf1 : pf0, o0); o1 = MFMA32(vf1, s ? pf1 : pf0, o1);
            }
            if (__all(carry <= -150.f)) break;
        }
        bf16* op = o + (mb + tg) * 1024 + h * 64 + 4 * hi;
#pragma unroll
        for (int g = 0; g < 4; ++g) {
            u32x2 w0, w1; w0.x = cvt_pk_bf16(o0[4 * g], o0[4 * g + 1]); w0.y = cvt_pk_bf16(o0[4 * g + 2], o0[4 * g + 3]);
            w1.x = cvt_pk_bf16(o1[4 * g], o1[4 * g + 1]); w1.y = cvt_pk_bf16(o1[4 * g + 2], o1[4 * g + 3]);
            *(u32x2*)(op + 8 * g) = w0; *(u32x2*)(op + 32 + 8 * g) = w1;
        }
    }
}

__device__ __forceinline__ void swa_phase(const bf16* qkv, const float* sinks, bf16* o, LAS unsigned char* lds, int vcu, int G, int tid) {
    const int lane = tid & 63, wave = __builtin_amdgcn_readfirstlane(tid >> 6), r32 = lane & 31, hi = lane >> 5;
    const int i16 = lane & 15, tq = i16 >> 2, tp = i16 & 3, blk = (lane >> 4) & 1;
    const int vtr_off = (4 * hi + tq) * SB_ROW + (16 * blk + 4 * tp) * 2;
    LAS unsigned char* Kb = lds; LAS unsigned char* Vb = lds + 256 * SB_ROW;
    for (int u = vcu; u < 256; u += G) {
        const int kv = u & 1, n = (u >> 1) & 31, b = u >> 6;
        const int head = kv * 8 + wave;
        const float slope = exp2f(-0.5f * (float)(head + 1)), sink = sinks[head];
        __syncthreads();
#pragma unroll
        for (int c4 = 0; c4 < 4; ++c4) {
            const int idx = tid + NTHREADS * c4, kr = idx >> 3, ch = idx & 7;
            u32x4 kk = (u32x4){0u, 0u, 0u, 0u}, vv = kk;
            if (n > 0 || kr >= 128) { const bf16* p = qkv + ((size_t)b * SEQ + 128 * (n - 1) + kr) * 1280 + 1024 + kv * 64 + ch * 8; kk = *(const u32x4*)p; vv = *(const u32x4*)(p + 128); }
            *(LAS u32x4*)(Kb + kr * SB_ROW + ch * 16) = kk; *(LAS u32x4*)(Vb + kr * SB_ROW + ch * 16) = vv;
        }
        __syncthreads();
        for (int sb = 0; sb < 4; ++sb) {
            const size_t qrow = (size_t)b * SEQ + 128 * n + 32 * sb + r32;
            bf16x8 qf[4];
            { const bf16* qp = qkv + qrow * 1280 + head * 64 + 8 * hi;
#pragma unroll
              for (int d0 = 0; d0 < 4; ++d0) qf[d0] = *(const bf16x8*)(qp + 16 * d0); }
            const int kl = 128 + 32 * sb + r32;
            float lg[5][16]; float mx = sink;
#pragma unroll
            for (int kt = 0; kt < 5; ++kt) {
                f32x16 p;
#pragma unroll
                for (int r = 0; r < 16; ++r) p[r] = 0.f;
                const LAS unsigned char* kp = Kb + (32 * (sb + kt) + r32) * SB_ROW + 16 * hi;
#pragma unroll
                for (int d0 = 0; d0 < 4; ++d0) p = MFMA32(*(const LAS bf16x8*)(kp + 32 * d0), qf[d0], p);
#pragma unroll
                for (int r = 0; r < 16; ++r) {
                    const int kvl = 32 * (sb + kt) + (r & 3) + 8 * (r >> 2) + 4 * hi, dist = kl - kvl;
                    const bool valid = dist >= 0 && dist < 128 && (n > 0 || kvl >= 128);
                    const float v = valid ? p[r] - slope * (float)dist : -1e30f;
                    lg[kt][r] = v; mx = fmaxf(mx, v);
                }
            }
            mx = fmaxf(mx, __shfl_xor(mx, 32));
            float l = 0.f;
            f32x16 o0, o1;
#pragma unroll
            for (int r = 0; r < 16; ++r) { o0[r] = 0.f; o1[r] = 0.f; }
#pragma unroll
            for (int kt = 0; kt < 5; ++kt) {
#pragma unroll
                for (int r = 0; r < 16; ++r) { const float e = __expf(lg[kt][r] - mx); lg[kt][r] = e; l += e; }
                const bf16x8 pf0 = pack8(&lg[kt][0]), pf1 = pack8(&lg[kt][8]);
#pragma unroll
                for (int s = 0; s < 2; ++s) {
                    const LAS unsigned char* vp = Vb + (32 * (sb + kt) + 16 * s) * SB_ROW + vtr_off;
                    const s16x4 a0 = tr16(vp), a1 = tr16(vp + 8 * SB_ROW), b0 = tr16(vp + 64), b1 = tr16(vp + 64 + 8 * SB_ROW);
                    const bf16x8 vf0 = __builtin_shufflevector(a0, a1, 0, 1, 2, 3, 4, 5, 6, 7), vf1 = __builtin_shufflevector(b0, b1, 0, 1, 2, 3, 4, 5, 6, 7);
                    o0 = MFMA32(vf0, s ? pf1 : pf0, o0); o1 = MFMA32(vf1, s ? pf1 : pf0, o1);
                }
            }
            l += __shfl_xor(l, 32);
            const float inv = 1.f / (l + __expf(sink - mx));
            bf16* op = o + qrow * 1024 + head * 64 + 4 * hi;
#pragma unroll
            for (int g = 0; g < 4; ++g) {
                u32x2 w0, w1; w0.x = cvt_pk_bf16(o0[4 * g] * inv, o0[4 * g + 1] * inv); w0.y = cvt_pk_bf16(o0[4 * g + 2] * inv, o0[4 * g + 3] * inv);
                w1.x = cvt_pk_bf16(o1[4 * g] * inv, o1[4 * g + 1] * inv); w1.y = cvt_pk_bf16(o1[4 * g + 2] * inv, o1[4 * g + 3] * inv);
                *(u32x2*)(op + 8 * g) = w0; *(u32x2*)(op + 32 + 8 * g) = w1;
            }
        }
    }
}

__device__ __forceinline__ void ret_scores(bf16* qk, bf16* sc, int vcu, int G, int tid) {
    const int lane = tid & 63, wave = __builtin_amdgcn_readfirstlane(tid >> 6), r32 = lane & 31, hi = lane >> 5;
    const int it = wave >> 1, jh = wave & 1;
    for (int u = vcu; u < 512; u += G) {
        const int bh = u >> 5, n = u & 31, b = bh >> 2, h = bh & 3;
        const float lg = log2f(1.f - exp2f(-5.f - (float)h));
        const size_t row0 = (size_t)b * SEQ + n * 128;
        const bf16* qp = qk + (row0 + 32 * it + r32) * 2048 + h * 256 + 8 * hi;
        bf16x8 qf[16];
#pragma unroll
        for (int ks = 0; ks < 16; ++ks) qf[ks] = *(const bf16x8*)(qp + 16 * ks);
#pragma unroll
        for (int jt2 = 0; jt2 < 2; ++jt2) {
            const int jt = 2 * jh + jt2;
            if (jt <= it) {
                const bf16* kp = qk + (row0 + 32 * jt + r32) * 2048 + 1024 + h * 256 + 8 * hi;
                f32x16 p;
#pragma unroll
                for (int r = 0; r < 16; ++r) p[r] = 0.f;
#pragma unroll
                for (int ks = 0; ks < 16; ++ks) p = MFMA32(*(const bf16x8*)(kp + 16 * ks), qf[ks], p);
                const int i = 32 * it + r32;
                bf16* sp = sc + (size_t)u * 16384 + (size_t)(it * 8 + 2 * jt) * 512 + r32 * 8 + 4 * hi;
#pragma unroll
                for (int g = 0; g < 4; ++g) {
                    float v[4];
#pragma unroll
                    for (int e = 0; e < 4; ++e) { const int j = 32 * jt + 8 * g + 4 * hi + e; v[e] = (i >= j) ? p[4 * g + e] * exp2f((float)(i - j) * lg) : 0.f; }
                    u32x2 w; w.x = cvt_pk_bf16(v[0], v[1]); w.y = cvt_pk_bf16(v[2], v[3]);
                    *(u32x2*)(sp + (g >> 1) * 512 + (g & 1) * 256) = w;
                }
            }
        }
        __syncthreads();
        if (jh == 0) {
            char* qc = (char*)(qk + row0 * 2048 + h * 256) + (size_t)(it * 32 + hi) * 4096 + r32 * 16;
#pragma unroll
            for (int ks = 0; ks < 16; ++ks) *(bf16x8*)(qc + ks * 8192) = qf[ks];
        }
    }
}
constexpr int RT_ST_ROW = 528, RT_V_ROW = 80, RT_K_ROW = 144;
constexpr int RT_OFF_ST = 0, RT_OFF_V = 32 * RT_ST_ROW, RT_OFF_VD = RT_OFF_V + 128 * RT_V_ROW, RT_OFF_K = RT_OFF_VD + 128 * RT_V_ROW, RT_SLAB = 64 * RT_K_ROW;
__device__ __forceinline__ void ret_scan(const bf16* qk, bf16* vo, const bf16* sc, float* ssqo, LAS unsigned char* lds, int vcu, int G, int tid) {
    const int lane = tid & 63, wave = __builtin_amdgcn_readfirstlane(tid >> 6), r32 = lane & 31, hi = lane >> 5;
    const int i16 = lane & 15, tq = i16 >> 2, tp = i16 & 3, blk = (lane >> 4) & 1;
    const int trv = (8 * hi + tq) * RT_V_ROW + (16 * blk + 4 * tp) * 2, trk = (8 * hi + tq) * RT_K_ROW + (16 * blk + 4 * tp) * 2;
    const int vj = tid >> 2, vch = tid & 3;
    const int krj = lane >> 3, kch = lane & 7, uw = wave & 3;
    const bool owave = wave < 4;
    LAS unsigned char* slab = lds + RT_OFF_K + uw * RT_SLAB;
    for (int u = vcu; u < 256; u += G) {
        const int bh = u >> 4, es = u & 15, b = bh >> 2, h = bh & 3, e0 = 32 * es;
        const float lg = log2f(1.f - exp2f(-5.f - (float)h)), cdec = exp2f(128.f * lg);
        const float kd = exp2f((float)(127 - vj) * lg);
        const size_t rowb = (size_t)b * SEQ;
        const int i = 32 * uw + r32;
        const float qd = exp2f((float)(i + 1) * lg);
        f32x16 st0, st1;
#pragma unroll
        for (int r = 0; r < 16; ++r) { st0[r] = 0.f; st1[r] = 0.f; }
        u32x4 kreg[16], vreg; bf16x8 qreg[16], sreg[8];
        unsigned offq = (unsigned)(hi * 4096 + r32 * 16), offs = (unsigned)(lane * 16), offk = (unsigned)(krj * 2048 + 8 * kch) * 2u, offv = (unsigned)(vj * 2048 + 8 * vch) * 2u;
        unsigned offo = (unsigned)(i * 2048 + 4 * hi) * 2u, offsq = (unsigned)(i * 64) * 4u;
        const char* const qbase = (const char*)(qk + rowb * 2048 + h * 256);
        const char* const kbase = (const char*)(qk + rowb * 2048 + 1024 + h * 256 + 64 * uw);
        const char* const sbase = (const char*)(sc + (size_t)(bh * 32) * 16384);
        char* const vbase = (char*)(vo + rowb * 2048 + h * 512 + e0);
        char* const sqbase = (char*)(ssqo + (rowb * 4 + h) * 16 + es);
#define RT_LOAD_K(nn, half) do { const char* kb_ = kbase + (size_t)(128 * (nn) + 64 * (half)) * 4096; _Pragma("unroll") for (int c8 = 0; c8 < 8; ++c8) \
            kreg[8 * (half) + c8] = *(const u32x4*)(kb_ + c8 * 32768 + offk); } while (0)
#define RT_LOAD_QS(nn) do { const char* qb_ = qbase + (size_t)(128 * (nn) + 32 * uw) * 4096; \
            _Pragma("unroll") for (int ks = 0; ks < 16; ++ks) qreg[ks] = *(const bf16x8*)(qb_ + 8192 * ks + offq); \
            const char* sb_ = sbase + (size_t)(nn) * 32768 + uw * 8192; \
            _Pragma("unroll") for (int ks = 0; ks < 8; ++ks) if (ks < 2 * uw + 2) sreg[ks] = *(const bf16x8*)(sb_ + 1024 * ks + offs); } while (0)
#define RT_LOAD_V(nn) do { vreg = *(const u32x4*)(vbase + (size_t)(128 * (nn)) * 4096 + offv); } while (0)
#define RT_WRITE_V() do { *(LAS u32x4*)(lds + RT_OFF_V + vj * RT_V_ROW + vch * 16) = vreg; float f8[8]; UNPACK8(f8, vreg); \
            u32x4 wd; wd.x = cvt_pk_bf16(f8[0] * kd, f8[1] * kd); wd.y = cvt_pk_bf16(f8[2] * kd, f8[3] * kd); wd.z = cvt_pk_bf16(f8[4] * kd, f8[5] * kd); wd.w = cvt_pk_bf16(f8[6] * kd, f8[7] * kd); \
            *(LAS u32x4*)(lds + RT_OFF_VD + vj * RT_V_ROW + vch * 16) = wd; } while (0)
        __syncthreads();
        for (int x = tid * 16; x < 32 * RT_ST_ROW; x += NTHREADS * 16) *(LAS u32x4*)(lds + RT_OFF_ST + x) = (u32x4){0u, 0u, 0u, 0u};
        RT_LOAD_V(0); RT_WRITE_V();
#define RT_BAR() do { asm volatile("s_waitcnt lgkmcnt(0)" ::: "memory"); __builtin_amdgcn_s_barrier(); asm volatile("" ::: "memory"); } while (0)
        for (int k_ = 0; k_ < es; ++k_) __builtin_amdgcn_s_sleep(6);
        if (owave) {
            RT_LOAD_QS(0);
            for (int n = 0; n < 32; ++n) {
                RT_BAR();
                asm volatile("" : "+v"(offq), "+v"(offs), "+v"(offv), "+v"(offo), "+v"(offsq));
                if (n < 31) RT_LOAD_V(n + 1);
                f32x16 oc, oi;
#pragma unroll
                for (int r = 0; r < 16; ++r) { oc[r] = 0.f; oi[r] = 0.f; }
                const LAS unsigned char* sp = lds + RT_OFF_ST + r32 * RT_ST_ROW + 16 * hi;
#pragma unroll
                for (int ks = 0; ks < 16; ++ks) oc = MFMA32(*(const LAS bf16x8*)(sp + 32 * ks), qreg[ks], oc);
#pragma unroll
                for (int ks = 0; ks < 8; ++ks) if (ks < 2 * uw + 2) {
                    const LAS unsigned char* vp = lds + RT_OFF_V + 16 * ks * RT_V_ROW + trv;
                    const s16x4 a0 = tr16(vp), a1 = tr16(vp + 4 * RT_V_ROW);
                    const bf16x8 vf = __builtin_shufflevector(a0, a1, 0, 1, 2, 3, 4, 5, 6, 7);
                    oi = MFMA32(vf, sreg[ks], oi);
                }
                if (n < 31) RT_LOAD_QS(n + 1);
                float s = 0.f;
                char* const op = vbase + (size_t)(128 * n) * 4096 + offo;
#pragma unroll
                for (int g = 0; g < 4; ++g) {
                    float v[4];
#pragma unroll
                    for (int e = 0; e < 4; ++e) { v[e] = oi[4 * g + e] + qd * oc[4 * g + e]; s += v[e] * v[e]; }
                    u32x2 w; w.x = cvt_pk_bf16(v[0], v[1]); w.y = cvt_pk_bf16(v[2], v[3]);
                    *(u32x2*)(op + 16 * g) = w;
                }
                s += __shfl_xor(s, 32);
                if (hi == 0) *(float*)(sqbase + (size_t)(128 * n) * 256 + offsq) = s;
                RT_BAR();
                if (n < 31) RT_WRITE_V();
            }
        } else {
            RT_LOAD_K(0, 0); RT_LOAD_K(0, 1);
            for (int n = 0; n < 32; ++n) {
                RT_BAR();
                asm volatile("" : "+v"(offk), "+v"(offv));
                if (n < 31) RT_LOAD_V(n + 1);
#pragma unroll
                for (int r = 0; r < 16; ++r) { st0[r] *= cdec; st1[r] *= cdec; }
#pragma unroll
                for (int half = 0; half < 2; ++half) {
#pragma unroll
                    for (int c8 = 0; c8 < 8; ++c8) *(LAS u32x4*)(slab + (krj + 8 * c8) * RT_K_ROW + kch * 16) = kreg[8 * half + c8];
                    if (n < 31) { if (half == 0) RT_LOAD_K(n + 1, 0); else RT_LOAD_K(n + 1, 1); }
#pragma unroll
                    for (int ks = 0; ks < 4; ++ks) {
                        const LAS unsigned char* kp = slab + 16 * ks * RT_K_ROW + trk;
                        const LAS unsigned char* vp = lds + RT_OFF_VD + (64 * half + 16 * ks) * RT_V_ROW + trv;
                        const s16x4 v0 = tr16(vp), v1 = tr16(vp + 4 * RT_V_ROW);
                        const s16x4 k0 = tr16(kp), k1 = tr16(kp + 4 * RT_K_ROW), k2 = tr16(kp + 64), k3 = tr16(kp + 64 + 4 * RT_K_ROW);
                        const bf16x8 vf = __builtin_shufflevector(v0, v1, 0, 1, 2, 3, 4, 5, 6, 7);
                        const bf16x8 kf0 = __builtin_shufflevector(k0, k1, 0, 1, 2, 3, 4, 5, 6, 7), kf1 = __builtin_shufflevector(k2, k3, 0, 1, 2, 3, 4, 5, 6, 7);
                        st0 = MFMA32(kf0, vf, st0); st1 = MFMA32(kf1, vf, st1);
                    }
                }
                RT_BAR();
                { LAS unsigned char* wp = lds + RT_OFF_ST + r32 * RT_ST_ROW + (64 * uw + 4 * hi) * 2;
#pragma unroll
                  for (int g = 0; g < 4; ++g) {
                    u32x2 w0, w1; w0.x = cvt_pk_bf16(st0[4 * g], st0[4 * g + 1]); w0.y = cvt_pk_bf16(st0[4 * g + 2], st0[4 * g + 3]);
                    w1.x = cvt_pk_bf16(st1[4 * g], st1[4 * g + 1]); w1.y = cvt_pk_bf16(st1[4 * g + 2], st1[4 * g + 3]);
                    *(LAS u32x2*)(wp + 16 * g) = w0; *(LAS u32x2*)(wp + 64 + 16 * g) = w1;
                  } }
                if (n < 31) RT_WRITE_V();
            }
        }
#undef RT_BAR
#undef RT_LOAD_K
#undef RT_LOAD_QS
#undef RT_LOAD_V
#undef RT_WRITE_V
    }
}

#define XB_TMO      128
#define XB_XCNT(j)  (256  + 64 * (j))
#define XB_XSUB(j)  (1280 + 64 * (j))
#define XB_XGEN(j)  (2304 + 64 * (j))
#define XB_TOP      3328
#define XB_TOPGEN   3392
#define XCD_BAR_WORDS 3456
#define XB_SPIN_CAP (1u << 18)

__device__ __forceinline__ unsigned xb_ld(unsigned* p)              { return __hip_atomic_load(p, __ATOMIC_RELAXED, __HIP_MEMORY_SCOPE_AGENT); }
__device__ __forceinline__ unsigned xb_add(unsigned* p, unsigned v) { return __hip_atomic_fetch_add(p, v, __ATOMIC_RELAXED, __HIP_MEMORY_SCOPE_AGENT); }
__device__ __forceinline__ unsigned xb_xcc_id() { return (unsigned)__builtin_amdgcn_s_getreg((3 << 11) | 20) & 0xFu; }
#define XB_SPIN(cond, bar) do { unsigned _sp = 0; while (cond) { __builtin_amdgcn_s_sleep(1); \
    if ((++_sp & 255u) == 0u) { if (xb_ld(&(bar)[XB_TMO])) break; if (_sp > XB_SPIN_CAP) { atomicAdd(&(bar)[XB_TMO], 1u); break; } } } } while (0)

struct XcdBarrier {
    unsigned* bar; unsigned x;
    volatile LAS unsigned* st;
};

__device__ __forceinline__ XcdBarrier xcd_barrier_post(unsigned* bar, volatile LAS unsigned* st) {
    XcdBarrier b; b.bar = bar; b.x = xb_xcc_id(); b.st = st;
    if (threadIdx.x == 0) (void)xb_add(&bar[XB_XCNT(b.x)], 1u);
    return b;
}
__device__ __forceinline__ void xcd_barrier_complete(unsigned* bar, unsigned x, unsigned& nloc, unsigned& nx) {
    const unsigned G = gridDim.x * gridDim.y * gridDim.z;
    unsigned sum, cnt, mine, sp = 0u;
    for (;;) {
        sum = 0u; cnt = 0u; mine = 0u;
#pragma unroll
        for (unsigned j = 0; j < 16; ++j) { const unsigned c = xb_ld(&bar[XB_XCNT(j)]); sum += c; cnt += (c > 0u) ? 1u : 0u; mine = (j == x) ? c : mine; }
        if (sum == G) break;
        __builtin_amdgcn_s_sleep(1);
        if ((++sp & 255u) == 0u) { if (xb_ld(&bar[XB_TMO])) break; if (sp > XB_SPIN_CAP) { atomicAdd(&bar[XB_TMO], 1u); break; } }
    }
    nloc = mine > 0u ? mine : 1u; nx = cnt > 0u ? cnt : 1u;
}

__device__ __forceinline__ void xcd_barrier(const XcdBarrier& b) {
    asm volatile("s_waitcnt vmcnt(0)" ::: "memory");
    __syncthreads();
    if (threadIdx.x == 0) {
        unsigned* bar = b.bar;
        __builtin_amdgcn_s_waitcnt(0);
        unsigned nloc = b.st[0], nx = b.st[1];
        if (nloc == 0u) { xcd_barrier_complete(bar, b.x, nloc, nx); b.st[0] = nloc; b.st[1] = nx; }
        const unsigned old = xb_add(&bar[XB_XSUB(b.x)], 1u);
        const unsigned gen = old / nloc;
        if (old + 1u == (gen + 1u) * nloc) {
            __builtin_amdgcn_fence(__ATOMIC_RELEASE, "agent");
            asm volatile("s_waitcnt vmcnt(0)" ::: "memory");
            const unsigned og = xb_add(&bar[XB_TOP], 1u);
            const unsigned tg = og / nx;
            if (og + 1u == (tg + 1u) * nx) xb_add(&bar[XB_TOPGEN], 1u);
            else XB_SPIN(xb_ld(&bar[XB_TOPGEN]) == tg, bar);
            __builtin_amdgcn_fence(__ATOMIC_ACQUIRE, "agent");
            xb_add(&bar[XB_XGEN(b.x)], 1u);
            asm volatile("s_waitcnt vmcnt(0)" ::: "memory");
        } else {
            XB_SPIN(xb_ld(&bar[XB_XGEN(b.x)]) == gen, bar);
            __builtin_amdgcn_fence(__ATOMIC_ACQUIRE, "agent");
            asm volatile("s_waitcnt vmcnt(0)" ::: "memory");
        }
    }
    __syncthreads();
}

#define FILL_RS_TABLE(S_, kk_) do { _Pragma("unroll") for (int ui_ = 0; ui_ < 4; ++ui_) { pg8::Unit u_; kk_[ui_] = -1; \
        if (S_.next(ui_, u_)) { kk_[ui_] = u_.pm; if (tl_ < 256) rstab[ui_ * 256 + tl_] = row_rs(ssq, u_.pm * 256 + tl_); } } __syncthreads(); } while (0)
__global__ void __launch_bounds__(NTHREADS, 2) mega(Args a) {
    extern __shared__ __attribute__((aligned(16))) unsigned char lds_raw[];
    LAS unsigned char* lds = (LAS unsigned char*)lds_raw;
    cg::grid_group grid = cg::this_grid();
    const int tid = threadIdx.x, lane0 = tid & 63, wave = __builtin_amdgcn_readfirstlane(tid >> 6);
    const int G = gridDim.x, bx = blockIdx.x;
    const int gw = bx * NWAVES + wave, NGW = G * NWAVES, gthreads = G * NTHREADS;
    const int vcu = (G % 8 == 0) ? (bx % 8) * (G / 8) + bx / 8 : bx;
    unsigned char* ws = a.ws;
    float* ssq = (float*)(ws + WS_SSQ); bf16* hb = (bf16*)(ws + WS_HB);
    unsigned char* R = ws + WS_R;

    volatile LAS unsigned* xb_st = (volatile LAS unsigned*)(lds + 131072 + 64);
    LAS float* rstab = (LAS float*)(lds + 131072 + 256);
    if (tid < 2) xb_st[tid] = 0u;
    unsigned* barw = (unsigned*)(ws + WS_BAR);
    __syncthreads();
    const XcdBarrier xbar = xcd_barrier_post(barw, xb_st);
    const bool has_slack = (G < 320) && (2 * G > 320);
    convert_layer(a, 0, has_slack ? 1 : 15, lds, gw, NGW, wave, lane0);
    for (int m = gw; m < M; m += 2 * NGW) {
        const int lane = lane0; const int m1 = m + NGW; const bool two = m1 < M;
        const f32x4* xr0 = (const f32x4*)(a.in[0] + (size_t)m * D) + lane; const f32x4* xr1 = (const f32x4*)(a.in[0] + (size_t)(two ? m1 : m) * D) + lane;
        f32x4 v0[4], v1[4];
#pragma unroll
        for (int j = 0; j < 4; ++j) { v0[j] = __builtin_nontemporal_load(xr0 + 64 * j); v1[j] = __builtin_nontemporal_load(xr1 + 64 * j); }
        float s0 = 0.f, s1 = 0.f;
        unsigned long long* o0 = (unsigned long long*)(hb + (size_t)m * D) + lane; unsigned long long* o1 = (unsigned long long*)(hb + (size_t)m1 * D) + lane;
#pragma unroll
        for (int j = 0; j < 4; ++j) {
            s0 += (v0[j][0] * v0[j][0] + v0[j][1] * v0[j][1]) + (v0[j][2] * v0[j][2] + v0[j][3] * v0[j][3]);
            s1 += (v1[j][0] * v1[j][0] + v1[j][1] * v1[j][1]) + (v1[j][2] * v1[j][2] + v1[j][3] * v1[j][3]);
            o0[64 * j] = (unsigned long long)cvt_pk_bf16(v0[j][0], v0[j][1]) | ((unsigned long long)cvt_pk_bf16(v0[j][2], v0[j][3]) << 32);
            if (two) o1[64 * j] = (unsigned long long)cvt_pk_bf16(v1[j][0], v1[j][1]) | ((unsigned long long)cvt_pk_bf16(v1[j][2], v1[j][3]) << 32);
        }
        s0 = wave_sum(s0); s1 = wave_sum(s1);
        if (lane < 16) { ssq[(size_t)m * 16 + lane] = (lane == 0) ? s0 : 0.f; if (two) ssq[(size_t)m1 * 16 + lane] = (lane == 0) ? s1 : 0.f; }
    }
    if (a.ws == nullptr) grid.sync();
    xcd_barrier(xbar);

    for (int i = 0; i < DEPTH; ++i) {
        const int kind = i % 3, j = i / 3;
        unsigned char* wb = ws + ((i & 1) ? WS_WB1 : WS_WB0);
        int tl_ = threadIdx.x; asm volatile("" : "+v"(tl_));
        const int lane = tl_ & 63, gtid = bx * NTHREADS + tl_;
        {
            const int n_in = kind == 0 ? 1280 : (kind == 1 ? 3072 : 4096);
            pg8::Gemm g{hb, (const bf16*)(wb + WB_IN), M, n_in, D}; pg8::StaticOrder S; S.init(M, n_in, G, bx);
            int kk[4]; FILL_RS_TABLE(S, kk);
            EpiRowScale<0> E{(bf16*)R, kind == 2 ? 2048 : n_in, ssq, kind == 2 ? 2048 : 0, (size_t)(R_V / 2), rstab, kk[0], kk[1], kk[2], kk[3]};
            pg8::gemm_phase<EpiRowScale<0>, pg8::StaticOrder, true, true>(lds, g, S, E);
            if (kind == 0 && has_slack) {
                const int first = S.nwg - G;
                if (bx >= first) { convert_layer(a, i, 14, lds, (bx - first) * NWAVES + wave, (G - first) * NWAVES, wave, lane);
                    if (i + 1 < DEPTH) convert_layer(a, i + 1, 15, lds, (bx - first) * NWAVES + wave, (G - first) * NWAVES, wave, lane); }
            }
        }
        xcd_barrier(xbar);
        if (i + 1 < DEPTH && !(kind == 0 && has_slack)) { convert_layer(a, i + 1, (has_slack && (i + 1) % 3 == 0) ? 1 : 15, lds, gw, NGW, wave, lane); __syncthreads(); }
        if (kind == 0) swa_phase((const bf16*)R, a.in[5] + j * 16, (bf16*)(R + R_O), lds, vcu, G, tl_);
        else if (kind == 1) sb_phase_w((const bf16*)R, (bf16*)(R + R_O), lds, vcu, G, tl_);
        else {
            ret_scores((bf16*)R, (bf16*)(ws + WS_SC), vcu, G, tl_);
            xcd_barrier(xbar);
            ret_scan((const bf16*)R, (bf16*)(R + R_V), (const bf16*)(ws + WS_SC), (float*)(ws + WS_SSQO), lds, vcu, G, tl_);
            xcd_barrier(xbar);
            pg8::Gemm g{hb, (const bf16*)(wb + WB_IN) + (size_t)4096 * D, M, 2048, D}; pg8::StaticOrder S; S.init(M, 2048, G, bx);
            EpiGate E{(bf16*)R, (const bf16*)(R + R_V), ssq, (const float*)(ws + WS_SSQO)};
            pg8::gemm_phase<EpiGate, pg8::StaticOrder, true, true>(lds, g, S, E);
        }
        xcd_barrier(xbar);
        {
            const int k_o = kind == 2 ? 2048 : 1024;
            pg8::Gemm g{kind == 2 ? (const bf16*)R : (const bf16*)(R + R_O), (const bf16*)(wb + WB_O), M, D, k_o}; pg8::StaticOrder S; S.init(M, D, G, bx);
            EpiRes<false> E{nullptr, hb, ssq}; pg8::gemm_phase<EpiRes<false>, pg8::StaticOrder, true, true>(lds, g, S, E);
        }
        xcd_barrier(xbar);
        {
            pg8::Gemm g{hb, (const bf16*)(wb + WB_UP), M, FF, D}; pg8::StaticOrder S; S.init(M, FF, G, bx);
            int kk[4]; FILL_RS_TABLE(S, kk);
            EpiRowScale<1> E{(bf16*)R, FF, ssq, 0, 0, rstab, kk[0], kk[1], kk[2], kk[3]};
            pg8::gemm_phase<EpiRowScale<1>, pg8::StaticOrder, true, true>(lds, g, S, E);
        }
        xcd_barrier(xbar);
        {
            pg8::Gemm g{(const bf16*)R, (const bf16*)(wb + WB_DOWN), M, D, FF}; pg8::StaticOrder S; S.init(M, D, G, bx);
            EpiRes<false> E{nullptr, hb, ssq};
            pg8::gemm_phase<EpiRes<false>, pg8::StaticOrder, true, true>(lds, g, S, E);
        }
        xcd_barrier(xbar);
    }
    for (int m = gw; m < M; m += NGW) {
        const float rs = row_rs(ssq, m); const int lane = lane0;
        const u32x4* hr = (const u32x4*)(hb + (size_t)m * D) + lane; const f32x4* gr = (const f32x4*)a.in[3] + 2 * lane; f32x4* orow = (f32x4*)(a.out + (size_t)m * D) + 2 * lane;
#pragma unroll
        for (int jj = 0; jj < 2; ++jj) { const u32x4 hv = hr[64 * jj]; const f32x4 g0 = gr[128 * jj], g1 = gr[128 * jj + 1];
            const f32x4 v0 = (f32x4){bflo(hv.x), bfhi(hv.x), bflo(hv.y), bfhi(hv.y)}, v1 = (f32x4){bflo(hv.z), bfhi(hv.z), bflo(hv.w), bfhi(hv.w)};
            __builtin_nontemporal_store(v0 * rs * g0, orow + 128 * jj); __builtin_nontemporal_store(v1 * rs * g1, orow + 128 * jj + 1); }
    }
}

extern "C" void kernel_launch(void* const* d_in, const int* in_sizes, int n_in, void* d_out, int out_size, void* d_ws, size_t ws_size, hipStream_t stream) {
    static int grid = 0;
    if (grid == 0) {
        if (n_in != 13 || out_size != M * D || ws_size < WS_END) { fprintf(stderr, "kernel_launch: unexpected shapes (n_in %d out %d ws %zu)\n", n_in, out_size, ws_size); grid = -1; return; }
        int dev = 0, cus = 0, per_cu = 0;
        hipGetDevice(&dev); hipDeviceGetAttribute(&cus, hipDeviceAttributeMultiprocessorCount, dev);
        hipFuncSetAttribute((const void*)mega, hipFuncAttributeMaxDynamicSharedMemorySize, LDS_BYTES);
        if (hipOccupancyMaxActiveBlocksPerMultiprocessor(&per_cu, (const void*)mega, NTHREADS, LDS_BYTES) != hipSuccess || per_cu < 1) { fprintf(stderr, "kernel_launch: occupancy query gave %d\n", per_cu); per_cu = 1; }
        (void)hipGetLastError();
        grid = cus * per_cu;
        fprintf(stderr, "kernel_launch: grid %d (cus %d x %d)\n", grid, cus, per_cu);
    }
    if (grid < 0) return;
    Args a{};
    for (int i = 0; i < 13; ++i) a.in[i] = (const float*)d_in[i];
    a.out = (float*)d_out; a.ws = (unsigned char*)d_ws;
    if (hipMemsetAsync((char*)d_ws + WS_BAR, 0, XCD_BAR_WORDS * 4, stream) != hipSuccess) { fprintf(stderr, "kernel_launch: memset of the barrier words failed\n"); return; }
    void* args[] = {&a};
    hipError_t e = hipLaunchCooperativeKernel((const void*)mega, dim3(grid), dim3(NTHREADS), args, LDS_BYTES, stream);
    if (e != hipSuccess) fprintf(stderr, "cooperative launch failed: %s (grid %d)\n", hipGetErrorString(e), grid);
}
```
